# Optimizing an MI355X kernel written in HIP

```python
import math
import jax, jax.numpy as jnp
from jax import lax
import numpy as np

D_MODEL = 1024
BATCH = 8
SEQ = 2048
DEPTH = 2

N_HEADS = 8
HEAD_DIM = 64
ATTN_WIDTH = N_HEADS * HEAD_DIM
CONV_WIDTH = 512
CONV_K = 31
DILATED_GROUPS = ((128, 1), (512, 4), (2048, 16))
BLK = 128
ROPE_THETA = 10000.0
N_EXPERT_GROUPS = 4
EXPERTS_PER_GROUP = 8
N_EXPERTS = N_EXPERT_GROUPS * EXPERTS_PER_GROUP
EXPERT_FF = 512
TOP_K_IN_GROUP = 2
MOE_BLOCK = 128
PLE_DIM = 256
EPS = 1e-6
NEG_INF = -1e30

W_IN_SPLITS = (ATTN_WIDTH, 2 * ATTN_WIDTH, 3 * ATTN_WIDTH,
               3 * ATTN_WIDTH + CONV_WIDTH, 3 * ATTN_WIDTH + 2 * CONV_WIDTH,
               3 * ATTN_WIDTH + 2 * CONV_WIDTH + D_MODEL)
W_IN_COLS = 3 * ATTN_WIDTH + 2 * CONV_WIDTH + 2 * D_MODEL

kernel_name = "hybrid_dilated_attn_conformer_hmoe_ple"


def _rms_norm(t, g):
    tf = t.astype(jnp.float32)
    y = tf * lax.rsqrt(jnp.mean(tf * tf, axis=-1, keepdims=True) + EPS)
    return (y * g.astype(jnp.float32)).astype(t.dtype)


def _layer_norm(t, g, b):
    tf = t.astype(jnp.float32)
    mu = jnp.mean(tf, axis=-1, keepdims=True)
    var = jnp.mean(jnp.square(tf - mu), axis=-1, keepdims=True)
    y = (tf - mu) * lax.rsqrt(var + EPS)
    return (y * g.astype(jnp.float32) + b.astype(jnp.float32)).astype(t.dtype)


def _rope(t):
    S = t.shape[1]
    inv = jnp.power(ROPE_THETA, -jnp.arange(0, HEAD_DIM, 2, dtype=jnp.float32) / HEAD_DIM)
    ang = jnp.arange(S, dtype=jnp.float32)[:, None] * inv[None, :]
    cos = jnp.cos(ang)[None, :, None, :]
    sin = jnp.sin(ang)[None, :, None, :]
    tf = t.astype(jnp.float32)
    t1, t2 = tf[..., :HEAD_DIM // 2], tf[..., HEAD_DIM // 2:]
    return jnp.concatenate([t1 * cos - t2 * sin, t1 * sin + t2 * cos], axis=-1).astype(t.dtype)


def _to_dilated_blocks(t, dilation):
    B, S = t.shape[0], t.shape[1]
    rest = t.shape[2:]
    seg = dilation * BLK
    Sp = -(-S // seg) * seg
    t = jnp.pad(t, [(0, 0), (0, Sp - S)] + [(0, 0)] * len(rest))
    t = t.reshape((B, Sp // dilation, dilation) + rest)
    t = jnp.moveaxis(t, 2, 1)
    return t.reshape((B, dilation, Sp // seg, BLK) + rest)


def _from_dilated_blocks(t, S):
    B, d, nb, blk = t.shape[:4]
    rest = t.shape[4:]
    t = t.reshape((B, d, nb * blk) + rest)
    t = jnp.moveaxis(t, 1, 2).reshape((B, nb * blk * d) + rest)
    return t[:, :S]


def _dilated_window_attention(q, k, v, window, dilation):
    band = window // dilation
    assert band <= BLK
    S = q.shape[1]
    qb, kb, vb = (_to_dilated_blocks(t, dilation) for t in (q, k, v))

    def with_prev(t):
        prev = jnp.pad(t, ((0, 0), (0, 0), (1, 0), (0, 0), (0, 0), (0, 0)))[:, :, :-1]
        return jnp.concatenate([prev, t], axis=3)

    kk, vv = with_prev(kb), with_prev(vb)
    s = jnp.einsum('brnqhe,brnkhe->brnhqk', qb, kk,
                   preferred_element_type=jnp.float32) * (HEAD_DIM ** -0.5)
    nb = qb.shape[2]
    qi = jnp.arange(BLK)[:, None] + BLK
    kj = jnp.arange(2 * BLK)[None, :]
    in_band = (kj <= qi) & (qi - kj <= band)
    not_before_start = (jnp.arange(nb)[:, None, None] > 0) | (kj >= BLK)[None]
    allowed = in_band[None] & not_before_start
    s = jnp.where(allowed[:, None], s, NEG_INF)
    m = jnp.max(s, axis=-1)
    pexp = jnp.exp(s - m[..., None])
    l = jnp.sum(pexp, axis=-1)
    acc = jnp.einsum('brnhqk,brnkhe->brnqhe', pexp.astype(v.dtype), vv,
                     preferred_element_type=jnp.float32)
    m = jnp.moveaxis(m, 3, 4)
    l = jnp.moveaxis(l, 3, 4)
    return (_from_dilated_blocks(acc, S), _from_dilated_blocks(m, S), _from_dilated_blocks(l, S))


def _dilated_mixture_attention(q, k, v):
    parts = [_dilated_window_attention(q, k, v, w, d) for (w, d) in DILATED_GROUPS]
    M = parts[0][1]
    for _, m_g, _ in parts[1:]:
        M = jnp.maximum(M, m_g)
    num = 0.0
    den = 0.0
    for acc_g, m_g, l_g in parts:
        scale = jnp.exp(m_g - M)
        num = num + acc_g * scale[..., None]
        den = den + l_g * scale
    o = num / den[..., None]
    B, S = q.shape[0], q.shape[1]
    return o.reshape(B, S, ATTN_WIDTH).astype(q.dtype)


def _conformer_conv(cu, cg, w_dw, b_dw, ln_g, ln_b):
    u = cu * jax.nn.sigmoid(cg)
    rhs = w_dw.reshape(CONV_K, 1, CONV_WIDTH).astype(u.dtype)
    y = lax.conv_general_dilated(u, rhs, window_strides=(1,), padding=[(CONV_K - 1, 0)],
                                 dimension_numbers=('NWC', 'WIO', 'NWC'),
                                 feature_group_count=CONV_WIDTH)
    y = y + b_dw
    y = _layer_norm(y, ln_g, ln_b)
    return jax.nn.silu(y)


def _hier_moe(h, w_rg, b_rg, w_re, b_re, w_gate, w_up, w_down):
    B, S, D = h.shape
    T = B * S
    hf = h.reshape(T, D)
    lg = (hf @ w_rg + b_rg).astype(jnp.float32)
    pg = jax.nn.softmax(lg, axis=-1)
    gsel = jnp.argmax(lg, axis=-1)
    le = (hf @ w_re + b_re).astype(jnp.float32).reshape(T, N_EXPERT_GROUPS, EXPERTS_PER_GROUP)
    le_sel = jnp.take_along_axis(le, gsel[:, None, None], axis=1)[:, 0]
    top_v, top_i = lax.top_k(le_sel, TOP_K_IN_GROUP)
    gate = jnp.take_along_axis(pg, gsel[:, None], axis=1) * jax.nn.softmax(top_v, axis=-1)
    eid = gsel[:, None] * EXPERTS_PER_GROUP + top_i

    A = T * TOP_K_IN_GROUP
    flat_e = eid.reshape(-1)
    order = jnp.argsort(flat_e)
    sorted_e = flat_e[order]
    counts = jnp.bincount(flat_e, length=N_EXPERTS)
    padded = ((counts + MOE_BLOCK - 1) // MOE_BLOCK) * MOE_BLOCK
    ends = jnp.cumsum(padded)
    pad_start = ends - padded
    start = jnp.cumsum(counts) - counts
    dest = pad_start[sorted_e] + (jnp.arange(A) - start[sorted_e])
    n_rows = (-(-A // MOE_BLOCK)) * MOE_BLOCK + N_EXPERTS * MOE_BLOCK
    n_blocks = n_rows // MOE_BLOCK
    tok = order // TOP_K_IN_GROUP
    buf = jnp.zeros((n_rows, D), hf.dtype).at[dest].set(hf[tok])
    block_e = jnp.minimum(jnp.searchsorted(ends, jnp.arange(n_blocks) * MOE_BLOCK, side='right'),
                          N_EXPERTS - 1)

    def expert_block(args):
        xb, e = args
        hb = jax.nn.silu(xb @ w_gate[e]) * (xb @ w_up[e])
        return hb @ w_down[e]

    yb = lax.map(expert_block, (buf.reshape(n_blocks, MOE_BLOCK, D), block_e))
    y_rows = yb.reshape(n_rows, D)[dest]
    contrib = y_rows * gate.reshape(-1)[order][:, None].astype(y_rows.dtype)
    out = jnp.zeros((T, D), hf.dtype).at[tok].add(contrib)
    return out.reshape(B, S, D)


def setup_inputs(seed: int = 0) -> dict:
    key = jax.random.key(seed)
    ks = jax.random.split(key, 24)
    L, D, f32 = DEPTH, D_MODEL, jnp.float32

    def nrm(k, shape, fan_in):
        return jax.random.normal(k, shape, f32) * (fan_in ** -0.5)

    def gain(k, shape):
        return 1.0 + 0.05 * jax.random.normal(k, shape, f32)

    def small(k, shape, s=0.02):
        return s * jax.random.normal(k, shape, f32)

    return {
        "x": jax.random.normal(ks[0], (BATCH, SEQ, D), f32),
        "p": jax.random.normal(ks[1], (DEPTH, BATCH, SEQ, PLE_DIM), f32),
        "norm_mix": gain(ks[2], (L, D)),
        "w_in": nrm(ks[3], (L, D, W_IN_COLS), D),
        "w_dw": nrm(ks[4], (L, CONV_K, CONV_WIDTH), CONV_K),
        "b_dw": small(ks[5], (L, CONV_WIDTH)),
        "ln_conv_g": gain(ks[6], (L, CONV_WIDTH)),
        "ln_conv_b": small(ks[7], (L, CONV_WIDTH)),
        "w_attn_out": nrm(ks[8], (L, ATTN_WIDTH, D), ATTN_WIDTH),
        "w_conv_out": nrm(ks[9], (L, CONV_WIDTH, D), CONV_WIDTH),
        "b_conv_out": small(ks[10], (L, D)),
        "w_out": nrm(ks[11], (L, D, D), D),
        "norm_ffn": gain(ks[12], (L, D)),
        "w_route_group": nrm(ks[13], (L, D, N_EXPERT_GROUPS), D),
        "b_route_group": small(ks[14], (L, N_EXPERT_GROUPS), 0.01),
        "w_route_expert": nrm(ks[15], (L, D, N_EXPERTS), D),
        "b_route_expert": small(ks[16], (L, N_EXPERTS), 0.01),
        "w_exp_gate": nrm(ks[17], (L, N_EXPERTS, D, EXPERT_FF), D),
        "w_exp_up": nrm(ks[18], (L, N_EXPERTS, D, EXPERT_FF), D),
        "w_exp_down": nrm(ks[19], (L, N_EXPERTS, EXPERT_FF, D), EXPERT_FF),
        "norm_ple": gain(ks[20], (L, D)),
        "w_ple_proj": nrm(ks[21], (L, PLE_DIM, D), PLE_DIM),
        "w_ple_gate": nrm(ks[22], (L, D, D), D),
        "norm_final": gain(ks[23], (D,)),
    }


def reference(x, p, norm_mix, w_in, w_dw, b_dw, ln_conv_g, ln_conv_b, w_attn_out,
              w_conv_out, b_conv_out, w_out, norm_ffn, w_route_group, b_route_group,
              w_route_expert, b_route_expert, w_exp_gate, w_exp_up, w_exp_down,
              norm_ple, w_ple_proj, w_ple_gate, norm_final):
    B, S, _ = x.shape
    for i in range(DEPTH):
        h = _rms_norm(x, norm_mix[i])
        z = h @ w_in[i]
        q, k, v, cu, cg, ga, gb = jnp.split(z, W_IN_SPLITS, axis=-1)
        q = _rope(q.reshape(B, S, N_HEADS, HEAD_DIM))
        k = _rope(k.reshape(B, S, N_HEADS, HEAD_DIM))
        v = v.reshape(B, S, N_HEADS, HEAD_DIM)
        y_a = _dilated_mixture_attention(q, k, v) @ w_attn_out[i]
        y_b = _conformer_conv(cu, cg, w_dw[i], b_dw[i], ln_conv_g[i], ln_conv_b[i]) \
            @ w_conv_out[i] + b_conv_out[i]
        merged = jax.nn.sigmoid(ga) * y_a + jax.nn.sigmoid(gb) * y_b
        x = x + merged @ w_out[i]
        h2 = _rms_norm(x, norm_ffn[i])
        x = x + _hier_moe(h2, w_route_group[i], b_route_group[i], w_route_expert[i],
                          b_route_expert[i], w_exp_gate[i], w_exp_up[i], w_exp_down[i])
        g_ple = jax.nn.sigmoid(_rms_norm(x, norm_ple[i]) @ w_ple_gate[i])
        x = x + g_ple * (p[i] @ w_ple_proj[i])
    return _rms_norm(x, norm_final)
```

```cpp
#define MK_OPT_PHASES 22
#define MK_SINGLE 1
#include <hip/hip_runtime.h>
#include <cstdio>
#include <cstdint>
#include <cmath>
namespace pg8 {
#define PG8_LAS __attribute__((address_space(3)))
typedef unsigned short bf16_t;
typedef short bf16x8 __attribute__((ext_vector_type(8)));
typedef float f32x4 __attribute__((ext_vector_type(4)));
typedef float f32x2 __attribute__((ext_vector_type(2)));
typedef unsigned u32x4 __attribute__((ext_vector_type(4)));
typedef unsigned u32x2 __attribute__((ext_vector_type(2)));
constexpr int BM = 256, BK = 64, HALF = 128, HTB = HALF * BK * 2  , STAGE_BYTES = 8 * HTB, NXCD = 8, WGM = 8;

__host__ __device__ __forceinline__ int lds_byte(int r, int c) { const int st = (r >> 4) * 2 + (c >> 5), rr = r & 15, cc = c & 31, ob = rr * 64 + cc * 2; return st * 1024 + (ob ^ (((ob >> 9) & 1) << 5)); }
__host__ __device__ __forceinline__ void stage_rc(int b, int& R, int& C) { const int st = b / 1024, sb = b % 1024, swz = sb ^ (((sb >> 9) & 1) << 5); R = (st >> 1) * 16 + swz / 64; C = (st & 1) * 32 + (swz % 64) / 2; }
__host__ __device__ __forceinline__ int perm32(int rho) { const int n = rho >> 4, i = rho & 15; return 8 * (i >> 2) + 4 * n + (i & 3); }

struct Unit { int pm, pn, aux; const char* A; const char* B; };
struct Dims { int K, lda, ldb; };

__host__ __device__ __forceinline__ void tile_of(int L, int nM, int nN, int& pm, int& pn) {
    const int nwg = nM * nN; int wgid = L; { const int q = nwg / NXCD, r = nwg % NXCD, xcd = wgid % NXCD, off = wgid / NXCD; wgid = (xcd < r ? xcd * (q + 1) : r * (q + 1) + (xcd - r) * q) + off; }
    const int nig = WGM * nN, gid = wgid / nig, fm = gid * WGM, gsz = (nM - fm) < WGM ? (nM - fm) : WGM;
    pm = fm + ((wgid % nig) % gsz); pn = (wgid % nig) / gsz;
}

typedef __bf16 bf16x2v __attribute__((ext_vector_type(2)));
__device__ __forceinline__ unsigned cvt_pk_bf16(float lo, float hi) { const f32x2 v = {lo, hi}; const bf16x2v b = __builtin_convertvector(v, bf16x2v); return __builtin_bit_cast(unsigned, b); }
__device__ __forceinline__ u32x4 pack8(const f32x4 a, const f32x4 b) { u32x4 w; w.x = cvt_pk_bf16(a[0], a[1]); w.y = cvt_pk_bf16(a[2], a[3]); w.z = cvt_pk_bf16(b[0], b[1]); w.w = cvt_pk_bf16(b[2], b[3]); return w; }
__device__ __forceinline__ float bf_lo(unsigned w) { return __uint_as_float(w << 16); }
__device__ __forceinline__ float bf_hi(unsigned w) { return __uint_as_float(w & 0xffff0000u); }
__device__ __forceinline__ void unpack8(const u32x4 w, f32x4& a, f32x4& b) { a[0] = bf_lo(w.x); a[1] = bf_hi(w.x); a[2] = bf_lo(w.y); a[3] = bf_hi(w.y); b[0] = bf_lo(w.z); b[1] = bf_hi(w.z); b[2] = bf_lo(w.w); b[3] = bf_hi(w.w); }
__device__ __forceinline__ float sigm(float x) { return __builtin_amdgcn_rcpf(1.0f + __builtin_amdgcn_exp2f(-1.4426950408889634f * x)); }
__device__ __forceinline__ f32x4 sigm4(const f32x4 x) { f32x4 r; r[0] = sigm(x[0]); r[1] = sigm(x[1]); r[2] = sigm(x[2]); r[3] = sigm(x[3]); return r; }

template <class Epi, class Sched, bool ALIGN_EPI>
__device__ __forceinline__ void gemm_phase(PG8_LAS unsigned char* lds, const Dims g, const Sched& S, const Epi& E) {
    int tid_ = threadIdx.x; asm volatile("" : "+v"(tid_));
    const int tid = tid_, wid = __builtin_amdgcn_readfirstlane(tid >> 6), lane = tid & 63, wr = wid >> 2, wc = wid & 3, fr = lane & 15, fq = lane >> 4;
    const int K = g.K, nt = K / BK;
    unsigned voffA[2], voffB[2];
#pragma unroll
    for (int i = 0; i < 2; ++i) { int R, C; stage_rc(tid * 16 + i * 8192, R, C); const int Rb = Epi::PERM ? ((R & ~31) + perm32(R & 31)) : R;
        voffA[i] = (unsigned)(R * g.lda + C) * 2u; voffB[i] = (unsigned)(Rb * g.ldb + C) * 2u; }
    const size_t kstep = (size_t)(BK * 2);
    const size_t hA = (size_t)HALF * g.lda * 2, hB = (size_t)HALF * g.ldb * 2;
    const unsigned ldsw = (unsigned)wid * 1024u;
    const int aoff = lds_byte(wr * 64 + fr, fq * 8), boff = lds_byte(wc * 32 + fr, fq * 8);
#define PG8_SA(b, h) (((b) * 2 + (h)) * HTB)
#define PG8_SB(b, h) ((4 + (b) * 2 + (h)) * HTB)
#define PG8_STAGE(bufoff, gbase, voff) do { _Pragma("unroll") for (int _i = 0; _i < 2; ++_i) \
        __builtin_amdgcn_global_load_lds((const unsigned*)((const char*)(gbase) + (voff)[_i]), (PG8_LAS unsigned*)(lds + (bufoff) + ldsw + _i * 8192), 16, 0, 0); } while (0)
#define PG8_LDA(dst, b, h) do { _Pragma("unroll") for (int m = 0; m < 4; ++m) _Pragma("unroll") for (int k = 0; k < 2; ++k) dst[m][k] = *(const PG8_LAS bf16x8*)(lds + PG8_SA(b, h) + aoff + m * 2048 + k * 1024); } while (0)
#define PG8_LDB(dst, b, h) do { _Pragma("unroll") for (int n = 0; n < 2; ++n) _Pragma("unroll") for (int k = 0; k < 2; ++k) dst[n][k] = *(const PG8_LAS bf16x8*)(lds + PG8_SB(b, h) + boff + n * 2048 + k * 1024); } while (0)
#define PG8_MMA(ai, bj, At, Bt) do { __builtin_amdgcn_s_setprio(1); _Pragma("unroll") for (int m = 0; m < 4; ++m) _Pragma("unroll") for (int n = 0; n < 2; ++n) _Pragma("unroll") for (int k = 0; k < 2; ++k) \
        acc[ai][bj][m][n] = __builtin_amdgcn_mfma_f32_16x16x32_bf16(Bt[n][k], At[m][k], acc[ai][bj][m][n], 0, 0, 0); __builtin_amdgcn_s_setprio(0); } while (0)
#define PG8_WAIT_V(n) asm volatile("s_waitcnt vmcnt(" #n ")" ::: "memory")
#define PG8_WAIT_L(n) asm volatile("s_waitcnt lgkmcnt(" #n ")" ::: "memory")
#define PG8_BAR __builtin_amdgcn_s_barrier()
#define PG8_SCHED __builtin_amdgcn_sched_barrier(0)
    Unit cur, nxt; int ui = 0;
    if (!S.next(0, cur)) return;
    f32x4 acc[2][2][4][2];
#pragma unroll
    for (int a = 0; a < 2; ++a)
#pragma unroll
        for (int b = 0; b < 2; ++b)
#pragma unroll
            for (int m = 0; m < 4; ++m)
#pragma unroll
                for (int n = 0; n < 2; ++n) acc[a][b][m][n] = (f32x4){0.f, 0.f, 0.f, 0.f};
    bf16x8 At[4][2], B0[2][2], B1[2][2];
    const char* cA = cur.A; const char* cB = cur.B;
    PG8_STAGE(PG8_SB(0, 0), cB, voffB); PG8_STAGE(PG8_SB(0, 1), cB + hB, voffB); PG8_STAGE(PG8_SA(0, 0), cA, voffA); PG8_STAGE(PG8_SA(0, 1), cA + hA, voffA);
    if (wr == 1) PG8_BAR;
    PG8_WAIT_V(2); PG8_BAR;
    PG8_STAGE(PG8_SB(1, 0), cB + kstep, voffB); PG8_STAGE(PG8_SA(1, 0), cA + kstep, voffA); PG8_STAGE(PG8_SB(1, 1), cB + hB + kstep, voffB);
    PG8_WAIT_V(6); PG8_BAR;
    for (;;) {
        const bool has_next = S.next(ui + 1, nxt);
        const char* nA = has_next ? nxt.A : cA; const char* nB = has_next ? nxt.B : cB;
        for (int t = 0; t < nt; t += 2) {
            const bool last = (t == nt - 2);
            const char* a1 = cA + (size_t)(t + 1) * kstep;
            const char* a2 = last ? nA : cA + (size_t)(t + 2) * kstep; const char* b2 = last ? nB : cB + (size_t)(t + 2) * kstep;
            const char* a3 = a2 + kstep; const char* b3 = b2 + kstep;
            PG8_LDB(B0, 0, 0); PG8_LDB(B1, 0, 1); PG8_SCHED; PG8_LDA(At, 0, 0); PG8_STAGE(PG8_SA(1, 1), a1 + hA, voffA);
            PG8_WAIT_V(8); PG8_WAIT_L(0); PG8_BAR; PG8_MMA(0, 0, At, B0); PG8_MMA(0, 1, At, B1); PG8_BAR; PG8_SCHED;
            PG8_LDA(At, 0, 1); PG8_STAGE(PG8_SB(0, 0), b2, voffB); PG8_STAGE(PG8_SB(0, 1), b2 + hB, voffB); PG8_STAGE(PG8_SA(0, 0), a2, voffA);
            PG8_WAIT_V(8); PG8_WAIT_L(0); PG8_BAR; PG8_MMA(1, 0, At, B0); PG8_MMA(1, 1, At, B1); PG8_BAR; PG8_SCHED;
            PG8_LDB(B0, 1, 0); PG8_LDB(B1, 1, 1); PG8_SCHED; PG8_LDA(At, 1, 0); PG8_STAGE(PG8_SA(0, 1), a2 + hA, voffA);
            PG8_WAIT_V(8); PG8_WAIT_L(0); PG8_BAR; PG8_MMA(0, 0, At, B0); PG8_MMA(0, 1, At, B1); PG8_BAR; PG8_SCHED;
            PG8_LDA(At, 1, 1); PG8_STAGE(PG8_SB(1, 0), b3, voffB); PG8_STAGE(PG8_SB(1, 1), b3 + hB, voffB); PG8_STAGE(PG8_SA(1, 0), a3, voffA);
            PG8_WAIT_V(8); PG8_WAIT_L(0); PG8_BAR; PG8_MMA(1, 0, At, B0); PG8_MMA(1, 1, At, B1); PG8_BAR; PG8_SCHED;
        }
        if constexpr (ALIGN_EPI) { if (wr == 0) PG8_BAR; }
        E(acc, cur, wr, wc, fr, fq);
        if (!has_next) break;
#pragma unroll
        for (int a = 0; a < 2; ++a)
#pragma unroll
            for (int b = 0; b < 2; ++b)
#pragma unroll
                for (int m = 0; m < 4; ++m)
#pragma unroll
                    for (int n = 0; n < 2; ++n) acc[a][b][m][n] = (f32x4){0.f, 0.f, 0.f, 0.f};
        cur = nxt; cA = nA; cB = nB; ++ui;
        if constexpr (ALIGN_EPI) { if (wr == 1) PG8_BAR; }
    }
    PG8_WAIT_V(0);
    if constexpr (!ALIGN_EPI) { if (wr == 0) PG8_BAR; }
    PG8_BAR;
#undef PG8_SA
#undef PG8_SB
#undef PG8_STAGE
#undef PG8_LDA
#undef PG8_LDB
#undef PG8_MMA
#undef PG8_WAIT_V
#undef PG8_WAIT_L
#undef PG8_BAR
#undef PG8_SCHED
}

template <class Epi, class Sched, bool ALIGN_EPI>
__device__ __forceinline__ void gemm_phase_ref(PG8_LAS unsigned char* lds, const Dims g, const Sched& S, const Epi& E) {
    int tid_ = threadIdx.x; asm volatile("" : "+v"(tid_));
    const int tid = tid_, wid = __builtin_amdgcn_readfirstlane(tid >> 6), lane = tid & 63, wr = wid >> 2, wc = wid & 3, fr = lane & 15, fq = lane >> 4;
    typedef __bf16 bf2 __attribute__((ext_vector_type(2)));
    Unit cur;
    for (int ui = 0; S.next(ui, cur); ++ui) {
        f32x4 acc[2][2][4][2];
#pragma unroll
        for (int a = 0; a < 2; ++a)
#pragma unroll
            for (int b = 0; b < 2; ++b)
#pragma unroll
                for (int m = 0; m < 4; ++m)
#pragma unroll
                    for (int n = 0; n < 2; ++n) acc[a][b][m][n] = (f32x4){0.f, 0.f, 0.f, 0.f};
        for (int k0 = 0; k0 < g.K; k0 += 8) {
            u32x4 av[2][4];
#pragma unroll
            for (int a = 0; a < 2; ++a)
#pragma unroll
                for (int m = 0; m < 4; ++m) av[a][m] = *(const u32x4*)(cur.A + ((size_t)(128 * a + 64 * wr + 16 * m + fr) * g.lda + k0) * 2);
#pragma unroll
            for (int b = 0; b < 2; ++b)
#pragma unroll
                for (int n = 0; n < 2; ++n)
#pragma unroll
                    for (int i = 0; i < 4; ++i) {
                        const int col = Epi::PERM ? (128 * b + 32 * wc + 8 * fq + 4 * n + i) : (128 * b + 32 * wc + 16 * n + 4 * fq + i);
                        const u32x4 bv = *(const u32x4*)(cur.B + ((size_t)col * g.ldb + k0) * 2);
#pragma unroll
                        for (int a = 0; a < 2; ++a)
#pragma unroll
                            for (int m = 0; m < 4; ++m) { float s = acc[a][b][m][n][i];
                                s = __builtin_amdgcn_fdot2_f32_bf16(__builtin_bit_cast(bf2, av[a][m].x), __builtin_bit_cast(bf2, bv.x), s, false);
                                s = __builtin_amdgcn_fdot2_f32_bf16(__builtin_bit_cast(bf2, av[a][m].y), __builtin_bit_cast(bf2, bv.y), s, false);
                                s = __builtin_amdgcn_fdot2_f32_bf16(__builtin_bit_cast(bf2, av[a][m].z), __builtin_bit_cast(bf2, bv.z), s, false);
                                s = __builtin_amdgcn_fdot2_f32_bf16(__builtin_bit_cast(bf2, av[a][m].w), __builtin_bit_cast(bf2, bv.w), s, false);
                                acc[a][b][m][n][i] = s; }
                    }
        }
        E(acc, cur, wr, wc, fr, fq);
    }
}
}
#define GAS __attribute__((address_space(1)))
#define LAS __attribute__((address_space(3)))
typedef unsigned short bf16;
typedef unsigned v4u __attribute__((ext_vector_type(4)));
typedef unsigned v2u __attribute__((ext_vector_type(2)));
typedef float f32x4 __attribute__((ext_vector_type(4)));
typedef float f32x2 __attribute__((ext_vector_type(2)));
typedef short bf16x8 __attribute__((ext_vector_type(8)));
typedef __bf16 bf16x2_t __attribute__((ext_vector_type(2)));
typedef GAS unsigned gu32;
#define RLX_AGENT __ATOMIC_RELAXED, __HIP_MEMORY_SCOPE_AGENT
#define LDS_WAIT() asm volatile("s_waitcnt lgkmcnt(0)" ::: "memory")
#define VM_WAIT() asm volatile("s_waitcnt vmcnt(0)" ::: "memory")
using pg8::cvt_pk_bf16; using pg8::pack8; using pg8::unpack8; using pg8::bf_lo; using pg8::bf_hi; using pg8::sigm; using pg8::sigm4;

__device__ __forceinline__ float wave_sum(float v) {
#pragma unroll
    for (int o = 1; o < 64; o <<= 1) v += __shfl_xor(v, o);
    return v;
}
__device__ __forceinline__ float dot2bf(unsigned a, unsigned b, float acc) { return __builtin_amdgcn_fdot2_f32_bf16(__builtin_bit_cast(bf16x2_t, a), __builtin_bit_cast(bf16x2_t, b), acc, false); }

#define XB_TMO      128
#define XB_XCNT(j)  (256  + 64 * (j))
#define XB_XSUB(j)  (1280 + 64 * (j))
#define XB_XGEN(j)  (2304 + 64 * (j))
#define XB_TOP      3328
#define XB_TOPGEN   3392
#define XCD_BAR_WORDS 3456
#define XB_SPIN_CAP (1u << 18)

__device__ __forceinline__ unsigned xb_ld(unsigned* p)              { return __hip_atomic_load(p, __ATOMIC_RELAXED, __HIP_MEMORY_SCOPE_AGENT); }
__device__ __forceinline__ unsigned xb_add(unsigned* p, unsigned v) { return __hip_atomic_fetch_add(p, v, __ATOMIC_RELAXED, __HIP_MEMORY_SCOPE_AGENT); }
__device__ __forceinline__ unsigned xb_xcc_id() { return (unsigned)__builtin_amdgcn_s_getreg((3 << 11) | 20) & 0xFu; }
#define XB_SPIN(cond, bar) do { unsigned _sp = 0; while (cond) { __builtin_amdgcn_s_sleep(1); \
    if ((++_sp & 255u) == 0u) { if (xb_ld(&(bar)[XB_TMO])) break; if (_sp > XB_SPIN_CAP) { atomicAdd(&(bar)[XB_TMO], 1u); break; } } } } while (0)

struct XcdBarrier {
    unsigned* bar; unsigned x;
    volatile LAS unsigned* st;
};
__device__ __forceinline__ XcdBarrier xcd_barrier_post(unsigned* bar, volatile LAS unsigned* st) {
    XcdBarrier b; b.bar = bar; b.x = xb_xcc_id(); b.st = st;
    if (threadIdx.x == 0) (void)xb_add(&bar[XB_XCNT(b.x)], 1u);
    return b;
}
__device__ __forceinline__ void xcd_barrier_complete(unsigned* bar, unsigned x, unsigned& nloc, unsigned& nx) {
    const unsigned G = gridDim.x * gridDim.y * gridDim.z;
    unsigned sum, cnt, mine, sp = 0u;
    for (;;) {
        sum = 0u; cnt = 0u; mine = 0u;
#pragma unroll
        for (unsigned j = 0; j < 16; ++j) { const unsigned c = xb_ld(&bar[XB_XCNT(j)]); sum += c; cnt += (c > 0u) ? 1u : 0u; mine = (j == x) ? c : mine; }
        if (sum == G) break;
        __builtin_amdgcn_s_sleep(1);
        if ((++sp & 255u) == 0u) { if (xb_ld(&bar[XB_TMO])) break; if (sp > XB_SPIN_CAP) { atomicAdd(&bar[XB_TMO], 1u); break; } }
    }
    nloc = mine > 0u ? mine : 1u; nx = cnt > 0u ? cnt : 1u;
}
__device__ __forceinline__ void xcd_barrier(const XcdBarrier& b) {
    asm volatile("s_waitcnt vmcnt(0)" ::: "memory");
    __syncthreads();
    if (threadIdx.x == 0) {
        unsigned* bar = b.bar;
        __builtin_amdgcn_s_waitcnt(0);
        unsigned nloc = b.st[0], nx = b.st[1];
        if (nloc == 0u) { xcd_barrier_complete(bar, b.x, nloc, nx); b.st[0] = nloc; b.st[1] = nx; }
        const unsigned old = xb_add(&bar[XB_XSUB(b.x)], 1u);
        const unsigned gen = old / nloc;
        if (old + 1u == (gen + 1u) * nloc) {
            __builtin_amdgcn_fence(__ATOMIC_RELEASE, "agent");
            asm volatile("s_waitcnt vmcnt(0)" ::: "memory");
            const unsigned og = xb_add(&bar[XB_TOP], 1u);
            const unsigned tg = og / nx;
            if (og + 1u == (tg + 1u) * nx) xb_add(&bar[XB_TOPGEN], 1u);
            else XB_SPIN(xb_ld(&bar[XB_TOPGEN]) == tg, bar);
            __builtin_amdgcn_fence(__ATOMIC_ACQUIRE, "agent");
            xb_add(&bar[XB_XGEN(b.x)], 1u);
            asm volatile("s_waitcnt vmcnt(0)" ::: "memory");
        } else {
            XB_SPIN(xb_ld(&bar[XB_XGEN(b.x)]) == gen, bar);
            __builtin_amdgcn_fence(__ATOMIC_ACQUIRE, "agent");
            asm volatile("s_waitcnt vmcnt(0)" ::: "memory");
        }
    }
    __syncthreads();
}
constexpr int NWAVES = 8;
constexpr int BATCH = 8, SEQ = 2048, DM = 1024, M = BATCH * SEQ, DEPTH = 2, NH = 8, HD = 64, AW = 512, CW = 512, CK = 31;
constexpr int NGRP = 4, EPG = 8, NEXP = 32, FF = 512, PLE = 256, WIN = 4608;
constexpr float EPS = 1e-6f;
constexpr float QSCALE = 0.125f * 1.4426950408889634f;
constexpr int MAXROWS = 2 * M + NEXP * 256;
constexpr size_t MiB = 1u << 20;
constexpr size_t WS_CTL = 0, CTL_ZERO_BYTES = 2 * MiB;
constexpr size_t WS_COS = 2 * MiB, WS_SIN = 2 * MiB + 256 * 1024;
constexpr size_t WS_SSQ = 3 * MiB;
constexpr size_t WS_ROUTE = 10 * MiB, WS_POS = 10 * MiB + 512 * 1024, WS_RSC = 11 * MiB, WS_ROWG = 11 * MiB + 256 * 1024;
constexpr size_t WS_WR = 12 * MiB;
constexpr size_t WS_W = 16 * MiB, W_LAYER = 112 * MiB;
constexpr size_t WO_WIN = 0, WO_WAO = 9 * MiB, WO_WCO = 10 * MiB, WO_WOUT = 11 * MiB, WO_WPG = 13 * MiB, WO_WPP = 15 * MiB, WO_WGU = 16 * MiB, WO_WD = 80 * MiB;
constexpr size_t WS_XB = 240 * MiB, WS_PB = 272 * MiB, WS_PE = 288 * MiB, WS_MG = 320 * MiB;
constexpr size_t WS_Q = 352 * MiB, WS_K = 368 * MiB, WS_V = 384 * MiB, WS_U = 400 * MiB, WS_SGA = 416 * MiB, WS_SGB = 448 * MiB, WS_OC = 480 * MiB;
constexpr size_t WS_XG = 352 * MiB, WS_H = 432 * MiB, WS_Y = 352 * MiB, WS_END = 512 * MiB;
constexpr int CW_TMO = 0, CW_CODE = 1, CW_BAR = 4096, CW_CNT = 16384;
constexpr int RING_OFF = 0, RING_BYTES = 131072;
constexpr int LDSCTL_OFF = RING_BYTES, MISC_OFF = LDSCTL_OFF + 320, OFFS_OFF = LDSCTL_OFF + 1024;
constexpr int LDS_BYTES = 147456;
constexpr int PH_PER_LAYER = 10, PH_FINAL = 1 + DEPTH * PH_PER_LAYER, N_PHASES = PH_FINAL + 1;

struct Frame {
    LAS unsigned char* lds;
    volatile LAS unsigned* MISC;
    gu32* ctl;
    int tid, lane, wave, vcu, G;
    float* out; unsigned char* ws;
};
struct Args { const float* in[24]; float* out; unsigned char* ws; int ph_lo, ph_hi, use_bar, pad; };
#define WSP(T, off) ((T*)(F.ws + (off)))

__device__ __forceinline__ void transpose_item(const float* W, int ld, int col0, const float* gain, int k0, bf16* WT, int K, int row0, LAS float* scr, int lane) {
#pragma unroll 8
    for (int i = 0; i < 32; ++i) { const int kk = 2 * i + (lane >> 5); float v = W[(size_t)(k0 + kk) * ld + col0 + (lane & 31)]; if (gain) v *= gain[k0 + kk]; scr[kk * 33 + (lane & 31)] = v; }
    LDS_WAIT(); asm volatile("" ::: "memory");
    const int c = lane & 7;
#pragma unroll
    for (int j = 0; j < 4; ++j) { const int n = (lane >> 3) + 8 * j; const LAS float* s = scr + (8 * c) * 33 + n;
        v4u o; o.x = cvt_pk_bf16(s[0 * 33], s[1 * 33]); o.y = cvt_pk_bf16(s[2 * 33], s[3 * 33]); o.z = cvt_pk_bf16(s[4 * 33], s[5 * 33]); o.w = cvt_pk_bf16(s[6 * 33], s[7 * 33]);
        *(GAS v4u*)(WT + (size_t)(row0 + n) * K + k0 + 8 * c) = o; }
    LDS_WAIT(); asm volatile("" ::: "memory");
}
__device__ __forceinline__ int win_src_col(int g) {
    const int pn = g >> 3, sub = g & 7;
    if (pn < 2) return 64 * (4 * pn + (sub & 3)) + 32 * (sub >> 2);
    if (pn < 4) return 512 + 64 * (4 * (pn - 2) + (sub & 3)) + 32 * (sub >> 2);
    if (pn < 6) return 1024 + 256 * (pn - 4) + 32 * sub;
    if (pn < 10) return (sub < 4 ? 1536 : 2048) + 128 * (pn - 6) + 32 * (sub & 3);
    return 2560 + 256 * (pn - 10) + 32 * sub;
}
constexpr int IT_WIN = 144 * 16, IT_WAO = 32 * 8, IT_WCO = 32 * 8, IT_WOUT = 32 * 16, IT_WPG = 32 * 16, IT_WPP = 32 * 4, IT_WGU = 1024 * 16, IT_WD = 1024 * 8;
constexpr int IT_LAYER = IT_WIN + IT_WAO + IT_WCO + IT_WOUT + IT_WPG + IT_WPP + IT_WGU + IT_WD;
__device__ __forceinline__ void conv_item(Frame& F, const Args& args, int L, int it, LAS float* scr) {
    unsigned char* wl = F.ws + WS_W + (size_t)L * W_LAYER; const int lane = F.lane;
    int r = it;
    if (r < IT_WIN) { const int g = r >> 4, kb = r & 15; transpose_item(args.in[3] + (size_t)L * DM * WIN, WIN, win_src_col(g), args.in[2] + L * DM, 64 * kb, (bf16*)(wl + WO_WIN), 1024, 32 * g, scr, lane); return; } r -= IT_WIN;
    if (r < IT_WAO) { const int g = r >> 3, kb = r & 7; transpose_item(args.in[8] + (size_t)L * 512 * DM, DM, 32 * g, nullptr, 64 * kb, (bf16*)(wl + WO_WAO), 512, 32 * g, scr, lane); return; } r -= IT_WAO;
    if (r < IT_WCO) { const int g = r >> 3, kb = r & 7; transpose_item(args.in[9] + (size_t)L * 512 * DM, DM, 32 * g, nullptr, 64 * kb, (bf16*)(wl + WO_WCO), 512, 32 * g, scr, lane); return; } r -= IT_WCO;
    if (r < IT_WOUT) { const int g = r >> 4, kb = r & 15; transpose_item(args.in[11] + (size_t)L * DM * DM, DM, 32 * g, nullptr, 64 * kb, (bf16*)(wl + WO_WOUT), 1024, 32 * g, scr, lane); return; } r -= IT_WOUT;
    if (r < IT_WPG) { const int g = r >> 4, kb = r & 15; transpose_item(args.in[22] + (size_t)L * DM * DM, DM, 32 * g, args.in[20] + L * DM, 64 * kb, (bf16*)(wl + WO_WPG), 1024, 32 * g, scr, lane); return; } r -= IT_WPG;
    if (r < IT_WPP) { const int g = r >> 2, kb = r & 3; transpose_item(args.in[21] + (size_t)L * PLE * DM, DM, 32 * g, nullptr, 64 * kb, (bf16*)(wl + WO_WPP), 256, 32 * g, scr, lane); return; } r -= IT_WPP;
    if (r < IT_WGU) { const int g = r >> 4, kb = r & 15, e = g >> 5, gl = g & 31, tile = gl >> 3, sub = gl & 7;
        const float* src = (sub < 4 ? args.in[17] : args.in[18]) + ((size_t)L * NEXP + e) * DM * FF;
        transpose_item(src, FF, 128 * tile + 32 * (sub & 3), args.in[12] + L * DM, 64 * kb, (bf16*)(wl + WO_WGU), 1024, 32 * g, scr, lane); return; } r -= IT_WGU;
    { const int g = r >> 3, kb = r & 7, e = g >> 5, gl = g & 31;
        transpose_item(args.in[19] + ((size_t)L * NEXP + e) * FF * DM, DM, 32 * gl, nullptr, 64 * kb, (bf16*)(wl + WO_WD), 512, 32 * g, scr, lane); }
}
__device__ __forceinline__ void p0_prologue(Frame& F, const Args& args) {
    LAS float* scr = (LAS float*)(F.lds + RING_OFF + F.wave * 16384);
    const int gw = F.vcu * NWAVES + F.wave, NGW = F.G * NWAVES, lane = F.lane;
    const int gt = (F.vcu * NWAVES + F.wave) * 64 + lane, NGT = NGW * 64;
    { bf16* XB = WSP(bf16, WS_XB); float* SSQ = WSP(float, WS_SSQ);
      for (int m = gw; m < M; m += NGW) {
          const GAS f32x4* xr = (const GAS f32x4*)(args.in[0] + (size_t)m * DM) + lane; float s = 0.f; GAS v2u* o8 = (GAS v2u*)(XB + (size_t)m * DM) + lane;
#pragma unroll
          for (int j = 0; j < 4; ++j) { const f32x4 v = xr[64 * j]; s += (v[0] * v[0] + v[1] * v[1]) + (v[2] * v[2] + v[3] * v[3]); v2u w; w.x = cvt_pk_bf16(v[0], v[1]); w.y = cvt_pk_bf16(v[2], v[3]); o8[64 * j] = w; }
          const float tot = wave_sum(s);
          if (lane < 16) SSQ[(size_t)m * 16 + lane] = lane == 0 ? tot : 0.f;
      } }
    { const GAS f32x4* ps = (const GAS f32x4*)args.in[1]; GAS v4u* pb = (GAS v4u*)WSP(bf16, WS_PB);
      for (int i = gt; i < DEPTH * M * PLE / 8; i += NGT) { const f32x4 a = ps[2 * i], b = ps[2 * i + 1]; pb[i] = pack8(a, b); } }
    { float* ct = WSP(float, WS_COS); float* st = WSP(float, WS_SIN);
      for (int i = gt; i < SEQ * 32; i += NGT) { const int pos = i >> 5, k = i & 31; const float inv = powf(10000.0f, -(float)(2 * k) / 64.0f); const float ang = (float)pos * inv; ct[i] = cosf(ang); st[i] = sinf(ang); } }
    { bf16* wr = WSP(bf16, WS_WR);
      for (int i = gt; i < DEPTH * 64 * DM; i += NGT) { const int L = i >> 16, j = (i >> 10) & 63, k = i & 1023; float v = 0.f;
          if (j < 4) v = args.in[13][((size_t)L * DM + k) * NGRP + j]; else if (j < 36) v = args.in[15][((size_t)L * DM + k) * NEXP + (j - 4)];
          v *= args.in[12][L * DM + k]; wr[i] = (bf16)(cvt_pk_bf16(v, 0.f) & 0xffffu); } }
    for (int it = gw; it < DEPTH * IT_LAYER; it += NGW) { const int L = it >= IT_LAYER ? 1 : 0; conv_item(F, args, L, it - L * IT_LAYER, scr); }
}

struct SchedGrid {
    int nM, nN, G, c; const char* Ab; const char* Bb; size_t astep, bstep;
    __device__ __forceinline__ bool next(int i, pg8::Unit& u) const {
        const int L = i * G + c; if (L >= nM * nN) return false;
        pg8::tile_of(L, nM, nN, u.pm, u.pn); u.aux = 0; u.A = Ab + (size_t)u.pm * astep; u.B = Bb + (size_t)u.pn * bstep; return true; }
};
struct SchedP3 {
    int G, c; const char* OC; const char* Wa; const char* Wc;
    __device__ __forceinline__ bool next(int i, pg8::Unit& u) const {
        const int T = (i >> 1) * G + c; if (T >= 256) return false;
        pg8::tile_of(T, 64, 4, u.pm, u.pn); u.aux = i & 1;
        u.A = OC + (size_t)u.pm * (256 * 1024 * 2) + (u.aux ? 512 * 2 : 0); u.B = (u.aux ? Wc : Wa) + (size_t)u.pn * (256 * 512 * 2); return true; }
};
struct SchedMoe {
    const volatile LAS int* offs; int G, c, up; const char* Ab; const char* Bb;
    __device__ __forceinline__ bool next(int i, pg8::Unit& u) const {
        const int NB = offs[32] >> 8, L = i * G + c; if (L >= NB * 4) return false;
        const int mb = L >> 2, pn = L & 3; int e = 0;
        while (e < 31 && offs[e + 1] <= mb * 256) ++e;
        u.pm = mb; u.pn = pn; u.aux = e;
        if (up) { u.A = Ab + (size_t)mb * (256 * 1024 * 2); u.B = Bb + ((size_t)e * 1024 + pn * 256) * (1024 * 2); }
        else    { u.A = Ab + (size_t)mb * (256 * 512 * 2);  u.B = Bb + ((size_t)e * 1024 + pn * 256) * (512 * 2); }
        return true; }
};

using pg8::f32x4;
#define EPI_FOR_ROWS _Pragma("unroll") for (int ai = 0; ai < 2; ++ai) _Pragma("unroll") for (int m = 0; m < 4; ++m)
#define EPI_ROW (u.pm * 256 + ai * 128 + wr * 64 + m * 16 + fr)
__device__ __forceinline__ float rscale_of(const float* ssq, int row) {
    const f32x4* sp = (const f32x4*)(ssq + (size_t)row * 16); const f32x4 a = sp[0], b = sp[1], c = sp[2], d = sp[3];
    const float s = ((a[0] + a[1]) + (a[2] + a[3])) + ((b[0] + b[1]) + (b[2] + b[3])) + ((c[0] + c[1]) + (c[2] + c[3])) + ((d[0] + d[1]) + (d[2] + d[3]));
    return rsqrtf(s * (1.0f / DM) + EPS);
}
struct EpiP1 {
    static constexpr bool PERM = true;
    const float* ssq; const float* cosT; const float* sinT; bf16 *Q, *K, *V, *U, *SGA, *SGB;
    __device__ __forceinline__ void operator()(const f32x4 (&acc)[2][2][4][2], const pg8::Unit& u, int wr, int wc, int fr, int fq) const {
        const int pn = u.pn;
        EPI_FOR_ROWS { const int row = EPI_ROW;
            const float r = rscale_of(ssq, row); const int b = row >> 11, t = row & 2047;
            if (pn < 4) {
                const int head = 4 * (pn & 1) + wc; const float qs = pn < 2 ? QSCALE : 1.0f;
                const f32x4* cp = (const f32x4*)(cosT + t * 32 + 8 * fq); const f32x4* sp = (const f32x4*)(sinT + t * 32 + 8 * fq);
                f32x4 o1[2], o2[2];
#pragma unroll
                for (int n = 0; n < 2; ++n) { const f32x4 c = cp[n], s = sp[n], t1 = acc[ai][0][m][n] * (r * qs), t2 = acc[ai][1][m][n] * (r * qs); o1[n] = t1 * c - t2 * s; o2[n] = t1 * s + t2 * c; }
                bf16* dst = (pn < 2 ? Q : K) + ((size_t)(b * NH + head) * SEQ + t) * HD + 8 * fq;
                *(v4u*)dst = pack8(o1[0], o1[1]); *(v4u*)(dst + 32) = pack8(o2[0], o2[1]);
            } else if (pn < 6) {
#pragma unroll
                for (int bj = 0; bj < 2; ++bj) { const int head = 4 * (pn - 4) + 2 * bj + (wc >> 1), dim = 32 * (wc & 1) + 8 * fq;
                    *(v4u*)(V + ((size_t)(b * NH + head) * SEQ + t) * HD + dim) = pack8(acc[ai][bj][m][0] * r, acc[ai][bj][m][1] * r); }
            } else if (pn < 10) {
                f32x4 o[2];
#pragma unroll
                for (int n = 0; n < 2; ++n) o[n] = (acc[ai][0][m][n] * r) * sigm4(acc[ai][1][m][n] * r);
                *(v4u*)(U + (size_t)row * CW + 128 * (pn - 6) + 32 * wc + 8 * fq) = pack8(o[0], o[1]);
            } else {
                bf16* base = (pn < 14 ? SGA + 256 * (pn - 10) : SGB + 256 * (pn - 14)) + (size_t)row * DM + 32 * wc + 8 * fq;
#pragma unroll
                for (int bj = 0; bj < 2; ++bj) *(v4u*)(base + 128 * bj) = pack8(sigm4(acc[ai][bj][m][0] * r), sigm4(acc[ai][bj][m][1] * r));
            }
        }
    }
};
struct EpiP3 {
    static constexpr bool PERM = true;
    const bf16* SGA; const bf16* SGB; const float* bco; bf16* MG;
    __device__ __forceinline__ void operator()(const f32x4 (&acc)[2][2][4][2], const pg8::Unit& u, int wr, int wc, int fr, int fq) const {
        const int kind = u.aux;
        EPI_FOR_ROWS { const int row = EPI_ROW;
#pragma unroll
            for (int bj = 0; bj < 2; ++bj) { const int col = u.pn * 256 + 128 * bj + 32 * wc + 8 * fq; const size_t off = (size_t)row * DM + col;
                f32x4 g0, g1; unpack8(*(const v4u*)((kind ? SGB : SGA) + off), g0, g1);
                f32x4 v0 = acc[ai][bj][m][0], v1 = acc[ai][bj][m][1];
                if (kind) { const f32x4 b0 = *(const f32x4*)(bco + col), b1 = *(const f32x4*)(bco + col + 4); f32x4 p0, p1; unpack8(*(const v4u*)(MG + off), p0, p1); v0 = p0 + g0 * (v0 + b0); v1 = p1 + g1 * (v1 + b1); }
                else { v0 = g0 * v0; v1 = g1 * v1; }
                *(v4u*)(MG + off) = pack8(v0, v1); }
        }
    }
};
#define RESID_STORE(DELTA0, DELTA1) { const f32x4 x0 = *(const f32x4*)(resid + off), x1 = *(const f32x4*)(resid + off + 4); const f32x4 v0 = x0 + (DELTA0), v1 = x1 + (DELTA1); \
        *(f32x4*)(X + off) = v0; *(f32x4*)(X + off + 4) = v1; *(v4u*)(XB + off) = pack8(v0, v1); \
        ss += ((v0[0] * v0[0] + v0[1] * v0[1]) + (v0[2] * v0[2] + v0[3] * v0[3])) + ((v1[0] * v1[0] + v1[1] * v1[1]) + (v1[2] * v1[2] + v1[3] * v1[3])); }
#define SSQ_STORE() { ss += __shfl_xor(ss, 16); ss += __shfl_xor(ss, 32); if (fq == 0) ssq_out[(size_t)row * 16 + u.pn * 4 + wc] = ss; }
struct EpiP4 {
    static constexpr bool PERM = true;
    const float* resid; float* X; bf16* XB; float* ssq_out;
    __device__ __forceinline__ void operator()(const f32x4 (&acc)[2][2][4][2], const pg8::Unit& u, int wr, int wc, int fr, int fq) const {
        EPI_FOR_ROWS { const int row = EPI_ROW;
            float ss = 0.f;
#pragma unroll
            for (int bj = 0; bj < 2; ++bj) { const size_t off = (size_t)row * DM + u.pn * 256 + 128 * bj + 32 * wc + 8 * fq; RESID_STORE(acc[ai][bj][m][0], acc[ai][bj][m][1]) }
            SSQ_STORE()
        }
    }
};
struct EpiP8 {
    static constexpr bool PERM = true;
    const float* ssq_in; const bf16* PE; const float* resid; float* X; bf16* XB; float* ssq_out;
    __device__ __forceinline__ void operator()(const f32x4 (&acc)[2][2][4][2], const pg8::Unit& u, int wr, int wc, int fr, int fq) const {
        EPI_FOR_ROWS { const int row = EPI_ROW;
            const float r = rscale_of(ssq_in, row); float ss = 0.f;
#pragma unroll
            for (int bj = 0; bj < 2; ++bj) { const size_t off = (size_t)row * DM + u.pn * 256 + 128 * bj + 32 * wc + 8 * fq;
                f32x4 p0, p1; unpack8(*(const v4u*)(PE + off), p0, p1);
                RESID_STORE(sigm4(acc[ai][bj][m][0] * r) * p0, sigm4(acc[ai][bj][m][1] * r) * p1) }
            SSQ_STORE()
        }
    }
};
struct EpiBf16 {
    static constexpr bool PERM = true;
    bf16* O; int ldc;
    __device__ __forceinline__ void operator()(const f32x4 (&acc)[2][2][4][2], const pg8::Unit& u, int wr, int wc, int fr, int fq) const {
        EPI_FOR_ROWS { const int row = EPI_ROW;
#pragma unroll
            for (int bj = 0; bj < 2; ++bj) *(v4u*)(O + (size_t)row * ldc + u.pn * 256 + 128 * bj + 32 * wc + 8 * fq) = pack8(acc[ai][bj][m][0], acc[ai][bj][m][1]);
        }
    }
};
struct EpiUp {
    static constexpr bool PERM = true;
    const float* RSC; bf16* H;
    __device__ __forceinline__ void operator()(const f32x4 (&acc)[2][2][4][2], const pg8::Unit& u, int wr, int wc, int fr, int fq) const {
        EPI_FOR_ROWS { const int row = EPI_ROW;
            const float r = RSC[row]; f32x4 o[2];
#pragma unroll
            for (int n = 0; n < 2; ++n) { const f32x4 g = acc[ai][0][m][n] * r; o[n] = g * sigm4(g) * (acc[ai][1][m][n] * r); }
            *(v4u*)(H + (size_t)row * FF + 128 * u.pn + 32 * wc + 8 * fq) = pack8(o[0], o[1]);
        }
    }
};
struct EpiDown {
    static constexpr bool PERM = true;
    const float* ROWG; bf16* Y;
    __device__ __forceinline__ void operator()(const f32x4 (&acc)[2][2][4][2], const pg8::Unit& u, int wr, int wc, int fr, int fq) const {
        EPI_FOR_ROWS { const int row = EPI_ROW;
            const float gt = ROWG[row];
#pragma unroll
            for (int bj = 0; bj < 2; ++bj) *(v4u*)(Y + (size_t)row * DM + u.pn * 256 + 128 * bj + 32 * wc + 8 * fq) = pack8(acc[ai][bj][m][0] * gt, acc[ai][bj][m][1] * gt);
        }
    }
};

__device__ __forceinline__ void attn_simple(Frame& F) {
    const bf16* Q = WSP(bf16, WS_Q); const bf16* Kb = WSP(bf16, WS_K); const bf16* Vb = WSP(bf16, WS_V); bf16* OC = WSP(bf16, WS_OC);
    const int lane = F.lane;
    for (int unit = F.vcu * NWAVES + F.wave; unit < BATCH * NH * (SEQ / 64); unit += F.G * NWAVES) {
        const int bh = unit >> 5, t = ((unit & 31) << 6) + lane;
        unsigned qw[32];
        { const GAS v4u* qp = (const GAS v4u*)(Q + ((size_t)bh * SEQ + t) * HD);
#pragma unroll
          for (int i = 0; i < 8; ++i) { const v4u w = qp[i]; qw[4 * i] = w.x; qw[4 * i + 1] = w.y; qw[4 * i + 2] = w.z; qw[4 * i + 3] = w.w; } }
        float o[64];
#pragma unroll
        for (int i = 0; i < 64; ++i) o[i] = 0.f;
        float mx = -1e30f, l = 0.f;
        for (int g = 0; g < 3; ++g) {
            const int d = g == 0 ? 1 : (g == 1 ? 4 : 16);
            for (int j0 = 0; j0 <= 128; j0 += 4) {
                if (!__any(t - j0 * d >= 0)) break;
                float s[4]; int pc[4];
#pragma unroll
                for (int c = 0; c < 4; ++c) { const int j = j0 + c, pos = t - j * d; const bool valid = pos >= 0 && j <= 128; pc[c] = valid ? pos : t;
                    const GAS v4u* kp = (const GAS v4u*)(Kb + ((size_t)bh * SEQ + pc[c]) * HD); float a = 0.f;
#pragma unroll
                    for (int i = 0; i < 8; ++i) { const v4u w = kp[i]; a = dot2bf(qw[4 * i], w.x, a); a = dot2bf(qw[4 * i + 1], w.y, a); a = dot2bf(qw[4 * i + 2], w.z, a); a = dot2bf(qw[4 * i + 3], w.w, a); }
                    s[c] = valid ? a : -1e30f; }
                const float mc = fmaxf(fmaxf(s[0], s[1]), fmaxf(s[2], s[3])), mn = fmaxf(mx, mc), sc = __builtin_amdgcn_exp2f(mx - mn);
                l *= sc;
#pragma unroll
                for (int i = 0; i < 64; ++i) o[i] *= sc;
                mx = mn;
#pragma unroll
                for (int c = 0; c < 4; ++c) { const float p = __builtin_amdgcn_exp2f(s[c] - mn); l += p;
                    const GAS v4u* vp = (const GAS v4u*)(Vb + ((size_t)bh * SEQ + pc[c]) * HD);
#pragma unroll
                    for (int i = 0; i < 8; ++i) { const v4u w = vp[i];
                        o[8 * i + 0] += p * bf_lo(w.x); o[8 * i + 1] += p * bf_hi(w.x); o[8 * i + 2] += p * bf_lo(w.y); o[8 * i + 3] += p * bf_hi(w.y);
                        o[8 * i + 4] += p * bf_lo(w.z); o[8 * i + 5] += p * bf_hi(w.z); o[8 * i + 6] += p * bf_lo(w.w); o[8 * i + 7] += p * bf_hi(w.w); } }
            }
        }
        const float inv = 1.0f / l; const int b = bh >> 3, h = bh & 7;
        GAS v4u* op = (GAS v4u*)(OC + ((size_t)(b * SEQ + t)) * DM + h * HD);
#pragma unroll
        for (int i = 0; i < 8; ++i) { v4u w; w.x = cvt_pk_bf16(o[8 * i] * inv, o[8 * i + 1] * inv); w.y = cvt_pk_bf16(o[8 * i + 2] * inv, o[8 * i + 3] * inv); w.z = cvt_pk_bf16(o[8 * i + 4] * inv, o[8 * i + 5] * inv); w.w = cvt_pk_bf16(o[8 * i + 6] * inv, o[8 * i + 7] * inv); op[i] = w; }
    }
}
__device__ __forceinline__ void conv_simple(Frame& F, const Args& args, int L) {
    LAS float* ybuf = (LAS float*)(F.lds + RING_OFF); LAS float* stats = ybuf + 16 * 512;
    const bf16* U = WSP(bf16, WS_U); bf16* OC = WSP(bf16, WS_OC);
    const int c = F.tid, lane = F.lane;
    float w[CK];
#pragma unroll
    for (int j = 0; j < CK; ++j) w[j] = args.in[4][((size_t)L * CK + j) * CW + c];
    const float bias = args.in[5][L * CW + c], lg = args.in[6][L * CW + c], lb = args.in[7][L * CW + c];
    for (int unit = F.vcu; unit < M / 16; unit += F.G) {
        const int row0 = unit * 16, t0 = row0 & (SEQ - 1);
        float uu[46];
#pragma unroll
        for (int i = 0; i < 46; ++i) { const int tt = t0 - 30 + i; uu[i] = tt >= 0 ? __uint_as_float((unsigned)U[(size_t)(row0 - 30 + i) * CW + c] << 16) : 0.f; }
        float y[16];
#pragma unroll
        for (int tt = 0; tt < 16; ++tt) { float a = bias;
#pragma unroll
            for (int j = 0; j < CK; ++j) a += w[j] * uu[tt + j];
            y[tt] = a; ybuf[tt * 512 + c] = a; }
        __syncthreads();
#pragma unroll
        for (int q = 0; q < 2; ++q) { const int tt = 2 * F.wave + q; float v[8]; float s = 0.f;
#pragma unroll
            for (int i = 0; i < 8; ++i) { v[i] = ybuf[tt * 512 + lane + 64 * i]; s += v[i]; }
            const float mu = wave_sum(s) * (1.0f / 512.0f); float s2 = 0.f;
#pragma unroll
            for (int i = 0; i < 8; ++i) { const float dd = v[i] - mu; s2 += dd * dd; }
            const float var = wave_sum(s2) * (1.0f / 512.0f);
            if (lane == 0) { stats[2 * tt] = mu; stats[2 * tt + 1] = rsqrtf(var + EPS); } }
        __syncthreads();
#pragma unroll
        for (int tt = 0; tt < 16; ++tt) { const float yn = (y[tt] - stats[2 * tt]) * stats[2 * tt + 1] * lg + lb; const float ov = yn * sigm(yn);
            OC[(size_t)(row0 + tt) * DM + 512 + c] = (bf16)(cvt_pk_bf16(ov, 0.f) & 0xffffu); }
        __syncthreads();
    }
}
__device__ __forceinline__ void route_phase(Frame& F, const Args& args, int L) {
    LAS float* lgs = (LAS float*)(F.lds + RING_OFF) + F.wave * (8 * 40);
    const bf16* XB = WSP(bf16, WS_XB); const float* SSQ = WSP(float, WS_SSQ + (size_t)(3 * L + 1) * MiB); const bf16* WR = WSP(bf16, WS_WR) + (size_t)L * 64 * DM;
    int* ROUTE = WSP(int, WS_ROUTE); unsigned* cnt = (unsigned*)(F.ctl + CW_CNT + 64 * L);
    const int lane = F.lane, gw = F.vcu * NWAVES + F.wave, NGW = F.G * NWAVES;
    int vz = 0; asm volatile("" : "+v"(vz));
    const float bias = lane < 4 ? args.in[14][L * NGRP + lane] : (lane < 36 ? args.in[16][L * NEXP + lane - 4] : 0.f);
    for (int tb = gw; tb < M / 8; tb += NGW) {
        const int t0 = tb * 8;
        const GAS v4u* wp = (const GAS v4u*)(WR + (size_t)lane * DM);
        float a[8];
#pragma unroll
        for (int tt = 0; tt < 8; ++tt) a[tt] = 0.f;
        for (int kc = 0; kc < 128; ++kc) { const v4u w = wp[kc];
#pragma unroll
            for (int tt = 0; tt < 8; ++tt) { const v4u x = *((const GAS v4u*)(XB + (size_t)(t0 + tt) * DM) + kc + vz);
                a[tt] = dot2bf(w.x, x.x, a[tt]); a[tt] = dot2bf(w.y, x.y, a[tt]); a[tt] = dot2bf(w.z, x.z, a[tt]); a[tt] = dot2bf(w.w, x.w, a[tt]); } }
        float rr = 0.f;
#pragma unroll
        for (int tt = 0; tt < 8; ++tt) { const float r = rscale_of(SSQ + vz, t0 + tt); if (lane == tt) rr = r; if (lane < 36) lgs[tt * 40 + lane] = a[tt] * r + bias; }
        LDS_WAIT(); asm volatile("" ::: "memory");
        if (lane < 8) {
            const int t = t0 + lane; const LAS float* lp = lgs + lane * 40;
            float mxv = -1e30f; int gs = 0; float l4[4];
#pragma unroll
            for (int i = 0; i < 4; ++i) { l4[i] = lp[i]; if (l4[i] > mxv) { mxv = l4[i]; gs = i; } }
            float se = 0.f;
#pragma unroll
            for (int i = 0; i < 4; ++i) se += __expf(l4[i] - mxv);
            const float pg = 1.0f / se;
            float v1 = -1e30f, v2 = -1e30f; int i1 = 0, i2 = 0;
#pragma unroll
            for (int i = 0; i < 8; ++i) { const float v = lp[4 + gs * 8 + i]; if (v > v1) { v2 = v1; i2 = i1; v1 = v; i1 = i; } else if (v > v2) { v2 = v; i2 = i; } }
            const float e2 = __expf(v2 - v1), s1 = 1.0f / (1.0f + e2);
            const int ea = gs * 8 + i1, eb = gs * 8 + i2;
            const unsigned ia = atomicAdd(cnt + ea, 1u), ib = atomicAdd(cnt + eb, 1u);
            v4u r0, r1; r0.x = (unsigned)ea; r0.y = (unsigned)eb; r0.z = ia; r0.w = ib; r1.x = __float_as_uint(pg * s1); r1.y = __float_as_uint(pg * e2 * s1); r1.z = __float_as_uint(rr); r1.w = 0u;
            *(GAS v4u*)(ROUTE + (size_t)t * 8) = r0; *(GAS v4u*)(ROUTE + (size_t)t * 8 + 4) = r1;
        }
        LDS_WAIT(); asm volatile("" ::: "memory");
    }
}
__device__ __forceinline__ void moe_offsets(Frame& F, int L) {
    volatile LAS int* offs = (volatile LAS int*)(F.lds + OFFS_OFF);
    __syncthreads();
    if (F.tid == 0) { int acc = 0;
        for (int e = 0; e < NEXP; ++e) { offs[e] = acc; const unsigned c = __hip_atomic_load(F.ctl + CW_CNT + 64 * L + e, RLX_AGENT); acc += (int)((c + 255u) & ~255u); }
        offs[NEXP] = acc; }
    __syncthreads();
}
__device__ __forceinline__ void dispatch_phase(Frame& F, int L) {
    moe_offsets(F, L);
    const volatile LAS int* offs = (const volatile LAS int*)(F.lds + OFFS_OFF);
    const bf16* XB = WSP(bf16, WS_XB); bf16* XG = WSP(bf16, WS_XG); const int* ROUTE = WSP(int, WS_ROUTE); int* POS = WSP(int, WS_POS); float* RSC = WSP(float, WS_RSC); float* ROWG = WSP(float, WS_ROWG);
    const int lane = F.lane, gw = F.vcu * NWAVES + F.wave, NGW = F.G * NWAVES;
    int vz = 0; asm volatile("" : "+v"(vz));
    for (int t = gw; t < M; t += NGW) {
        const v4u r0 = *(const GAS v4u*)(ROUTE + (size_t)t * 8 + vz), r1 = *(const GAS v4u*)(ROUTE + (size_t)t * 8 + 4 + vz);
        const int s0 = offs[r0.x] + (int)r0.z, s1 = offs[r0.y] + (int)r0.w;
        const GAS v4u* src = (const GAS v4u*)(XB + (size_t)t * DM) + lane; const v4u a = src[0], b = src[64];
        GAS v4u* d0 = (GAS v4u*)(XG + (size_t)s0 * DM) + lane; GAS v4u* d1 = (GAS v4u*)(XG + (size_t)s1 * DM) + lane;
        d0[0] = a; d0[64] = b; d1[0] = a; d1[64] = b;
        if (lane == 0) { POS[2 * t] = s0; POS[2 * t + 1] = s1; RSC[s0] = __uint_as_float(r1.z); RSC[s1] = __uint_as_float(r1.z); ROWG[s0] = __uint_as_float(r1.x); ROWG[s1] = __uint_as_float(r1.y); }
    }
}
__device__ __forceinline__ void combine_phase(Frame& F, int L) {
    float* X = F.out; bf16* XB = WSP(bf16, WS_XB); const bf16* Y = WSP(bf16, WS_Y); const int* POS = WSP(int, WS_POS); float* SSQ = WSP(float, WS_SSQ + (size_t)(3 * L + 2) * MiB);
    const int lane = F.lane, gw = F.vcu * NWAVES + F.wave, NGW = F.G * NWAVES;
    int vz = 0; asm volatile("" : "+v"(vz));
    for (int t = gw; t < M; t += NGW) {
        const int s0 = POS[2 * t + vz], s1 = POS[2 * t + 1 + vz];
        GAS f32x4* xr = (GAS f32x4*)(X + (size_t)t * DM) + lane; const GAS v2u* y0 = (const GAS v2u*)(Y + (size_t)s0 * DM) + lane; const GAS v2u* y1 = (const GAS v2u*)(Y + (size_t)s1 * DM) + lane;
        GAS v2u* xb = (GAS v2u*)(XB + (size_t)t * DM) + lane; float s = 0.f;
#pragma unroll
        for (int j = 0; j < 4; ++j) { f32x4 v = xr[64 * j]; const v2u a = y0[64 * j], b = y1[64 * j];
            v[0] += bf_lo(a.x) + bf_lo(b.x); v[1] += bf_hi(a.x) + bf_hi(b.x); v[2] += bf_lo(a.y) + bf_lo(b.y); v[3] += bf_hi(a.y) + bf_hi(b.y);
            xr[64 * j] = v; v2u w; w.x = cvt_pk_bf16(v[0], v[1]); w.y = cvt_pk_bf16(v[2], v[3]); xb[64 * j] = w;
            s += (v[0] * v[0] + v[1] * v[1]) + (v[2] * v[2] + v[3] * v[3]); }
        const float tot = wave_sum(s);
        if (lane < 16) SSQ[(size_t)t * 16 + lane] = lane == 0 ? tot : 0.f;
    }
}
__device__ __forceinline__ void final_norm_phase(Frame& F, const Args& args) {
    float* X = F.out; const float* g = args.in[23];
    const int lane = F.lane, gw = F.vcu * NWAVES + F.wave, NGW = F.G * NWAVES;
    for (int t = gw; t < M; t += NGW) {
        GAS f32x4* xr = (GAS f32x4*)(X + (size_t)t * DM) + lane; f32x4 v[4]; float s = 0.f;
#pragma unroll
        for (int j = 0; j < 4; ++j) { v[j] = xr[64 * j]; s += (v[j][0] * v[j][0] + v[j][1] * v[j][1]) + (v[j][2] * v[j][2] + v[j][3] * v[j][3]); }
        const float r = rsqrtf(wave_sum(s) * (1.0f / DM) + EPS);
#pragma unroll
        for (int j = 0; j < 4; ++j) { const f32x4 gv = *((const f32x4*)g + lane + 64 * j); xr[64 * j] = v[j] * r * gv; }
    }
}
#ifdef MK_REFGEMM
#define GEMM_BODY gemm_phase_ref
#else
#define GEMM_BODY gemm_phase
#endif
#ifndef MK_EN
#define MK_EN 0xfff
#endif
__global__ void __launch_bounds__(NWAVES * 64, 2) mk_fwd(Args args) {
    extern __shared__ __attribute__((aligned(16))) unsigned char lds[];
    Frame F;
    F.lds = (LAS unsigned char*)lds;
    F.MISC = (volatile LAS unsigned*)(F.lds + MISC_OFF);
    F.tid = threadIdx.x; F.lane = F.tid & 63; F.wave = __builtin_amdgcn_readfirstlane(F.tid >> 6);
    F.G = gridDim.x; { const int bx = blockIdx.x; F.vcu = (F.G % 8 == 0) ? (bx % 8) * (F.G / 8) + bx / 8 : bx; }
    F.ws = args.ws; F.out = args.out; F.ctl = (gu32*)(args.ws + WS_CTL);
    for (int u = F.tid; u < (LDS_BYTES - LDSCTL_OFF) / 4; u += NWAVES * 64) ((LAS unsigned*)(F.lds + LDSCTL_OFF))[u] = 0u;
    __syncthreads();
    XcdBarrier bar; bar.bar = (unsigned*)(F.ctl + CW_BAR); bar.x = 0; bar.st = nullptr;
    if (args.use_bar) bar = xcd_barrier_post((unsigned*)(F.ctl + CW_BAR), F.MISC + 8);
    const int cblk = (int)blockIdx.x;
#define PHASE_SEAM(ph_) do { if ((ph_) + 1 < args.ph_hi) { if (args.use_bar) { xcd_barrier(bar); } else { VM_WAIT(); __syncthreads(); } } } while (0)
    int ph0 = args.ph_lo;
    if (ph0 == 0 && (MK_EN & 1)) { p0_prologue(F, args); PHASE_SEAM(0); ph0 = 1; }
    for (int ph = ph0; ph < args.ph_hi; ++ph) {
        { int t_ = threadIdx.x; asm volatile("" : "+v"(t_)); F.tid = t_; F.lane = t_ & 63; F.wave = __builtin_amdgcn_readfirstlane(t_ >> 6); }
        if (ph == PH_FINAL && (MK_EN & 2)) {
            final_norm_phase(F, args);
        } else {
            const int L = (ph - 1) / PH_PER_LAYER, sub = (ph - 1) % PH_PER_LAYER;
            const char* wl = (const char*)(F.ws + WS_W + (size_t)L * W_LAYER);
            float* SSQ0 = WSP(float, WS_SSQ + (size_t)(3 * L) * MiB);
            if (sub == 0 && (MK_EN & (4 << 0))) {
                SchedGrid S{64, 18, F.G, cblk, (const char*)WSP(bf16, WS_XB), wl + WO_WIN, (size_t)256 * 1024 * 2, (size_t)256 * 1024 * 2};
                EpiP1 E{SSQ0, WSP(float, WS_COS), WSP(float, WS_SIN), WSP(bf16, WS_Q), WSP(bf16, WS_K), WSP(bf16, WS_V), WSP(bf16, WS_U), WSP(bf16, WS_SGA), WSP(bf16, WS_SGB)};
                pg8::GEMM_BODY<EpiP1, SchedGrid, true>(F.lds + RING_OFF, pg8::Dims{1024, 1024, 1024}, S, E);
            } else if (sub == 1 && (MK_EN & (4 << 1))) {
                attn_simple(F);
                conv_simple(F, args, L);
            } else if (sub == 2 && (MK_EN & (4 << 2))) {
                SchedP3 S{F.G, cblk, (const char*)WSP(bf16, WS_OC), wl + WO_WAO, wl + WO_WCO};
                EpiP3 E{WSP(bf16, WS_SGA), WSP(bf16, WS_SGB), args.in[10] + L * DM, WSP(bf16, WS_MG)};
                pg8::GEMM_BODY<EpiP3, SchedP3, true>(F.lds + RING_OFF, pg8::Dims{512, 1024, 512}, S, E);
            } else if (sub == 3 && (MK_EN & (4 << 3))) {
                SchedGrid S{64, 4, F.G, cblk, (const char*)WSP(bf16, WS_MG), wl + WO_WOUT, (size_t)256 * 1024 * 2, (size_t)256 * 1024 * 2};
                EpiP4 E{L == 0 ? args.in[0] : F.out, F.out, WSP(bf16, WS_XB), WSP(float, WS_SSQ + (size_t)(3 * L + 1) * MiB)};
                pg8::GEMM_BODY<EpiP4, SchedGrid, false>(F.lds + RING_OFF, pg8::Dims{1024, 1024, 1024}, S, E);
            } else if (sub == 4 && (MK_EN & (4 << 4))) {
                route_phase(F, args, L);
                __syncthreads();
                SchedGrid S{64, 4, F.G, cblk, (const char*)(WSP(bf16, WS_PB) + (size_t)L * M * PLE), wl + WO_WPP, (size_t)256 * 256 * 2, (size_t)256 * 256 * 2};
                EpiBf16 E{WSP(bf16, WS_PE), DM};
                pg8::GEMM_BODY<EpiBf16, SchedGrid, false>(F.lds + RING_OFF, pg8::Dims{256, 256, 256}, S, E);
            } else if (sub == 5 && (MK_EN & (4 << 5))) {
                dispatch_phase(F, L);
            } else if (sub == 6 && (MK_EN & (4 << 6))) {
                moe_offsets(F, L);
                SchedMoe S{(const volatile LAS int*)(F.lds + OFFS_OFF), F.G, cblk, 1, (const char*)WSP(bf16, WS_XG), wl + WO_WGU};
                EpiUp E{WSP(float, WS_RSC), WSP(bf16, WS_H)};
                pg8::GEMM_BODY<EpiUp, SchedMoe, true>(F.lds + RING_OFF, pg8::Dims{1024, 1024, 1024}, S, E);
            } else if (sub == 7 && (MK_EN & (4 << 7))) {
                moe_offsets(F, L);
                SchedMoe S{(const volatile LAS int*)(F.lds + OFFS_OFF), F.G, cblk, 0, (const char*)WSP(bf16, WS_H), wl + WO_WD};
                EpiDown E{WSP(float, WS_ROWG), WSP(bf16, WS_Y)};
                pg8::GEMM_BODY<EpiDown, SchedMoe, true>(F.lds + RING_OFF, pg8::Dims{512, 512, 512}, S, E);
            } else if (sub == 8 && (MK_EN & (4 << 8))) {
                combine_phase(F, L);
            } else if (MK_EN & (4 << 9)) {
                SchedGrid S{64, 4, F.G, cblk, (const char*)WSP(bf16, WS_XB), wl + WO_WPG, (size_t)256 * 1024 * 2, (size_t)256 * 1024 * 2};
                EpiP8 E{WSP(float, WS_SSQ + (size_t)(3 * L + 2) * MiB), WSP(bf16, WS_PE), F.out, F.out, WSP(bf16, WS_XB), WSP(float, WS_SSQ + (size_t)(3 * L + 3) * MiB)};
                pg8::GEMM_BODY<EpiP8, SchedGrid, false>(F.lds + RING_OFF, pg8::Dims{1024, 1024, 1024}, S, E);
            }
        }
        PHASE_SEAM(ph);
    }
}

#ifndef MK_OPT_PHASES
#define MK_OPT_PHASES 22
#endif
#ifndef MK_REPEAT
#define MK_REPEAT 1
#endif
#ifndef MK_SINGLE
#define MK_SINGLE 0
#endif
#if MK_OPT_PHASES < 22
static void naive_tail(hipStream_t stream, void* const* d_in, float* X, float* out, char* ws, int L0, int st0) {
    using namespace naive;
    const float* p = (const float*)d_in[1]; const float* norm_mix = (const float*)d_in[2]; const float* w_in = (const float*)d_in[3];
    const float* w_dw = (const float*)d_in[4]; const float* b_dw = (const float*)d_in[5]; const float* ln_g = (const float*)d_in[6]; const float* ln_b = (const float*)d_in[7];
    const float* w_ao = (const float*)d_in[8]; const float* w_co = (const float*)d_in[9]; const float* b_co = (const float*)d_in[10]; const float* w_out = (const float*)d_in[11];
    const float* norm_ffn = (const float*)d_in[12]; const float* w_rg = (const float*)d_in[13]; const float* b_rg = (const float*)d_in[14]; const float* w_re = (const float*)d_in[15]; const float* b_re = (const float*)d_in[16];
    const float* w_eg = (const float*)d_in[17]; const float* w_eu = (const float*)d_in[18]; const float* w_ed = (const float*)d_in[19];
    const float* norm_ple = (const float*)d_in[20]; const float* w_pp = (const float*)d_in[21]; const float* w_pg = (const float*)d_in[22]; const float* norm_final = (const float*)d_in[23];
    constexpr size_t MiB_ = 1u << 20;
    float* Hn = (float*)(ws + 0 * MiB_); float* QKV = (float*)(ws + 64 * MiB_); float* CUG = (float*)(ws + 160 * MiB_); float* GAB = (float*)(ws + 224 * MiB_);
    float* AO = (float*)(ws + 352 * MiB_); float* CO = (float*)(ws + 384 * MiB_);
    float* YA = Hn; float* YB = QKV;
    float* LG = CUG; float* LE = CUG + (size_t)M_ * 4; int* EID = (int*)(CUG + (size_t)M_ * 40); float* GT = CUG + (size_t)M_ * 48;
    float* GL = GAB; float* PE = QKV;
    for (int L = L0; L < DEPTH_; ++L) {
        const int s0 = (L == L0) ? st0 : 0;
        if (s0 <= 0) {
            hipLaunchKernelGGL(rmsnorm_k, dim3(M_ / 4), dim3(256), 0, stream, X, norm_mix + L * D_, Hn);
            const float* win = w_in + (size_t)L * D_ * WIN_;
            sgemm(stream, Hn, D_, win, WIN_, QKV, 1536, M_, 1536, D_, nullptr, nullptr);
            sgemm(stream, Hn, D_, win + 1536, WIN_, CUG, 1024, M_, 1024, D_, nullptr, nullptr);
            sgemm(stream, Hn, D_, win + 2560, WIN_, GAB, 2048, M_, 2048, D_, nullptr, nullptr);
            hipLaunchKernelGGL(rope_k, dim3(M_ * 2 * H_ * 32 / 256), dim3(256), 0, stream, QKV);
            hipLaunchKernelGGL(attn_naive_k, dim3(M_ * H_ / 4), dim3(256), 0, stream, QKV, AO);
            hipLaunchKernelGGL(conv_naive_k, dim3(M_), dim3(512), 0, stream, CUG, w_dw + (size_t)L * CK_ * CW_, b_dw + L * CW_, ln_g + L * CW_, ln_b + L * CW_, CO);
            sgemm(stream, AO, 512, w_ao + (size_t)L * 512 * D_, D_, YA, D_, M_, D_, 512, nullptr, nullptr);
            sgemm(stream, CO, 512, w_co + (size_t)L * 512 * D_, D_, YB, D_, M_, D_, 512, b_co + L * D_, nullptr);
            hipLaunchKernelGGL(merge_k, dim3(M_ * D_ / 256), dim3(256), 0, stream, GAB, YA, YB);
            sgemm(stream, GAB, 2048, w_out + (size_t)L * D_ * D_, D_, X, D_, M_, D_, D_, nullptr, X);
        }
        if (s0 <= 1) {
            hipLaunchKernelGGL(rmsnorm_k, dim3(M_ / 4), dim3(256), 0, stream, X, norm_ffn + L * D_, Hn);
            sgemm(stream, Hn, D_, w_rg + (size_t)L * D_ * NG_, NG_, LG, 4, M_, 4, D_, b_rg + L * NG_, nullptr);
            sgemm(stream, Hn, D_, w_re + (size_t)L * D_ * NE_, NE_, LE, 32, M_, 32, D_, b_re + L * NE_, nullptr);
            hipLaunchKernelGGL(route_k, dim3(M_ / 256), dim3(256), 0, stream, LG, LE, EID, GT);
            hipLaunchKernelGGL(moe_naive_k, dim3(M_), dim3(256), 0, stream, Hn, EID, GT, w_eg + (size_t)L * NE_ * D_ * FF_, w_eu + (size_t)L * NE_ * D_ * FF_, w_ed + (size_t)L * NE_ * FF_ * D_, X);
        }
        if (s0 <= 2) {
            hipLaunchKernelGGL(rmsnorm_k, dim3(M_ / 4), dim3(256), 0, stream, X, norm_ple + L * D_, Hn);
            sgemm(stream, Hn, D_, w_pg + (size_t)L * D_ * D_, D_, GL, D_, M_, D_, D_, nullptr, nullptr);
            sgemm(stream, p + (size_t)L * M_ * PLE_, PLE_, w_pp + (size_t)L * PLE_ * D_, D_, PE, D_, M_, D_, PLE_, nullptr, nullptr);
            hipLaunchKernelGGL(ple_k, dim3(M_ * D_ / 256), dim3(256), 0, stream, X, GL, PE);
        }
    }
    hipLaunchKernelGGL(rmsnorm_k, dim3(M_ / 4), dim3(256), 0, stream, X, norm_final, out);
}
#endif


#if MK_OPT_PHASES < 22
namespace dbg {
__device__ __forceinline__ float b2f(unsigned short u) { return __uint_as_float((unsigned)u << 16); }
__global__ void __launch_bounds__(256) cvt_qkv_k(const unsigned short* Q, const unsigned short* K, const unsigned short* V, float* qkv) {
    const size_t idx = (size_t)blockIdx.x * 256 + threadIdx.x;
    const int tok = (int)(idx >> 9), col = (int)(idx & 511), h = col >> 6, d = col & 63, b = tok >> 11, t = tok & 2047;
    const size_t src = ((size_t)(b * 8 + h) * 2048 + t) * 64 + d;
    qkv[(size_t)tok * 1536 + col] = b2f(Q[src]) * (1.0f / (0.125f * 1.4426950408889634f));
    qkv[(size_t)tok * 1536 + 512 + col] = b2f(K[src]);
    qkv[(size_t)tok * 1536 + 1024 + col] = b2f(V[src]);
}
__global__ void __launch_bounds__(512) conv_from_u_k(const unsigned short* __restrict__ U, const float* __restrict__ wdw, const float* __restrict__ bdw,
                                                     const float* __restrict__ lg, const float* __restrict__ lb, float* __restrict__ co) {
    __shared__ float red[16];
    const int tok = blockIdx.x, c = threadIdx.x, t = tok % 2048;
    float y = bdw[c];
    for (int j = 0; j < 31; ++j) { const int tt = t - 30 + j; if (tt >= 0) y += wdw[j * 512 + c] * b2f(U[(size_t)(tok - 30 + j) * 512 + c]); }
    float s = naive::wave_sum(y);
    if ((c & 63) == 0) red[c >> 6] = s;
    __syncthreads();
    float mu = 0.f;
    for (int i = 0; i < 8; ++i) mu += red[i];
    mu *= (1.f / 512.f);
    const float dv = y - mu;
    float s2 = naive::wave_sum(dv * dv);
    if ((c & 63) == 0) red[8 + (c >> 6)] = s2;
    __syncthreads();
    float var = 0.f;
    for (int i = 0; i < 8; ++i) var += red[8 + i];
    var *= (1.f / 512.f);
    const float yn = dv * rsqrtf(var + 1e-6f) * lg[c] + lb[c];
    co[(size_t)tok * 512 + c] = yn / (1.f + expf(-yn));
}
__global__ void __launch_bounds__(256) merge_sig_k(const unsigned short* sga, const unsigned short* sgb, const float* ya, const float* yb, float* mg) {
    const size_t idx = (size_t)blockIdx.x * 256 + threadIdx.x;
    mg[idx] = b2f(sga[idx]) * ya[idx] + b2f(sgb[idx]) * yb[idx];
}
__global__ void __launch_bounds__(256) cvt_oc_k(const unsigned short* oc, float* ao, float* co) {
    const size_t idx = (size_t)blockIdx.x * 256 + threadIdx.x;
    const size_t m = idx >> 10; const int n = (int)(idx & 1023);
    const float v = b2f(oc[idx]);
    if (n < 512) ao[m * 512 + n] = v; else co[m * 512 + n - 512] = v;
}
__global__ void __launch_bounds__(256) cvt_bf_k(const unsigned short* src, float* dst) {
    const size_t idx = (size_t)blockIdx.x * 256 + threadIdx.x; dst[idx] = b2f(src[idx]);
}
}
static void dbg_mixer_tail(hipStream_t stream, void* const* d_in, float* X, char* ws, int nopt) {
    using namespace naive;
    constexpr size_t MiB_ = 1u << 20;
    const float* w_dw = (const float*)d_in[4]; const float* b_dw = (const float*)d_in[5]; const float* ln_g = (const float*)d_in[6]; const float* ln_b = (const float*)d_in[7];
    const float* w_ao = (const float*)d_in[8]; const float* w_co = (const float*)d_in[9]; const float* b_co = (const float*)d_in[10]; const float* w_out = (const float*)d_in[11];
    float* Hn = (float*)(ws + 0 * MiB_); float* QKV = (float*)(ws + 64 * MiB_); float* YBb = (float*)(ws + 160 * MiB_); float* MGf = (float*)(ws + 224 * MiB_);
    float* AO = (float*)(ws + 288 * MiB_); float* CO = (float*)(ws + 320 * MiB_);
    const unsigned short* Qb = (const unsigned short*)(ws + WS_Q); const unsigned short* Kb = (const unsigned short*)(ws + WS_K); const unsigned short* Vb = (const unsigned short*)(ws + WS_V);
    const unsigned short* Ub = (const unsigned short*)(ws + WS_U); const unsigned short* SGAb = (const unsigned short*)(ws + WS_SGA); const unsigned short* SGBb = (const unsigned short*)(ws + WS_SGB);
    const unsigned short* OCb = (const unsigned short*)(ws + WS_OC); const unsigned short* MGb = (const unsigned short*)(ws + WS_MG);
    (void)hipMemcpyAsync(X, d_in[0], (size_t)M_ * D_ * 4, hipMemcpyDeviceToDevice, stream);
    if (nopt == 2) {
        hipLaunchKernelGGL(dbg::cvt_qkv_k, dim3(M_ * 512 / 256), dim3(256), 0, stream, Qb, Kb, Vb, QKV);
        hipLaunchKernelGGL(attn_naive_k, dim3(M_ * H_ / 4), dim3(256), 0, stream, QKV, AO);
        hipLaunchKernelGGL(dbg::conv_from_u_k, dim3(M_), dim3(512), 0, stream, Ub, w_dw, b_dw, ln_g, ln_b, CO);
    } else if (nopt == 3) {
        hipLaunchKernelGGL(dbg::cvt_oc_k, dim3(M_ * D_ / 256), dim3(256), 0, stream, OCb, AO, CO);
    }
    if (nopt <= 3) {
        sgemm(stream, AO, 512, w_ao, D_, Hn, D_, M_, D_, 512, nullptr, nullptr);
        sgemm(stream, CO, 512, w_co, D_, YBb, D_, M_, D_, 512, b_co, nullptr);
        hipLaunchKernelGGL(dbg::merge_sig_k, dim3(M_ * D_ / 256), dim3(256), 0, stream, SGAb, SGBb, Hn, YBb, MGf);
    } else {
        hipLaunchKernelGGL(dbg::cvt_bf_k, dim3(M_ * D_ / 256), dim3(256), 0, stream, MGb, MGf);
    }
    sgemm(stream, MGf, D_, w_out, D_, X, D_, M_, D_, D_, nullptr, X);
}
#endif

#if MK_OPT_PHASES < 22
namespace dbg {
__global__ void __launch_bounds__(256) hash_k(const unsigned* buf, size_t nwords, unsigned* out) {
    unsigned acc = 0u;
    for (size_t i = (size_t)blockIdx.x * 256 + threadIdx.x; i < nwords; i += (size_t)gridDim.x * 256) acc += buf[i] * (2654435761u * (unsigned)(2 * i + 1)) + (unsigned)i;
    for (int o = 1; o < 64; o <<= 1) acc += __shfl_xor(acc, o);
    if ((threadIdx.x & 63) == 0) atomicAdd(out, acc);
}
__global__ void __launch_bounds__(256) perturb_k(float* out, size_t first, size_t count, const unsigned* hash) {
    const size_t i = (size_t)blockIdx.x * 256 + threadIdx.x;
    if (i < count) out[first + i] += (float)(hash[0] >> 8) * (1.0f / 16777216.0f);
}
}
static void dbg_hash(hipStream_t st, const void* buf, size_t bytes, unsigned* cell) { hipLaunchKernelGGL(dbg::hash_k, dim3(1024), dim3(256), 0, st, (const unsigned*)buf, bytes / 4, cell); }
#endif

#if MK_OPT_PHASES < 22
#ifndef DBG_USE
#define DBG_USE 7
#endif
static void dbg_p1_tail(hipStream_t stream, void* const* d_in, float* X, char* ws) {
    using namespace naive;
    constexpr size_t MiB_ = 1u << 20;
    const float* norm_mix = (const float*)d_in[2]; const float* w_in = (const float*)d_in[3];
    const float* w_dw = (const float*)d_in[4]; const float* b_dw = (const float*)d_in[5]; const float* ln_g = (const float*)d_in[6]; const float* ln_b = (const float*)d_in[7];
    const float* w_ao = (const float*)d_in[8]; const float* w_co = (const float*)d_in[9]; const float* b_co = (const float*)d_in[10]; const float* w_out = (const float*)d_in[11];
    float* Hn = (float*)(ws + 0 * MiB_); float* QKV = (float*)(ws + 64 * MiB_); float* CUG = (float*)(ws + 160 * MiB_); float* GAB = (float*)(ws + 224 * MiB_);
    float* AO = (float*)(ws + 480 * MiB_); float* CO = (float*)(ws + 64 * MiB_); float* YA = Hn; float* YB = (float*)(ws + 96 * MiB_); float* MGf = (float*)(ws + 160 * MiB_);
    const unsigned short* Qb = (const unsigned short*)(ws + WS_Q); const unsigned short* Kb = (const unsigned short*)(ws + WS_K); const unsigned short* Vb = (const unsigned short*)(ws + WS_V);
    const unsigned short* Ub = (const unsigned short*)(ws + WS_U); const unsigned short* SGAb = (const unsigned short*)(ws + WS_SGA); const unsigned short* SGBb = (const unsigned short*)(ws + WS_SGB);
    (void)hipMemcpyAsync(X, d_in[0], (size_t)M_ * D_ * 4, hipMemcpyDeviceToDevice, stream);
    hipLaunchKernelGGL(rmsnorm_k, dim3(M_ / 4), dim3(256), 0, stream, X, norm_mix, Hn);
    if (DBG_USE & 1) hipLaunchKernelGGL(dbg::cvt_qkv_k, dim3(M_ * 512 / 256), dim3(256), 0, stream, Qb, Kb, Vb, QKV);
    else { sgemm(stream, Hn, D_, w_in, WIN_, QKV, 1536, M_, 1536, D_, nullptr, nullptr); hipLaunchKernelGGL(rope_k, dim3(M_ * 2 * H_ * 32 / 256), dim3(256), 0, stream, QKV); }
    if (!(DBG_USE & 2)) sgemm(stream, Hn, D_, w_in + 1536, WIN_, CUG, 1024, M_, 1024, D_, nullptr, nullptr);
    if (!(DBG_USE & 4)) sgemm(stream, Hn, D_, w_in + 2560, WIN_, GAB, 2048, M_, 2048, D_, nullptr, nullptr);
    hipLaunchKernelGGL(attn_naive_k, dim3(M_ * H_ / 4), dim3(256), 0, stream, QKV, AO);
    if (DBG_USE & 2) hipLaunchKernelGGL(dbg::conv_from_u_k, dim3(M_), dim3(512), 0, stream, Ub, w_dw, b_dw, ln_g, ln_b, CO);
    else hipLaunchKernelGGL(conv_naive_k, dim3(M_), dim3(512), 0, stream, CUG, w_dw, b_dw, ln_g, ln_b, CO);
    sgemm(stream, AO, 512, w_ao, D_, YA, D_, M_, D_, 512, nullptr, nullptr);
    sgemm(stream, CO, 512, w_co, D_, YB, D_, M_, D_, 512, b_co, nullptr);
    if (DBG_USE & 4) { hipLaunchKernelGGL(dbg::merge_sig_k, dim3(M_ * D_ / 256), dim3(256), 0, stream, SGAb, SGBb, YA, YB, MGf); sgemm(stream, MGf, D_, w_out, D_, X, D_, M_, D_, D_, nullptr, X); }
    else { hipLaunchKernelGGL(merge_k, dim3(M_ * D_ / 256), dim3(256), 0, stream, GAB, YA, YB); sgemm(stream, GAB, 2048, w_out, D_, X, D_, M_, D_, D_, nullptr, X); }
}
#endif

extern "C" void kernel_launch(void* const* d_in, const int* in_sizes, int n_in, void* d_out, int out_size, void* d_ws, size_t ws_size, hipStream_t stream) {
    static int grid = 0;
    if (grid == 0) {
        if (n_in != 24 || in_sizes[0] != M * DM || out_size != M * DM || ws_size < WS_END) { fprintf(stderr, "kernel_launch: unexpected shapes (n_in %d, in0 %d, out %d, ws %zu); nothing launched\n", n_in, n_in > 0 ? in_sizes[0] : -1, out_size, ws_size); grid = -1; return; }
        int dev = 0, cus = 0, per_cu = 0;
        if (hipGetDevice(&dev) != hipSuccess || hipDeviceGetAttribute(&cus, hipDeviceAttributeMultiprocessorCount, dev) != hipSuccess) { fprintf(stderr, "kernel_launch: device query failed\n"); grid = -1; return; }
        if (hipFuncSetAttribute((const void*)mk_fwd, hipFuncAttributeMaxDynamicSharedMemorySize, LDS_BYTES) != hipSuccess) { fprintf(stderr, "kernel_launch: hipFuncSetAttribute failed\n"); grid = -1; return; }
        if (hipOccupancyMaxActiveBlocksPerMultiprocessor(&per_cu, (const void*)mk_fwd, NWAVES * 64, LDS_BYTES) != hipSuccess || per_cu < 1) { fprintf(stderr, "kernel_launch: occupancy query reports %d blocks per CU\n", per_cu); }
        (void)hipGetLastError();
        grid = cus;
    }
    if (grid < 0) return;
    (void)hipMemsetAsync((char*)d_ws + WS_CTL, 0, CTL_ZERO_BYTES, stream);
    Args a{};
    for (int i = 0; i < 24; ++i) a.in[i] = (const float*)d_in[i];
    a.out = (float*)d_out; a.ws = (unsigned char*)d_ws;
    constexpr int NOPT = MK_OPT_PHASES;
#if MK_SINGLE
    a.ph_lo = 0; a.ph_hi = NOPT; a.use_bar = 1;
    hipLaunchKernelGGL(mk_fwd, dim3(grid), dim3(NWAVES * 64), LDS_BYTES, stream, a);
#else
    for (int rep = 0; rep < MK_REPEAT; ++rep)
    for (int ph = 0; ph < NOPT; ++ph) { a.ph_lo = ph; a.ph_hi = ph + 1; a.use_bar = 0; hipLaunchKernelGGL(mk_fwd, dim3(grid), dim3(NWAVES * 64), LDS_BYTES, stream, a); }
#endif
#if defined(MK_PROBE)
    {
        constexpr size_t MiB_ = 1u << 20; char* ws = (char*)d_ws; unsigned* cells = (unsigned*)(ws + 520 * MiB_);
        (void)hipMemsetAsync(cells, 0, 256, stream);
        MK_PROBE
        (void)hipMemcpyAsync(d_out, d_in[0], (size_t)M * DM * 4, hipMemcpyDeviceToDevice, stream);
        naive_tail(stream, d_in, (float*)d_out, (float*)d_out, (char*)d_ws, 0, 0);
        hipLaunchKernelGGL(dbg::perturb_k, dim3((1u << 22) / 256), dim3(256), 0, stream, (float*)d_out, (size_t)0, (size_t)1 << 22, cells);
        hipLaunchKernelGGL(dbg::perturb_k, dim3((1u << 16) / 256), dim3(256), 0, stream, (float*)d_out, (size_t)1 << 23, (size_t)1 << 16, cells + 16);
    }
#elif MK_OPT_PHASES < 22
    {
        int L0 = 0, st0 = 0;
        if (NOPT <= 1) { (void)hipMemcpyAsync(d_out, d_in[0], (size_t)M * DM * 4, hipMemcpyDeviceToDevice, stream); }
        else if (NOPT == 2) { dbg_p1_tail(stream, d_in, (float*)d_out, (char*)d_ws); L0 = 0; st0 = 1; }
        else if (NOPT >= 3 && NOPT <= 4) { dbg_mixer_tail(stream, d_in, (float*)d_out, (char*)d_ws, NOPT); L0 = 0; st0 = 1; }
        else if (NOPT == 5) { L0 = 0; st0 = 1; } else if (NOPT == 10) { L0 = 0; st0 = 2; } else if (NOPT == 11) { L0 = 1; st0 = 0; }
        else if (NOPT == 15) { L0 = 1; st0 = 1; } else if (NOPT == 20) { L0 = 1; st0 = 2; } else if (NOPT == 21) { L0 = 2; st0 = 0; }
        naive_tail(stream, d_in, (float*)d_out, (float*)d_out, (char*)d_ws, L0, st0);
    }
#endif
}
```

```cpp
#define MK_OPT_PHASES 22
#define MK_SINGLE 1
#include <hip/hip_runtime.h>
#include <cstdio>
#include <cstdint>
#include <cmath>
namespace pg8 {
#define PG8_LAS __attribute__((address_space(3)))
typedef unsigned short bf16_t;
typedef short bf16x8 __attribute__((ext_vector_type(8)));
typedef float f32x4 __attribute__((ext_vector_type(4)));
typedef float f32x2 __attribute__((ext_vector_type(2)));
typedef unsigned u32x4 __attribute__((ext_vector_type(4)));
typedef unsigned u32x2 __attribute__((ext_vector_type(2)));
constexpr int BM = 256, BK = 64, HALF = 128, HTB = HALF * BK * 2  , STAGE_BYTES = 8 * HTB, NXCD = 8, WGM = 8;

__host__ __device__ __forceinline__ int lds_byte(int r, int c) { const int st = (r >> 4) * 2 + (c >> 5), rr = r & 15, cc = c & 31, ob = rr * 64 + cc * 2; return st * 1024 + (ob ^ (((ob >> 9) & 1) << 5)); }
__host__ __device__ __forceinline__ void stage_rc(int b, int& R, int& C) { const int st = b / 1024, sb = b % 1024, swz = sb ^ (((sb >> 9) & 1) << 5); R = (st >> 1) * 16 + swz / 64; C = (st & 1) * 32 + (swz % 64) / 2; }
__host__ __device__ __forceinline__ int perm32(int rho) { const int n = rho >> 4, i = rho & 15; return 8 * (i >> 2) + 4 * n + (i & 3); }

struct Unit { int pm, pn, aux; const char* A; const char* B; };
struct Dims { int K, lda, ldb; };

__host__ __device__ __forceinline__ void tile_of(int L, int nM, int nN, int& pm, int& pn) {
    const int nwg = nM * nN; int wgid = L; { const int q = nwg / NXCD, r = nwg % NXCD, xcd = wgid % NXCD, off = wgid / NXCD; wgid = (xcd < r ? xcd * (q + 1) : r * (q + 1) + (xcd - r) * q) + off; }
    const int nig = WGM * nN, gid = wgid / nig, fm = gid * WGM, gsz = (nM - fm) < WGM ? (nM - fm) : WGM;
    pm = fm + ((wgid % nig) % gsz); pn = (wgid % nig) / gsz;
}

typedef __bf16 bf16x2v __attribute__((ext_vector_type(2)));
__device__ __forceinline__ unsigned cvt_pk_bf16(float lo, float hi) { const f32x2 v = {lo, hi}; const bf16x2v b = __builtin_convertvector(v, bf16x2v); return __builtin_bit_cast(unsigned, b); }
__device__ __forceinline__ u32x4 pack8(const f32x4 a, const f32x4 b) { u32x4 w; w.x = cvt_pk_bf16(a[0], a[1]); w.y = cvt_pk_bf16(a[2], a[3]); w.z = cvt_pk_bf16(b[0], b[1]); w.w = cvt_pk_bf16(b[2], b[3]); return w; }
__device__ __forceinline__ float bf_lo(unsigned w) { return __uint_as_float(w << 16); }
__device__ __forceinline__ float bf_hi(unsigned w) { return __uint_as_float(w & 0xffff0000u); }
__device__ __forceinline__ void unpack8(const u32x4 w, f32x4& a, f32x4& b) { a[0] = bf_lo(w.x); a[1] = bf_hi(w.x); a[2] = bf_lo(w.y); a[3] = bf_hi(w.y); b[0] = bf_lo(w.z); b[1] = bf_hi(w.z); b[2] = bf_lo(w.w); b[3] = bf_hi(w.w); }
__device__ __forceinline__ float sigm(float x) { return __builtin_amdgcn_rcpf(1.0f + __builtin_amdgcn_exp2f(-1.4426950408889634f * x)); }
__device__ __forceinline__ f32x4 sigm4(const f32x4 x) { f32x4 r; r[0] = sigm(x[0]); r[1] = sigm(x[1]); r[2] = sigm(x[2]); r[3] = sigm(x[3]); return r; }

template <class Epi, class Sched, bool ALIGN_EPI>
__device__ __forceinline__ void gemm_phase(PG8_LAS unsigned char* lds, const Dims g, const Sched& S, const Epi& E) {
    int tid_ = threadIdx.x; asm volatile("" : "+v"(tid_));
    const int tid = tid_, wid = __builtin_amdgcn_readfirstlane(tid >> 6), lane = tid & 63, wr = wid >> 2, wc = wid & 3, fr = lane & 15, fq = lane >> 4;
    const int K = g.K, nt = K / BK;
    unsigned voffA[2], voffB[2];
#pragma unroll
    for (int i = 0; i < 2; ++i) { int R, C; stage_rc(tid * 16 + i * 8192, R, C); const int Rb = Epi::PERM ? ((R & ~31) + perm32(R & 31)) : R;
        voffA[i] = (unsigned)(R * g.lda + C) * 2u; voffB[i] = (unsigned)(Rb * g.ldb + C) * 2u; }
    const size_t kstep = (size_t)(BK * 2);
    const size_t hA = (size_t)HALF * g.lda * 2, hB = (size_t)HALF * g.ldb * 2;
    const unsigned ldsw = (unsigned)wid * 1024u;
    const int aoff = lds_byte(wr * 64 + fr, fq * 8), boff = lds_byte(wc * 32 + fr, fq * 8);
#define PG8_SA(b, h) (((b) * 2 + (h)) * HTB)
#define PG8_SB(b, h) ((4 + (b) * 2 + (h)) * HTB)
#define PG8_STAGE(bufoff, gbase, voff) do { _Pragma("unroll") for (int _i = 0; _i < 2; ++_i) \
        __builtin_amdgcn_global_load_lds((const unsigned*)((const char*)(gbase) + (voff)[_i]), (PG8_LAS unsigned*)(lds + (bufoff) + ldsw + _i * 8192), 16, 0, 0); } while (0)
#define PG8_LDA(dst, b, h) do { _Pragma("unroll") for (int m = 0; m < 4; ++m) _Pragma("unroll") for (int k = 0; k < 2; ++k) dst[m][k] = *(const PG8_LAS bf16x8*)(lds + PG8_SA(b, h) + aoff + m * 2048 + k * 1024); } while (0)
#define PG8_LDB(dst, b, h) do { _Pragma("unroll") for (int n = 0; n < 2; ++n) _Pragma("unroll") for (int k = 0; k < 2; ++k) dst[n][k] = *(const PG8_LAS bf16x8*)(lds + PG8_SB(b, h) + boff + n * 2048 + k * 1024); } while (0)
#define PG8_MMA(ai, bj, At, Bt) do { __builtin_amdgcn_s_setprio(1); _Pragma("unroll") for (int m = 0; m < 4; ++m) _Pragma("unroll") for (int n = 0; n < 2; ++n) _Pragma("unroll") for (int k = 0; k < 2; ++k) \
        acc[ai][bj][m][n] = __builtin_amdgcn_mfma_f32_16x16x32_bf16(Bt[n][k], At[m][k], acc[ai][bj][m][n], 0, 0, 0); __builtin_amdgcn_s_setprio(0); } while (0)
#define PG8_WAIT_V(n) asm volatile("s_waitcnt vmcnt(" #n ")" ::: "memory")
#define PG8_WAIT_L(n) asm volatile("s_waitcnt lgkmcnt(" #n ")" ::: "memory")
#define PG8_BAR __builtin_amdgcn_s_barrier()
#define PG8_SCHED __builtin_amdgcn_sched_barrier(0)
    Unit cur, nxt; int ui = 0;
    if (!S.next(0, cur)) return;
    f32x4 acc[2][2][4][2];
#pragma unroll
    for (int a = 0; a < 2; ++a)
#pragma unroll
        for (int b = 0; b < 2; ++b)
#pragma unroll
            for (int m = 0; m < 4; ++m)
#pragma unroll
                for (int n = 0; n < 2; ++n) acc[a][b][m][n] = (f32x4){0.f, 0.f, 0.f, 0.f};
    bf16x8 At[4][2], B0[2][2], B1[2][2];
    const char* cA = cur.A; const char* cB = cur.B;
    PG8_STAGE(PG8_SB(0, 0), cB, voffB); PG8_STAGE(PG8_SB(0, 1), cB + hB, voffB); PG8_STAGE(PG8_SA(0, 0), cA, voffA); PG8_STAGE(PG8_SA(0, 1), cA + hA, voffA);
    if (wr == 1) PG8_BAR;
    PG8_WAIT_V(2); PG8_BAR;
    PG8_STAGE(PG8_SB(1, 0), cB + kstep, voffB); PG8_STAGE(PG8_SA(1, 0), cA + kstep, voffA); PG8_STAGE(PG8_SB(1, 1), cB + hB + kstep, voffB);
    PG8_WAIT_V(6); PG8_BAR;
    for (;;) {
        const bool has_next = S.next(ui + 1, nxt);
        const char* nA = has_next ? nxt.A : cA; const char* nB = has_next ? nxt.B : cB;
        for (int t = 0; t < nt; t += 2) {
            const bool last = (t == nt - 2);
            const char* a1 = cA + (size_t)(t + 1) * kstep;
            const char* a2 = last ? nA : cA + (size_t)(t + 2) * kstep; const char* b2 = last ? nB : cB + (size_t)(t + 2) * kstep;
            const char* a3 = a2 + kstep; const char* b3 = b2 + kstep;
            PG8_LDB(B0, 0, 0); PG8_LDB(B1, 0, 1); PG8_SCHED; PG8_LDA(At, 0, 0); PG8_STAGE(PG8_SA(1, 1), a1 + hA, voffA);
            PG8_WAIT_V(8); PG8_WAIT_L(0); PG8_BAR; PG8_MMA(0, 0, At, B0); PG8_MMA(0, 1, At, B1); PG8_BAR; PG8_SCHED;
            PG8_LDA(At, 0, 1); PG8_STAGE(PG8_SB(0, 0), b2, voffB); PG8_STAGE(PG8_SB(0, 1), b2 + hB, voffB); PG8_STAGE(PG8_SA(0, 0), a2, voffA);
            PG8_WAIT_V(8); PG8_WAIT_L(0); PG8_BAR; PG8_MMA(1, 0, At, B0); PG8_MMA(1, 1, At, B1); PG8_BAR; PG8_SCHED;
            PG8_LDB(B0, 1, 0); PG8_LDB(B1, 1, 1); PG8_SCHED; PG8_LDA(At, 1, 0); PG8_STAGE(PG8_SA(0, 1), a2 + hA, voffA);
            PG8_WAIT_V(8); PG8_WAIT_L(0); PG8_BAR; PG8_MMA(0, 0, At, B0); PG8_MMA(0, 1, At, B1); PG8_BAR; PG8_SCHED;
            PG8_LDA(At, 1, 1); PG8_STAGE(PG8_SB(1, 0), b3, voffB); PG8_STAGE(PG8_SB(1, 1), b3 + hB, voffB); PG8_STAGE(PG8_SA(1, 0), a3, voffA);
            PG8_WAIT_V(8); PG8_WAIT_L(0); PG8_BAR; PG8_MMA(1, 0, At, B0); PG8_MMA(1, 1, At, B1); PG8_BAR; PG8_SCHED;
        }
        if constexpr (ALIGN_EPI) { if (wr == 0) PG8_BAR; }
        E(acc, cur, wr, wc, fr, fq);
        if (!has_next) break;
#pragma unroll
        for (int a = 0; a < 2; ++a)
#pragma unroll
            for (int b = 0; b < 2; ++b)
#pragma unroll
                for (int m = 0; m < 4; ++m)
#pragma unroll
                    for (int n = 0; n < 2; ++n) acc[a][b][m][n] = (f32x4){0.f, 0.f, 0.f, 0.f};
        cur = nxt; cA = nA; cB = nB; ++ui;
        if constexpr (ALIGN_EPI) { if (wr == 1) PG8_BAR; }
    }
    PG8_WAIT_V(0);
    if constexpr (!ALIGN_EPI) { if (wr == 0) PG8_BAR; }
    PG8_BAR;
#undef PG8_SA
#undef PG8_SB
#undef PG8_STAGE
#undef PG8_LDA
#undef PG8_LDB
#undef PG8_MMA
#undef PG8_WAIT_V
#undef PG8_WAIT_L
#undef PG8_BAR
#undef PG8_SCHED
}

template <class Epi, class Sched, bool ALIGN_EPI>
__device__ __forceinline__ void gemm_phase_ref(PG8_LAS unsigned char* lds, const Dims g, const Sched& S, const Epi& E) {
    int tid_ = threadIdx.x; asm volatile("" : "+v"(tid_));
    const int tid = tid_, wid = __builtin_amdgcn_readfirstlane(tid >> 6), lane = tid & 63, wr = wid >> 2, wc = wid & 3, fr = lane & 15, fq = lane >> 4;
    typedef __bf16 bf2 __attribute__((ext_vector_type(2)));
    Unit cur;
    for (int ui = 0; S.next(ui, cur); ++ui) {
        f32x4 acc[2][2][4][2];
#pragma unroll
        for (int a = 0; a < 2; ++a)
#pragma unroll
            for (int b = 0; b < 2; ++b)
#pragma unroll
                for (int m = 0; m < 4; ++m)
#pragma unroll
                    for (int n = 0; n < 2; ++n) acc[a][b][m][n] = (f32x4){0.f, 0.f, 0.f, 0.f};
        for (int k0 = 0; k0 < g.K; k0 += 8) {
            u32x4 av[2][4];
#pragma unroll
            for (int a = 0; a < 2; ++a)
#pragma unroll
                for (int m = 0; m < 4; ++m) av[a][m] = *(const u32x4*)(cur.A + ((size_t)(128 * a + 64 * wr + 16 * m + fr) * g.lda + k0) * 2);
#pragma unroll
            for (int b = 0; b < 2; ++b)
#pragma unroll
                for (int n = 0; n < 2; ++n)
#pragma unroll
                    for (int i = 0; i < 4; ++i) {
                        const int col = Epi::PERM ? (128 * b + 32 * wc + 8 * fq + 4 * n + i) : (128 * b + 32 * wc + 16 * n + 4 * fq + i);
                        const u32x4 bv = *(const u32x4*)(cur.B + ((size_t)col * g.ldb + k0) * 2);
#pragma unroll
                        for (int a = 0; a < 2; ++a)
#pragma unroll
                            for (int m = 0; m < 4; ++m) { float s = acc[a][b][m][n][i];
                                s = __builtin_amdgcn_fdot2_f32_bf16(__builtin_bit_cast(bf2, av[a][m].x), __builtin_bit_cast(bf2, bv.x), s, false);
                                s = __builtin_amdgcn_fdot2_f32_bf16(__builtin_bit_cast(bf2, av[a][m].y), __builtin_bit_cast(bf2, bv.y), s, false);
                                s = __builtin_amdgcn_fdot2_f32_bf16(__builtin_bit_cast(bf2, av[a][m].z), __builtin_bit_cast(bf2, bv.z), s, false);
                                s = __builtin_amdgcn_fdot2_f32_bf16(__builtin_bit_cast(bf2, av[a][m].w), __builtin_bit_cast(bf2, bv.w), s, false);
                                acc[a][b][m][n][i] = s; }
                    }
        }
        E(acc, cur, wr, wc, fr, fq);
    }
}
}
#define GAS __attribute__((address_space(1)))
#define LAS __attribute__((address_space(3)))
typedef unsigned short bf16;
typedef unsigned v4u __attribute__((ext_vector_type(4)));
typedef unsigned v2u __attribute__((ext_vector_type(2)));
typedef float f32x4 __attribute__((ext_vector_type(4)));
typedef float f32x2 __attribute__((ext_vector_type(2)));
typedef short bf16x8 __attribute__((ext_vector_type(8)));
typedef __bf16 bf16x2_t __attribute__((ext_vector_type(2)));
typedef GAS unsigned gu32;
#define RLX_AGENT __ATOMIC_RELAXED, __HIP_MEMORY_SCOPE_AGENT
#define LDS_WAIT() asm volatile("s_waitcnt lgkmcnt(0)" ::: "memory")
#define VM_WAIT() asm volatile("s_waitcnt vmcnt(0)" ::: "memory")
using pg8::cvt_pk_bf16; using pg8::pack8; using pg8::unpack8; using pg8::bf_lo; using pg8::bf_hi; using pg8::sigm; using pg8::sigm4;

__device__ __forceinline__ float wave_sum(float v) {
#pragma unroll
    for (int o = 1; o < 64; o <<= 1) v += __shfl_xor(v, o);
    return v;
}
__device__ __forceinline__ float dot2bf(unsigned a, unsigned b, float acc) { return __builtin_amdgcn_fdot2_f32_bf16(__builtin_bit_cast(bf16x2_t, a), __builtin_bit_cast(bf16x2_t, b), acc, false); }

#define XB_TMO      128
#define XB_XCNT(j)  (256  + 64 * (j))
#define XB_XSUB(j)  (1280 + 64 * (j))
#define XB_XGEN(j)  (2304 + 64 * (j))
#define XB_TOP      3328
#define XB_TOPGEN   3392
#define XCD_BAR_WORDS 3456
#define XB_SPIN_CAP (1u << 18)

__device__ __forceinline__ unsigned xb_ld(unsigned* p)              { return __hip_atomic_load(p, __ATOMIC_RELAXED, __HIP_MEMORY_SCOPE_AGENT); }
__device__ __forceinline__ unsigned xb_add(unsigned* p, unsigned v) { return __hip_atomic_fetch_add(p, v, __ATOMIC_RELAXED, __HIP_MEMORY_SCOPE_AGENT); }
__device__ __forceinline__ unsigned xb_xcc_id() { return (unsigned)__builtin_amdgcn_s_getreg((3 << 11) | 20) & 0xFu; }
#define XB_SPIN(cond, bar) do { unsigned _sp = 0; while (cond) { __builtin_amdgcn_s_sleep(1); \
    if ((++_sp & 255u) == 0u) { if (xb_ld(&(bar)[XB_TMO])) break; if (_sp > XB_SPIN_CAP) { atomicAdd(&(bar)[XB_TMO], 1u); break; } } } } while (0)

struct XcdBarrier {
    unsigned* bar; unsigned x;
    volatile LAS unsigned* st;
};
__device__ __forceinline__ XcdBarrier xcd_barrier_post(unsigned* bar, volatile LAS unsigned* st) {
    XcdBarrier b; b.bar = bar; b.x = xb_xcc_id(); b.st = st;
    if (threadIdx.x == 0) (void)xb_add(&bar[XB_XCNT(b.x)], 1u);
    return b;
}
__device__ __forceinline__ void xcd_barrier_complete(unsigned* bar, unsigned x, unsigned& nloc, unsigned& nx) {
    const unsigned G = gridDim.x * gridDim.y * gridDim.z;
    unsigned sum, cnt, mine, sp = 0u;
    for (;;) {
        sum = 0u; cnt = 0u; mine = 0u;
#pragma unroll
        for (unsigned j = 0; j < 16; ++j) { const unsigned c = xb_ld(&bar[XB_XCNT(j)]); sum += c; cnt += (c > 0u) ? 1u : 0u; mine = (j == x) ? c : mine; }
        if (sum == G) break;
        __builtin_amdgcn_s_sleep(1);
        if ((++sp & 255u) == 0u) { if (xb_ld(&bar[XB_TMO])) break; if (sp > XB_SPIN_CAP) { atomicAdd(&bar[XB_TMO], 1u); break; } }
    }
    nloc = mine > 0u ? mine : 1u; nx = cnt > 0u ? cnt : 1u;
}
__device__ __forceinline__ void xcd_barrier(const XcdBarrier& b) {
    asm volatile("s_waitcnt vmcnt(0)" ::: "memory");
    __syncthreads();
    if (threadIdx.x == 0) {
        unsigned* bar = b.bar;
        __builtin_amdgcn_s_waitcnt(0);
        unsigned nloc = b.st[0], nx = b.st[1];
        if (nloc == 0u) { xcd_barrier_complete(bar, b.x, nloc, nx); b.st[0] = nloc; b.st[1] = nx; }
        const unsigned old = xb_add(&bar[XB_XSUB(b.x)], 1u);
        const unsigned gen = old / nloc;
        if (old + 1u == (gen + 1u) * nloc) {
            __builtin_amdgcn_fence(__ATOMIC_RELEASE, "agent");
            asm volatile("s_waitcnt vmcnt(0)" ::: "memory");
            const unsigned og = xb_add(&bar[XB_TOP], 1u);
            const unsigned tg = og / nx;
            if (og + 1u == (tg + 1u) * nx) xb_add(&bar[XB_TOPGEN], 1u);
            else XB_SPIN(xb_ld(&bar[XB_TOPGEN]) == tg, bar);
            __builtin_amdgcn_fence(__ATOMIC_ACQUIRE, "agent");
            xb_add(&bar[XB_XGEN(b.x)], 1u);
            asm volatile("s_waitcnt vmcnt(0)" ::: "memory");
        } else {
            XB_SPIN(xb_ld(&bar[XB_XGEN(b.x)]) == gen, bar);
            __builtin_amdgcn_fence(__ATOMIC_ACQUIRE, "agent");
            asm volatile("s_waitcnt vmcnt(0)" ::: "memory");
        }
    }
    __syncthreads();
}
constexpr int NWAVES = 8;
constexpr int BATCH = 8, SEQ = 2048, DM = 1024, M = BATCH * SEQ, DEPTH = 2, NH = 8, HD = 64, AW = 512, CW = 512, CK = 31;
constexpr int NGRP = 4, EPG = 8, NEXP = 32, FF = 512, PLE = 256, WIN = 4608;
constexpr float EPS = 1e-6f;
constexpr float QSCALE = 0.125f * 1.4426950408889634f;
constexpr int MAXROWS = 2 * M + NEXP * 256;
constexpr size_t MiB = 1u << 20;
constexpr size_t WS_CTL = 0, CTL_ZERO_BYTES = 2 * MiB;
constexpr size_t WS_COS = 2 * MiB, WS_SIN = 2 * MiB + 256 * 1024;
constexpr size_t WS_SSQ = 3 * MiB;
constexpr size_t WS_ROUTE = 10 * MiB, WS_POS = 10 * MiB + 512 * 1024, WS_RSC = 11 * MiB, WS_ROWG = 11 * MiB + 256 * 1024;
constexpr size_t WS_WR = 12 * MiB;
constexpr size_t WS_W = 16 * MiB, W_LAYER = 112 * MiB;
constexpr size_t WO_WIN = 0, WO_WAO = 9 * MiB, WO_WCO = 10 * MiB, WO_WOUT = 11 * MiB, WO_WPG = 13 * MiB, WO_WPP = 15 * MiB, WO_WGU = 16 * MiB, WO_WD = 80 * MiB;
constexpr size_t WS_XB = 240 * MiB, WS_PB = 272 * MiB, WS_PE = 288 * MiB, WS_MG = 320 * MiB;
constexpr size_t WS_Q = 352 * MiB, WS_K = 368 * MiB, WS_V = 384 * MiB, WS_U = 400 * MiB, WS_SGA = 416 * MiB, WS_SGB = 448 * MiB, WS_OC = 480 * MiB;
constexpr size_t WS_XG = 352 * MiB, WS_H = 432 * MiB, WS_Y = 352 * MiB, WS_END = 512 * MiB;
constexpr int CW_TMO = 0, CW_CODE = 1, CW_BAR = 4096, CW_CNT = 16384;
constexpr int RING_OFF = 0, RING_BYTES = 131072;
constexpr int LDSCTL_OFF = RING_BYTES, MISC_OFF = LDSCTL_OFF + 320, OFFS_OFF = LDSCTL_OFF + 1024;
constexpr int LDS_BYTES = 147456;
constexpr int PH_PER_LAYER = 10, PH_FINAL = 1 + DEPTH * PH_PER_LAYER, N_PHASES = PH_FINAL + 1;

struct Frame {
    LAS unsigned char* lds;
    volatile LAS unsigned* MISC;
    gu32* ctl;
    int tid, lane, wave, vcu, G;
    float* out; unsigned char* ws;
};
struct Args { const float* in[24]; float* out; unsigned char* ws; int ph_lo, ph_hi, use_bar, pad; };
#define WSP(T, off) ((T*)(F.ws + (off)))

__device__ __forceinline__ void transpose_item(const float* W, int ld, int col0, const float* gain, int k0, bf16* WT, int K, int row0, LAS float* scr, int lane) {
#pragma unroll 8
    for (int i = 0; i < 32; ++i) { const int kk = 2 * i + (lane >> 5); float v = W[(size_t)(k0 + kk) * ld + col0 + (lane & 31)]; if (gain) v *= gain[k0 + kk]; scr[kk * 33 + (lane & 31)] = v; }
    LDS_WAIT(); asm volatile("" ::: "memory");
    const int c = lane & 7;
#pragma unroll
    for (int j = 0; j < 4; ++j) { const int n = (lane >> 3) + 8 * j; const LAS float* s = scr + (8 * c) * 33 + n;
        v4u o; o.x = cvt_pk_bf16(s[0 * 33], s[1 * 33]); o.y = cvt_pk_bf16(s[2 * 33], s[3 * 33]); o.z = cvt_pk_bf16(s[4 * 33], s[5 * 33]); o.w = cvt_pk_bf16(s[6 * 33], s[7 * 33]);
        *(GAS v4u*)(WT + (size_t)(row0 + n) * K + k0 + 8 * c) = o; }
    LDS_WAIT(); asm volatile("" ::: "memory");
}
__device__ __forceinline__ int win_src_col(int g) {
    const int pn = g >> 3, sub = g & 7;
    if (pn < 2) return 64 * (4 * pn + (sub & 3)) + 32 * (sub >> 2);
    if (pn < 4) return 512 + 64 * (4 * (pn - 2) + (sub & 3)) + 32 * (sub >> 2);
    if (pn < 6) return 1024 + 256 * (pn - 4) + 32 * sub;
    if (pn < 10) return (sub < 4 ? 1536 : 2048) + 128 * (pn - 6) + 32 * (sub & 3);
    return 2560 + 256 * (pn - 10) + 32 * sub;
}
constexpr int IT_WIN = 144 * 16, IT_WAO = 32 * 8, IT_WCO = 32 * 8, IT_WOUT = 32 * 16, IT_WPG = 32 * 16, IT_WPP = 32 * 4, IT_WGU = 1024 * 16, IT_WD = 1024 * 8;
constexpr int IT_LAYER = IT_WIN + IT_WAO + IT_WCO + IT_WOUT + IT_WPG + IT_WPP + IT_WGU + IT_WD;
__device__ __forceinline__ void conv_item(Frame& F, const Args& args, int L, int it, LAS float* scr) {
    unsigned char* wl = F.ws + WS_W + (size_t)L * W_LAYER; const int lane = F.lane;
    int r = it;
    if (r < IT_WIN) { const int g = r >> 4, kb = r & 15; transpose_item(args.in[3] + (size_t)L * DM * WIN, WIN, win_src_col(g), args.in[2] + L * DM, 64 * kb, (bf16*)(wl + WO_WIN), 1024, 32 * g, scr, lane); return; } r -= IT_WIN;
    if (r < IT_WAO) { const int g = r >> 3, kb = r & 7; transpose_item(args.in[8] + (size_t)L * 512 * DM, DM, 32 * g, nullptr, 64 * kb, (bf16*)(wl + WO_WAO), 512, 32 * g, scr, lane); return; } r -= IT_WAO;
    if (r < IT_WCO) { const int g = r >> 3, kb = r & 7; transpose_item(args.in[9] + (size_t)L * 512 * DM, DM, 32 * g, nullptr, 64 * kb, (bf16*)(wl + WO_WCO), 512, 32 * g, scr, lane); return; } r -= IT_WCO;
    if (r < IT_WOUT) { const int g = r >> 4, kb = r & 15; transpose_item(args.in[11] + (size_t)L * DM * DM, DM, 32 * g, nullptr, 64 * kb, (bf16*)(wl + WO_WOUT), 1024, 32 * g, scr, lane); return; } r -= IT_WOUT;
    if (r < IT_WPG) { const int g = r >> 4, kb = r & 15; transpose_item(args.in[22] + (size_t)L * DM * DM, DM, 32 * g, args.in[20] + L * DM, 64 * kb, (bf16*)(wl + WO_WPG), 1024, 32 * g, scr, lane); return; } r -= IT_WPG;
    if (r < IT_WPP) { const int g = r >> 2, kb = r & 3; transpose_item(args.in[21] + (size_t)L * PLE * DM, DM, 32 * g, nullptr, 64 * kb, (bf16*)(wl + WO_WPP), 256, 32 * g, scr, lane); return; } r -= IT_WPP;
    if (r < IT_WGU) { const int g = r >> 4, kb = r & 15, e = g >> 5, gl = g & 31, tile = gl >> 3, sub = gl & 7;
        const float* src = (sub < 4 ? args.in[17] : args.in[18]) + ((size_t)L * NEXP + e) * DM * FF;
        transpose_item(src, FF, 128 * tile + 32 * (sub & 3), args.in[12] + L * DM, 64 * kb, (bf16*)(wl + WO_WGU), 1024, 32 * g, scr, lane); return; } r -= IT_WGU;
    { const int g = r >> 3, kb = r & 7, e = g >> 5, gl = g & 31;
        transpose_item(args.in[19] + ((size_t)L * NEXP + e) * FF * DM, DM, 32 * gl, nullptr, 64 * kb, (bf16*)(wl + WO_WD), 512, 32 * g, scr, lane); }
}
__device__ __forceinline__ void p0_prologue(Frame& F, const Args& args) {
    LAS float* scr = (LAS float*)(F.lds + RING_OFF + F.wave * 16384);
    const int gw = F.vcu * NWAVES + F.wave, NGW = F.G * NWAVES, lane = F.lane;
    const int gt = (F.vcu * NWAVES + F.wave) * 64 + lane, NGT = NGW * 64;
    { bf16* XB = WSP(bf16, WS_XB); float* SSQ = WSP(float, WS_SSQ);
      for (int m = gw; m < M; m += NGW) {
          const GAS f32x4* xr = (const GAS f32x4*)(args.in[0] + (size_t)m * DM) + lane; float s = 0.f; GAS v2u* o8 = (GAS v2u*)(XB + (size_t)m * DM) + lane;
#pragma unroll
          for (int j = 0; j < 4; ++j) { const f32x4 v = xr[64 * j]; s += (v[0] * v[0] + v[1] * v[1]) + (v[2] * v[2] + v[3] * v[3]); v2u w; w.x = cvt_pk_bf16(v[0], v[1]); w.y = cvt_pk_bf16(v[2], v[3]); o8[64 * j] = w; }
          const float tot = wave_sum(s);
          if (lane < 16) SSQ[(size_t)m * 16 + lane] = lane == 0 ? tot : 0.f;
      } }
    { const GAS f32x4* ps = (const GAS f32x4*)args.in[1]; GAS v4u* pb = (GAS v4u*)WSP(bf16, WS_PB);
      for (int i = gt; i < DEPTH * M * PLE / 8; i += NGT) { const f32x4 a = ps[2 * i], b = ps[2 * i + 1]; pb[i] = pack8(a, b); } }
    { float* ct = WSP(float, WS_COS); float* st = WSP(float, WS_SIN);
      for (int i = gt; i < SEQ * 32; i += NGT) { const int pos = i >> 5, k = i & 31; const float inv = powf(10000.0f, -(float)(2 * k) / 64.0f); const float ang = (float)pos * inv; ct[i] = cosf(ang); st[i] = sinf(ang); } }
    { bf16* wr = WSP(bf16, WS_WR);
      for (int i = gt; i < DEPTH * 64 * DM; i += NGT) { const int L = i >> 16, j = (i >> 10) & 63, k = i & 1023; float v = 0.f;
          if (j < 4) v = args.in[13][((size_t)L * DM + k) * NGRP + j]; else if (j < 36) v = args.in[15][((size_t)L * DM + k) * NEXP + (j - 4)];
          v *= args.in[12][L * DM + k]; wr[i] = (bf16)(cvt_pk_bf16(v, 0.f) & 0xffffu); } }
    for (int it = gw; it < DEPTH * IT_LAYER; it += NGW) { const int L = it >= IT_LAYER ? 1 : 0; conv_item(F, args, L, it - L * IT_LAYER, scr); }
}

struct SchedGrid {
    int nM, nN, G, c; const char* Ab; const char* Bb; size_t astep, bstep;
    __device__ __forceinline__ bool next(int i, pg8::Unit& u) const {
        const int L = i * G + c; if (L >= nM * nN) return false;
        pg8::tile_of(L, nM, nN, u.pm, u.pn); u.aux = 0; u.A = Ab + (size_t)u.pm * astep; u.B = Bb + (size_t)u.pn * bstep; return true; }
};
struct SchedP3 {
    int G, c; const char* OC; const char* Wa; const char* Wc;
    __device__ __forceinline__ bool next(int i, pg8::Unit& u) const {
        const int T = (i >> 1) * G + c; if (T >= 256) return false;
        pg8::tile_of(T, 64, 4, u.pm, u.pn); u.aux = i & 1;
        u.A = OC + (size_t)u.pm * (256 * 1024 * 2) + (u.aux ? 512 * 2 : 0); u.B = (u.aux ? Wc : Wa) + (size_t)u.pn * (256 * 512 * 2); return true; }
};
struct SchedMoe {
    const volatile LAS int* offs; int G, c, up; const char* Ab; const char* Bb;
    __device__ __forceinline__ bool next(int i, pg8::Unit& u) const {
        const int NB = offs[32] >> 8, L = i * G + c; if (L >= NB * 4) return false;
        const int mb = L >> 2, pn = L & 3; int e = 0;
        while (e < 31 && offs[e + 1] <= mb * 256) ++e;
        u.pm = mb; u.pn = pn; u.aux = e;
        if (up) { u.A = Ab + (size_t)mb * (256 * 1024 * 2); u.B = Bb + ((size_t)e * 1024 + pn * 256) * (1024 * 2); }
        else    { u.A = Ab + (size_t)mb * (256 * 512 * 2);  u.B = Bb + ((size_t)e * 1024 + pn * 256) * (512 * 2); }
        return true; }
};

using pg8::f32x4;
#define EPI_FOR_ROWS _Pragma("unroll") for (int ai = 0; ai < 2; ++ai) _Pragma("unroll") for (int m = 0; m < 4; ++m)
#define EPI_ROW (u.pm * 256 + ai * 128 + wr * 64 + m * 16 + fr)
__device__ __forceinline__ float rscale_of(const float* ssq, int row) {
    const f32x4* sp = (const f32x4*)(ssq + (size_t)row * 16); const f32x4 a = sp[0], b = sp[1], c = sp[2], d = sp[3];
    const float s = ((a[0] + a[1]) + (a[2] + a[3])) + ((b[0] + b[1]) + (b[2] + b[3])) + ((c[0] + c[1]) + (c[2] + c[3])) + ((d[0] + d[1]) + (d[2] + d[3]));
    return rsqrtf(s * (1.0f / DM) + EPS);
}
struct EpiP1 {
    static constexpr bool PERM = true;
    const float* ssq; const float* cosT; const float* sinT; bf16 *Q, *K, *V, *U, *SGA, *SGB;
    __device__ __forceinline__ void operator()(const f32x4 (&acc)[2][2][4][2], const pg8::Unit& u, int wr, int wc, int fr, int fq) const {
        const int pn = u.pn;
        EPI_FOR_ROWS { const int row = EPI_ROW;
            const float r = rscale_of(ssq, row); const int b = row >> 11, t = row & 2047;
            if (pn < 4) {
                const int head = 4 * (pn & 1) + wc; const float qs = pn < 2 ? QSCALE : 1.0f;
                const f32x4* cp = (const f32x4*)(cosT + t * 32 + 8 * fq); const f32x4* sp = (const f32x4*)(sinT + t * 32 + 8 * fq);
                f32x4 o1[2], o2[2];
#pragma unroll
                for (int n = 0; n < 2; ++n) { const f32x4 c = cp[n], s = sp[n], t1 = acc[ai][0][m][n] * (r * qs), t2 = acc[ai][1][m][n] * (r * qs); o1[n] = t1 * c - t2 * s; o2[n] = t1 * s + t2 * c; }
                bf16* dst = (pn < 2 ? Q : K) + ((size_t)(b * NH + head) * SEQ + t) * HD + 8 * fq;
                *(v4u*)dst = pack8(o1[0], o1[1]); *(v4u*)(dst + 32) = pack8(o2[0], o2[1]);
            } else if (pn < 6) {
#pragma unroll
                for (int bj = 0; bj < 2; ++bj) { const int head = 4 * (pn - 4) + 2 * bj + (wc >> 1), dim = 32 * (wc & 1) + 8 * fq;
                    *(v4u*)(V + ((size_t)(b * NH + head) * SEQ + t) * HD + dim) = pack8(acc[ai][bj][m][0] * r, acc[ai][bj][m][1] * r); }
            } else if (pn < 10) {
                f32x4 o[2];
#pragma unroll
                for (int n = 0; n < 2; ++n) o[n] = (acc[ai][0][m][n] * r) * sigm4(acc[ai][1][m][n] * r);
                *(v4u*)(U + (size_t)row * CW + 128 * (pn - 6) + 32 * wc + 8 * fq) = pack8(o[0], o[1]);
            } else {
                bf16* base = (pn < 14 ? SGA + 256 * (pn - 10) : SGB + 256 * (pn - 14)) + (size_t)row * DM + 32 * wc + 8 * fq;
#pragma unroll
                for (int bj = 0; bj < 2; ++bj) *(v4u*)(base + 128 * bj) = pack8(sigm4(acc[ai][bj][m][0] * r), sigm4(acc[ai][bj][m][1] * r));
            }
        }
    }
};
struct EpiP3 {
    static constexpr bool PERM = true;
    const bf16* SGA; const bf16* SGB; const float* bco; bf16* MG;
    __device__ __forceinline__ void operator()(const f32x4 (&acc)[2][2][4][2], const pg8::Unit& u, int wr, int wc, int fr, int fq) const {
        const int kind = u.aux;
        EPI_FOR_ROWS { const int row = EPI_ROW;
#pragma unroll
            for (int bj = 0; bj < 2; ++bj) { const int col = u.pn * 256 + 128 * bj + 32 * wc + 8 * fq; const size_t off = (size_t)row * DM + col;
                f32x4 g0, g1; unpack8(*(const v4u*)((kind ? SGB : SGA) + off), g0, g1);
                f32x4 v0 = acc[ai][bj][m][0], v1 = acc[ai][bj][m][1];
                if (kind) { const f32x4 b0 = *(const f32x4*)(bco + col), b1 = *(const f32x4*)(bco + col + 4); f32x4 p0, p1; unpack8(*(const v4u*)(MG + off), p0, p1); v0 = p0 + g0 * (v0 + b0); v1 = p1 + g1 * (v1 + b1); }
                else { v0 = g0 * v0; v1 = g1 * v1; }
                *(v4u*)(MG + off) = pack8(v0, v1); }
        }
    }
};
#define RESID_STORE(DELTA0, DELTA1) { const f32x4 x0 = *(const f32x4*)(resid + off), x1 = *(const f32x4*)(resid + off + 4); const f32x4 v0 = x0 + (DELTA0), v1 = x1 + (DELTA1); \
        *(f32x4*)(X + off) = v0; *(f32x4*)(X + off + 4) = v1; *(v4u*)(XB + off) = pack8(v0, v1); \
        ss += ((v0[0] * v0[0] + v0[1] * v0[1]) + (v0[2] * v0[2] + v0[3] * v0[3])) + ((v1[0] * v1[0] + v1[1] * v1[1]) + (v1[2] * v1[2] + v1[3] * v1[3])); }
#define SSQ_STORE() { ss += __shfl_xor(ss, 16); ss += __shfl_xor(ss, 32); if (fq == 0) ssq_out[(size_t)row * 16 + u.pn * 4 + wc] = ss; }
struct EpiP4 {
    static constexpr bool PERM = true;
    const float* resid; float* X; bf16* XB; float* ssq_out;
    __device__ __forceinline__ void operator()(const f32x4 (&acc)[2][2][4][2], const pg8::Unit& u, int wr, int wc, int fr, int fq) const {
        EPI_FOR_ROWS { const int row = EPI_ROW;
            float ss = 0.f;
#pragma unroll
            for (int bj = 0; bj < 2; ++bj) { const size_t off = (size_t)row * DM + u.pn * 256 + 128 * bj + 32 * wc + 8 * fq; RESID_STORE(acc[ai][bj][m][0], acc[ai][bj][m][1]) }
            SSQ_STORE()
        }
    }
};
struct EpiP8 {
    static constexpr bool PERM = true;
    const float* ssq_in; const bf16* PE; const float* resid; float* X; bf16* XB; float* ssq_out;
    __device__ __forceinline__ void operator()(const f32x4 (&acc)[2][2][4][2], const pg8::Unit& u, int wr, int wc, int fr, int fq) const {
        EPI_FOR_ROWS { const int row = EPI_ROW;
            const float r = rscale_of(ssq_in, row); float ss = 0.f;
#pragma unroll
            for (int bj = 0; bj < 2; ++bj) { const size_t off = (size_t)row * DM + u.pn * 256 + 128 * bj + 32 * wc + 8 * fq;
                f32x4 p0, p1; unpack8(*(const v4u*)(PE + off), p0, p1);
                RESID_STORE(sigm4(acc[ai][bj][m][0] * r) * p0, sigm4(acc[ai][bj][m][1] * r) * p1) }
            SSQ_STORE()
        }
    }
};
struct EpiBf16 {
    static constexpr bool PERM = true;
    bf16* O; int ldc;
    __device__ __forceinline__ void operator()(const f32x4 (&acc)[2][2][4][2], const pg8::Unit& u, int wr, int wc, int fr, int fq) const {
        EPI_FOR_ROWS { const int row = EPI_ROW;
#pragma unroll
            for (int bj = 0; bj < 2; ++bj) *(v4u*)(O + (size_t)row * ldc + u.pn * 256 + 128 * bj + 32 * wc + 8 * fq) = pack8(acc[ai][bj][m][0], acc[ai][bj][m][1]);
        }
    }
};
struct EpiUp {
    static constexpr bool PERM = true;
    const float* RSC; bf16* H;
    __device__ __forceinline__ void operator()(const f32x4 (&acc)[2][2][4][2], const pg8::Unit& u, int wr, int wc, int fr, int fq) const {
        EPI_FOR_ROWS { const int row = EPI_ROW;
            const float r = RSC[row]; f32x4 o[2];
#pragma unroll
            for (int n = 0; n < 2; ++n) { const f32x4 g = acc[ai][0][m][n] * r; o[n] = g * sigm4(g) * (acc[ai][1][m][n] * r); }
            *(v4u*)(H + (size_t)row * FF + 128 * u.pn + 32 * wc + 8 * fq) = pack8(o[0], o[1]);
        }
    }
};
struct EpiDown {
    static constexpr bool PERM = true;
    const float* ROWG; bf16* Y;
    __device__ __forceinline__ void operator()(const f32x4 (&acc)[2][2][4][2], const pg8::Unit& u, int wr, int wc, int fr, int fq) const {
        EPI_FOR_ROWS { const int row = EPI_ROW;
            const float gt = ROWG[row];
#pragma unroll
            for (int bj = 0; bj < 2; ++bj) *(v4u*)(Y + (size_t)row * DM + u.pn * 256 + 128 * bj + 32 * wc + 8 * fq) = pack8(acc[ai][bj][m][0] * gt, acc[ai][bj][m][1] * gt);
        }
    }
};

__device__ __forceinline__ void attn_simple(Frame& F) {
    const bf16* Q = WSP(bf16, WS_Q); const bf16* Kb = WSP(bf16, WS_K); const bf16* Vb = WSP(bf16, WS_V); bf16* OC = WSP(bf16, WS_OC);
    const int lane = F.lane;
    for (int unit = F.vcu * NWAVES + F.wave; unit < BATCH * NH * (SEQ / 64); unit += F.G * NWAVES) {
        const int bh = unit >> 5, t = ((unit & 31) << 6) + lane;
        unsigned qw[32];
        { const GAS v4u* qp = (const GAS v4u*)(Q + ((size_t)bh * SEQ + t) * HD);
#pragma unroll
          for (int i = 0; i < 8; ++i) { const v4u w = qp[i]; qw[4 * i] = w.x; qw[4 * i + 1] = w.y; qw[4 * i + 2] = w.z; qw[4 * i + 3] = w.w; } }
        float o[64];
#pragma unroll
        for (int i = 0; i < 64; ++i) o[i] = 0.f;
        float mx = -1e30f, l = 0.f;
        for (int g = 0; g < 3; ++g) {
            const int d = g == 0 ? 1 : (g == 1 ? 4 : 16);
            for (int j0 = 0; j0 <= 128; j0 += 4) {
                if (!__any(t - j0 * d >= 0)) break;
                float s[4]; int pc[4];
#pragma unroll
                for (int c = 0; c < 4; ++c) { const int j = j0 + c, pos = t - j * d; const bool valid = pos >= 0 && j <= 128; pc[c] = valid ? pos : t;
                    const GAS v4u* kp = (const GAS v4u*)(Kb + ((size_t)bh * SEQ + pc[c]) * HD); float a = 0.f;
#pragma unroll
                    for (int i = 0; i < 8; ++i) { const v4u w = kp[i]; a = dot2bf(qw[4 * i], w.x, a); a = dot2bf(qw[4 * i + 1], w.y, a); a = dot2bf(qw[4 * i + 2], w.z, a); a = dot2bf(qw[4 * i + 3], w.w, a); }
                    s[c] = valid ? a : -1e30f; }
                const float mc = fmaxf(fmaxf(s[0], s[1]), fmaxf(s[2], s[3])), mn = fmaxf(mx, mc), sc = __builtin_amdgcn_exp2f(mx - mn);
                l *= sc;
#pragma unroll
                for (int i = 0; i < 64; ++i) o[i] *= sc;
                mx = mn;
#pragma unroll
                for (int c = 0; c < 4; ++c) { const float p = __builtin_amdgcn_exp2f(s[c] - mn); l += p;
                    const GAS v4u* vp = (const GAS v4u*)(Vb + ((size_t)bh * SEQ + pc[c]) * HD);
#pragma unroll
                    for (int i = 0; i < 8; ++i) { const v4u w = vp[i];
                        o[8 * i + 0] += p * bf_lo(w.x); o[8 * i + 1] += p * bf_hi(w.x); o[8 * i + 2] += p * bf_lo(w.y); o[8 * i + 3] += p * bf_hi(w.y);
                        o[8 * i + 4] += p * bf_lo(w.z); o[8 * i + 5] += p * bf_hi(w.z); o[8 * i + 6] += p * bf_lo(w.w); o[8 * i + 7] += p * bf_hi(w.w); } }
            }
        }
        const float inv = 1.0f / l; const int b = bh >> 3, h = bh & 7;
        GAS v4u* op = (GAS v4u*)(OC + ((size_t)(b * SEQ + t)) * DM + h * HD);
#pragma unroll
        for (int i = 0; i < 8; ++i) { v4u w; w.x = cvt_pk_bf16(o[8 * i] * inv, o[8 * i + 1] * inv); w.y = cvt_pk_bf16(o[8 * i + 2] * inv, o[8 * i + 3] * inv); w.z = cvt_pk_bf16(o[8 * i + 4] * inv, o[8 * i + 5] * inv); w.w = cvt_pk_bf16(o[8 * i + 6] * inv, o[8 * i + 7] * inv); op[i] = w; }
    }
}

typedef float f32x16 __attribute__((ext_vector_type(16)));
typedef short v4i16_t __attribute__((ext_vector_type(4)));
struct AttnStep { int p0, st, mode, T; };
__device__ __forceinline__ void attn_desc(int idx, int qb, int c, int i, int hi, int n1, int n0, int nb2, AttnStep& d) {
    if (idx < n1) { const int kb = qb - idx; d.p0 = 128 * kb + c; d.st = 4; d.mode = (idx == 0) ? 2 : ((idx == 4) ? 1 : 0); d.T = i - 4 * hi; }
    else if (idx < n1 + n0) { const int kb = (qb ? 0 : 4) + (idx - n1); d.st = 1;
        if (kb < 4) { d.p0 = 128 * (qb - 1) + 32 * kb; d.mode = 1; d.T = 4 * i + c - 32 * kb - 4 * hi; }
        else { d.p0 = 128 * qb + 32 * (kb - 4); d.mode = 2; d.T = 4 * i + c - 32 * (kb - 4) - 4 * hi; } }
    else { const int e = idx - n1 - n0, a = e / nb2, kb = e - a * nb2; d.p0 = 512 * kb + 4 * a + c; d.st = 16; d.mode = 2; d.T = ((i & 3) == a) ? (8 * qb + (i >> 2) - 32 * kb - 4 * hi) : -100; }
}
__device__ __forceinline__ void attn_dma(LAS unsigned char* slot, const bf16* Kh, const bf16* Vh, int p0, int st, int lane) {
    const int rl = lane >> 3, pos = lane & 7;
#pragma unroll
    for (int pc = 0; pc < 4; ++pc) {
        const int row = 8 * pc + rl; const size_t rowoff = (size_t)(p0 + st * row) * HD;
        const int chk = pos ^ ((row >> 1) & 7);
        const int chv = (((pos >> 1) ^ (((row >> 1) & 1) << 1)) << 1) | (pos & 1);
        __builtin_amdgcn_global_load_lds((const unsigned*)(Kh + rowoff + chk * 8), (LAS unsigned*)(slot + pc * 1024), 16, 0, 0);
        __builtin_amdgcn_global_load_lds((const unsigned*)(Vh + rowoff + chv * 8), (LAS unsigned*)(slot + 4096 + pc * 1024), 16, 0, 0);
    }
}
__device__ __forceinline__ void attn_mfma(Frame& F) {
    const bf16* Q = WSP(bf16, WS_Q); const bf16* Kb = WSP(bf16, WS_K); const bf16* Vb = WSP(bf16, WS_V); bf16* OC = WSP(bf16, WS_OC);
    const int lane = F.lane, i = lane & 31, hi = lane >> 5;
    LAS unsigned char* ring = F.lds + RING_OFF + F.wave * 16384;
    int koff[4];
#pragma unroll
    for (int s = 0; s < 4; ++s) koff[s] = i * 128 + (((2 * s + hi) ^ ((i >> 1) & 7)) << 4);
    const int g2 = (lane >> 4) & 1, q4 = (lane & 15) >> 2, p4 = lane & 3;
    int voff[2][2];
#pragma unroll
    for (int s = 0; s < 2; ++s)
#pragma unroll
        for (int db = 0; db < 2; ++db) { const int row = 16 * s + 4 * hi + q4; voff[s][db] = 4096 + row * 128 + (((2 * db + g2) ^ (((row >> 1) & 1) << 1)) << 5) + p4 * 8; }
    for (int pass = 0; pass < 2; ++pass) {
        const int gw = F.vcu * NWAVES + F.wave;
        const int T = pass == 0 ? gw : (BATCH * NH * 4 * 16 - 1 - gw);
        if (gw >= BATCH * NH * 4 * 16 / 2) break;
        const int qb = T & 15, c = (T >> 4) & 3, bh = T >> 6;
        const bf16* Kh = Kb + (size_t)bh * SEQ * HD; const bf16* Vh = Vb + (size_t)bh * SEQ * HD;
        const int tq = 128 * qb + 4 * i + c;
        bf16x8 qf[4];
        { const GAS bf16x8* qp = (const GAS bf16x8*)(Q + ((size_t)bh * SEQ + tq) * HD + 8 * hi);
#pragma unroll
          for (int s = 0; s < 4; ++s) qf[s] = qp[2 * s]; }
        const int n1 = (qb < 4 ? qb : 4) + 1, n0 = qb ? 8 : 4, nb2 = (qb >> 2) + 1, nsteps = n1 + n0 + 4 * nb2;
        f32x16 o0, o1;
#pragma unroll
        for (int r = 0; r < 16; ++r) { o0[r] = 0.f; o1[r] = 0.f; }
        float mrun = -1e30f, lrun = 0.f;
        AttnStep cur; attn_desc(0, qb, c, i, hi, n1, n0, nb2, cur);
        attn_dma(ring, Kh, Vh, cur.p0, cur.st, lane);
        for (int idx = 0; idx < nsteps; ++idx) {
            LAS unsigned char* slot = ring + (idx & 1) * 8192;
            AttnStep nxt = cur;
            if (idx + 1 < nsteps) { attn_desc(idx + 1, qb, c, i, hi, n1, n0, nb2, nxt); attn_dma(ring + ((idx + 1) & 1) * 8192, Kh, Vh, nxt.p0, nxt.st, lane); asm volatile("s_waitcnt vmcnt(8)" ::: "memory"); }
            else { asm volatile("s_waitcnt vmcnt(0)" ::: "memory"); }
            f32x16 sacc;
#pragma unroll
            for (int r = 0; r < 16; ++r) sacc[r] = 0.f;
#pragma unroll
            for (int s = 0; s < 4; ++s) { const bf16x8 kf = *(const LAS bf16x8*)(slot + koff[s]); sacc = __builtin_amdgcn_mfma_f32_32x32x16_bf16(kf, qf[s], sacc, 0, 0, 0); }
            if (cur.mode == 1) {
#pragma unroll
                for (int r = 0; r < 16; ++r) sacc[r] = ((r & 3) + 8 * (r >> 2) >= cur.T) ? sacc[r] : -1e30f;
            } else if (cur.mode == 2) {
#pragma unroll
                for (int r = 0; r < 16; ++r) sacc[r] = ((r & 3) + 8 * (r >> 2) <= cur.T) ? sacc[r] : -1e30f;
            }
            float mloc = sacc[0];
#pragma unroll
            for (int r = 1; r < 16; ++r) mloc = fmaxf(mloc, sacc[r]);
            { auto rr = __builtin_amdgcn_permlane32_swap(__float_as_uint(mloc), __float_as_uint(mloc), false, false); mloc = fmaxf(__uint_as_float(rr[0]), __uint_as_float(rr[1])); }
            const float mnew = fmaxf(mrun, mloc), alpha = __builtin_amdgcn_exp2f(mrun - mnew);
            mrun = mnew;
            float psum = 0.f;
#pragma unroll
            for (int r = 0; r < 16; ++r) { sacc[r] = __builtin_amdgcn_exp2f(sacc[r] - mnew); psum += sacc[r]; }
            lrun = lrun * alpha + psum;
#pragma unroll
            for (int r = 0; r < 16; ++r) { o0[r] *= alpha; o1[r] *= alpha; }
            bf16x8 pf[2];
#pragma unroll
            for (int s = 0; s < 2; ++s) { v4u w; w.x = cvt_pk_bf16(sacc[8 * s], sacc[8 * s + 1]); w.y = cvt_pk_bf16(sacc[8 * s + 2], sacc[8 * s + 3]); w.z = cvt_pk_bf16(sacc[8 * s + 4], sacc[8 * s + 5]); w.w = cvt_pk_bf16(sacc[8 * s + 6], sacc[8 * s + 7]); pf[s] = __builtin_bit_cast(bf16x8, w); }
#pragma unroll
            for (int s = 0; s < 2; ++s)
#pragma unroll
                for (int db = 0; db < 2; ++db) {
                    const v4i16_t lo = __builtin_amdgcn_ds_read_tr16_b64_v4i16((LAS v4i16_t*)(slot + voff[s][db]));
                    const v4i16_t hh = __builtin_amdgcn_ds_read_tr16_b64_v4i16((LAS v4i16_t*)(slot + voff[s][db] + 8 * 128));
                    const bf16x8 vf = (bf16x8){lo[0], lo[1], lo[2], lo[3], hh[0], hh[1], hh[2], hh[3]};
                    if (db == 0) o0 = __builtin_amdgcn_mfma_f32_32x32x16_bf16(vf, pf[s], o0, 0, 0, 0); else o1 = __builtin_amdgcn_mfma_f32_32x32x16_bf16(vf, pf[s], o1, 0, 0, 0);
                }
            cur = nxt;
        }
        { auto rr = __builtin_amdgcn_permlane32_swap(__float_as_uint(lrun), __float_as_uint(lrun), false, false); lrun = __uint_as_float(rr[0]) + __uint_as_float(rr[1]); }
        const float inv = 1.0f / lrun; const int b = bh >> 3, h = bh & 7;
        bf16* op = OC + ((size_t)(b * SEQ + tq)) * DM + h * HD + 4 * hi;
#pragma unroll
        for (int g = 0; g < 4; ++g) {
            v2u w0, w1; w0.x = cvt_pk_bf16(o0[4 * g] * inv, o0[4 * g + 1] * inv); w0.y = cvt_pk_bf16(o0[4 * g + 2] * inv, o0[4 * g + 3] * inv);
            w1.x = cvt_pk_bf16(o1[4 * g] * inv, o1[4 * g + 1] * inv); w1.y = cvt_pk_bf16(o1[4 * g + 2] * inv, o1[4 * g + 3] * inv);
            *(GAS v2u*)(op + 8 * g) = w0; *(GAS v2u*)(op + 32 + 8 * g) = w1; }
    }
    asm volatile("s_waitcnt vmcnt(0)" ::: "memory");
}

__device__ __forceinline__ void conv_simple(Frame& F, const Args& args, int L) {
    LAS float* ybuf = (LAS float*)(F.lds + RING_OFF); LAS float* stats = ybuf + 16 * 512;
    const bf16* U = WSP(bf16, WS_U); bf16* OC = WSP(bf16, WS_OC);
    const int c = F.tid, lane = F.lane;
    float w[CK];
#pragma unroll
    for (int j = 0; j < CK; ++j) w[j] = args.in[4][((size_t)L * CK + j) * CW + c];
    const float bias = args.in[5][L * CW + c], lg = args.in[6][L * CW + c], lb = args.in[7][L * CW + c];
    for (int unit = F.vcu; unit < M / 16; unit += F.G) {
        const int row0 = unit * 16, t0 = row0 & (SEQ - 1);
        float uu[46];
#pragma unroll
        for (int i = 0; i < 46; ++i) { const int tt = t0 - 30 + i; uu[i] = tt >= 0 ? __uint_as_float((unsigned)U[(size_t)(row0 - 30 + i) * CW + c] << 16) : 0.f; }
        float y[16];
#pragma unroll
        for (int tt = 0; tt < 16; ++tt) { float a = bias;
#pragma unroll
            for (int j = 0; j < CK; ++j) a += w[j] * uu[tt + j];
            y[tt] = a; ybuf[tt * 512 + c] = a; }
        __syncthreads();
#pragma unroll
        for (int q = 0; q < 2; ++q) { const int tt = 2 * F.wave + q; float v[8]; float s = 0.f;
#pragma unroll
            for (int i = 0; i < 8; ++i) { v[i] = ybuf[tt * 512 + lane + 64 * i]; s += v[i]; }
            const float mu = wave_sum(s) * (1.0f / 512.0f); float s2 = 0.f;
#pragma unroll
            for (int i = 0; i < 8; ++i) { const float dd = v[i] - mu; s2 += dd * dd; }
            const float var = wave_sum(s2) * (1.0f / 512.0f);
            if (lane == 0) { stats[2 * tt] = mu; stats[2 * tt + 1] = rsqrtf(var + EPS); } }
        __syncthreads();
#pragma unroll
        for (int tt = 0; tt < 16; ++tt) { const float yn = (y[tt] - stats[2 * tt]) * stats[2 * tt + 1] * lg + lb; const float ov = yn * sigm(yn);
            OC[(size_t)(row0 + tt) * DM + 512 + c] = (bf16)(cvt_pk_bf16(ov, 0.f) & 0xffffu); }
        __syncthreads();
    }
}
__device__ __forceinline__ void route_phase(Frame& F, const Args& args, int L) {
    LAS float* lgs = (LAS float*)(F.lds + RING_OFF) + F.wave * (8 * 40);
    const bf16* XB = WSP(bf16, WS_XB); const float* SSQ = WSP(float, WS_SSQ + (size_t)(3 * L + 1) * MiB); const bf16* WR = WSP(bf16, WS_WR) + (size_t)L * 64 * DM;
    int* ROUTE = WSP(int, WS_ROUTE); unsigned* cnt = (unsigned*)(F.ctl + CW_CNT + 64 * L);
    const int lane = F.lane, gw = F.vcu * NWAVES + F.wave, NGW = F.G * NWAVES;
    int vz = 0; asm volatile("" : "+v"(vz));
    const float bias = lane < 4 ? args.in[14][L * NGRP + lane] : (lane < 36 ? args.in[16][L * NEXP + lane - 4] : 0.f);
    for (int tb = gw; tb < M / 8; tb += NGW) {
        const int t0 = tb * 8;
        const GAS v4u* wp = (const GAS v4u*)(WR + (size_t)lane * DM);
        float a[8];
#pragma unroll
        for (int tt = 0; tt < 8; ++tt) a[tt] = 0.f;
        for (int kc = 0; kc < 128; ++kc) { const v4u w = wp[kc];
#pragma unroll
            for (int tt = 0; tt < 8; ++tt) { const v4u x = *((const GAS v4u*)(XB + (size_t)(t0 + tt) * DM) + kc + vz);
                a[tt] = dot2bf(w.x, x.x, a[tt]); a[tt] = dot2bf(w.y, x.y, a[tt]); a[tt] = dot2bf(w.z, x.z, a[tt]); a[tt] = dot2bf(w.w, x.w, a[tt]); } }
        float rr = 0.f;
#pragma unroll
        for (int tt = 0; tt < 8; ++tt) { const float r = rscale_of(SSQ + vz, t0 + tt); if (lane == tt) rr = r; if (lane < 36) lgs[tt * 40 + lane] = a[tt] * r + bias; }
        LDS_WAIT(); asm volatile("" ::: "memory");
        if (lane < 8) {
            const int t = t0 + lane; const LAS float* lp = lgs + lane * 40;
            float mxv = -1e30f; int gs = 0; float l4[4];
#pragma unroll
            for (int i = 0; i < 4; ++i) { l4[i] = lp[i]; if (l4[i] > mxv) { mxv = l4[i]; gs = i; } }
            float se = 0.f;
#pragma unroll
            for (int i = 0; i < 4; ++i) se += __expf(l4[i] - mxv);
            const float pg = 1.0f / se;
            float v1 = -1e30f, v2 = -1e30f; int i1 = 0, i2 = 0;
#pragma unroll
            for (int i = 0; i < 8; ++i) { const float v = lp[4 + gs * 8 + i]; if (v > v1) { v2 = v1; i2 = i1; v1 = v; i1 = i; } else if (v > v2) { v2 = v; i2 = i; } }
            const float e2 = __expf(v2 - v1), s1 = 1.0f / (1.0f + e2);
            const int ea = gs * 8 + i1, eb = gs * 8 + i2;
            const unsigned ia = atomicAdd(cnt + ea, 1u), ib = atomicAdd(cnt + eb, 1u);
            v4u r0, r1; r0.x = (unsigned)ea; r0.y = (unsigned)eb; r0.z = ia; r0.w = ib; r1.x = __float_as_uint(pg * s1); r1.y = __float_as_uint(pg * e2 * s1); r1.z = __float_as_uint(rr); r1.w = 0u;
            *(GAS v4u*)(ROUTE + (size_t)t * 8) = r0; *(GAS v4u*)(ROUTE + (size_t)t * 8 + 4) = r1;
        }
        LDS_WAIT(); asm volatile("" ::: "memory");
    }
}
__device__ __forceinline__ void moe_offsets(Frame& F, int L) {
    volatile LAS int* offs = (volatile LAS int*)(F.lds + OFFS_OFF);
    __syncthreads();
    if (F.tid == 0) { int acc = 0;
        for (int e = 0; e < NEXP; ++e) { offs[e] = acc; const unsigned c = __hip_atomic_load(F.ctl + CW_CNT + 64 * L + e, RLX_AGENT); acc += (int)((c + 255u) & ~255u); }
        offs[NEXP] = acc; }
    __syncthreads();
}
__device__ __forceinline__ void dispatch_phase(Frame& F, int L) {
    moe_offsets(F, L);
    const volatile LAS int* offs = (const volatile LAS int*)(F.lds + OFFS_OFF);
    const bf16* XB = WSP(bf16, WS_XB); bf16* XG = WSP(bf16, WS_XG); const int* ROUTE = WSP(int, WS_ROUTE); int* POS = WSP(int, WS_POS); float* RSC = WSP(float, WS_RSC); float* ROWG = WSP(float, WS_ROWG);
    const int lane = F.lane, gw = F.vcu * NWAVES + F.wave, NGW = F.G * NWAVES;
    int vz = 0; asm volatile("" : "+v"(vz));
    for (int t = gw; t < M; t += NGW) {
        const v4u r0 = *(const GAS v4u*)(ROUTE + (size_t)t * 8 + vz), r1 = *(const GAS v4u*)(ROUTE + (size_t)t * 8 + 4 + vz);
        const int s0 = offs[r0.x] + (int)r0.z, s1 = offs[r0.y] + (int)r0.w;
        const GAS v4u* src = (const GAS v4u*)(XB + (size_t)t * DM) + lane; const v4u a = src[0], b = src[64];
        GAS v4u* d0 = (GAS v4u*)(XG + (size_t)s0 * DM) + lane; GAS v4u* d1 = (GAS v4u*)(XG + (size_t)s1 * DM) + lane;
        d0[0] = a; d0[64] = b; d1[0] = a; d1[64] = b;
        if (lane == 0) { POS[2 * t] = s0; POS[2 * t + 1] = s1; RSC[s0] = __uint_as_float(r1.z); RSC[s1] = __uint_as_float(r1.z); ROWG[s0] = __uint_as_float(r1.x); ROWG[s1] = __uint_as_float(r1.y); }
    }
}
__device__ __forceinline__ void combine_phase(Frame& F, int L) {
    float* X = F.out; bf16* XB = WSP(bf16, WS_XB); const bf16* Y = WSP(bf16, WS_Y); const int* POS = WSP(int, WS_POS); float* SSQ = WSP(float, WS_SSQ + (size_t)(3 * L + 2) * MiB);
    const int lane = F.lane, gw = F.vcu * NWAVES + F.wave, NGW = F.G * NWAVES;
    int vz = 0; asm volatile("" : "+v"(vz));
    for (int t = gw; t < M; t += NGW) {
        const int s0 = POS[2 * t + vz], s1 = POS[2 * t + 1 + vz];
        GAS f32x4* xr = (GAS f32x4*)(X + (size_t)t * DM) + lane; const GAS v2u* y0 = (const GAS v2u*)(Y + (size_t)s0 * DM) + lane; const GAS v2u* y1 = (const GAS v2u*)(Y + (size_t)s1 * DM) + lane;
        GAS v2u* xb = (GAS v2u*)(XB + (size_t)t * DM) + lane; float s = 0.f;
#pragma unroll
        for (int j = 0; j < 4; ++j) { f32x4 v = xr[64 * j]; const v2u a = y0[64 * j], b = y1[64 * j];
            v[0] += bf_lo(a.x) + bf_lo(b.x); v[1] += bf_hi(a.x) + bf_hi(b.x); v[2] += bf_lo(a.y) + bf_lo(b.y); v[3] += bf_hi(a.y) + bf_hi(b.y);
            xr[64 * j] = v; v2u w; w.x = cvt_pk_bf16(v[0], v[1]); w.y = cvt_pk_bf16(v[2], v[3]); xb[64 * j] = w;
            s += (v[0] * v[0] + v[1] * v[1]) + (v[2] * v[2] + v[3] * v[3]); }
        const float tot = wave_sum(s);
        if (lane < 16) SSQ[(size_t)t * 16 + lane] = lane == 0 ? tot : 0.f;
    }
}
__device__ __forceinline__ void final_norm_phase(Frame& F, const Args& args) {
    float* X = F.out; const float* g = args.in[23];
    const int lane = F.lane, gw = F.vcu * NWAVES + F.wave, NGW = F.G * NWAVES;
    for (int t = gw; t < M; t += NGW) {
        GAS f32x4* xr = (GAS f32x4*)(X + (size_t)t * DM) + lane; f32x4 v[4]; float s = 0.f;
#pragma unroll
        for (int j = 0; j < 4; ++j) { v[j] = xr[64 * j]; s += (v[j][0] * v[j][0] + v[j][1] * v[j][1]) + (v[j][2] * v[j][2] + v[j][3] * v[j][3]); }
        const float r = rsqrtf(wave_sum(s) * (1.0f / DM) + EPS);
#pragma unroll
        for (int j = 0; j < 4; ++j) { const f32x4 gv = *((const f32x4*)g + lane + 64 * j); xr[64 * j] = v[j] * r * gv; }
    }
}
#ifndef MK_DUP
#define MK_DUP (-1)
#endif
#ifdef MK_REFGEMM
#define GEMM_BODY gemm_phase_ref
#else
#define GEMM_BODY gemm_phase
#endif
#ifndef MK_EN
#define MK_EN 0xfff
#endif
__global__ void __launch_bounds__(NWAVES * 64, 2) mk_fwd(Args args) {
    extern __shared__ __attribute__((aligned(16))) unsigned char lds[];
    Frame F;
    F.lds = (LAS unsigned char*)lds;
    F.MISC = (volatile LAS unsigned*)(F.lds + MISC_OFF);
    F.tid = threadIdx.x; F.lane = F.tid & 63; F.wave = __builtin_amdgcn_readfirstlane(F.tid >> 6);
    F.G = gridDim.x; { const int bx = blockIdx.x; F.vcu = (F.G % 8 == 0) ? (bx % 8) * (F.G / 8) + bx / 8 : bx; }
    F.ws = args.ws; F.out = args.out; F.ctl = (gu32*)(args.ws + WS_CTL);
    for (int u = F.tid; u < (LDS_BYTES - LDSCTL_OFF) / 4; u += NWAVES * 64) ((LAS unsigned*)(F.lds + LDSCTL_OFF))[u] = 0u;
    __syncthreads();
    XcdBarrier bar; bar.bar = (unsigned*)(F.ctl + CW_BAR); bar.x = 0; bar.st = nullptr;
    if (args.use_bar) bar = xcd_barrier_post((unsigned*)(F.ctl + CW_BAR), F.MISC + 8);
    const int cblk = (int)blockIdx.x;
#define PHASE_SEAM(ph_) do { if ((ph_) + 1 < args.ph_hi) { if (args.use_bar) { xcd_barrier(bar); } else { VM_WAIT(); __syncthreads(); } } } while (0)
    int ph0 = args.ph_lo;
    if (ph0 == 0 && (MK_EN & 1)) { p0_prologue(F, args); if (MK_DUP == 0) { xcd_barrier(bar); p0_prologue(F, args); } PHASE_SEAM(0); ph0 = 1; }
    for (int ph = ph0; ph < args.ph_hi; ++ph) {
      for (int rep_ = (ph == MK_DUP ? 2 : 1); rep_ > 0; --rep_) {
        { int t_ = threadIdx.x; asm volatile("" : "+v"(t_)); F.tid = t_; F.lane = t_ & 63; F.wave = __builtin_amdgcn_readfirstlane(t_ >> 6); }
        if (ph == PH_FINAL && (MK_EN & 2)) {
            final_norm_phase(F, args);
        } else {
            const int L = (ph - 1) / PH_PER_LAYER, sub = (ph - 1) % PH_PER_LAYER;
            const char* wl = (const char*)(F.ws + WS_W + (size_t)L * W_LAYER);
            float* SSQ0 = WSP(float, WS_SSQ + (size_t)(3 * L) * MiB);
            if (sub == 0 && (MK_EN & (4 << 0))) {
                SchedGrid S{64, 18, F.G, cblk, (const char*)WSP(bf16, WS_XB), wl + WO_WIN, (size_t)256 * 1024 * 2, (size_t)256 * 1024 * 2};
                EpiP1 E{SSQ0, WSP(float, WS_COS), WSP(float, WS_SIN), WSP(bf16, WS_Q), WSP(bf16, WS_K), WSP(bf16, WS_V), WSP(bf16, WS_U), WSP(bf16, WS_SGA), WSP(bf16, WS_SGB)};
                pg8::GEMM_BODY<EpiP1, SchedGrid, true>(F.lds + RING_OFF, pg8::Dims{1024, 1024, 1024}, S, E);
            } else if (sub == 1 && (MK_EN & (4 << 1))) {
#ifdef MK_ATTN_SIMPLE
                attn_simple(F);
#else
                attn_mfma(F); __syncthreads();
#endif
                conv_simple(F, args, L);
            } else if (sub == 2 && (MK_EN & (4 << 2))) {
                SchedP3 S{F.G, cblk, (const char*)WSP(bf16, WS_OC), wl + WO_WAO, wl + WO_WCO};
                EpiP3 E{WSP(bf16, WS_SGA), WSP(bf16, WS_SGB), args.in[10] + L * DM, WSP(bf16, WS_MG)};
                pg8::GEMM_BODY<EpiP3, SchedP3, true>(F.lds + RING_OFF, pg8::Dims{512, 1024, 512}, S, E);
            } else if (sub == 3 && (MK_EN & (4 << 3))) {
                SchedGrid S{64, 4, F.G, cblk, (const char*)WSP(bf16, WS_MG), wl + WO_WOUT, (size_t)256 * 1024 * 2, (size_t)256 * 1024 * 2};
                EpiP4 E{L == 0 ? args.in[0] : F.out, F.out, WSP(bf16, WS_XB), WSP(float, WS_SSQ + (size_t)(3 * L + 1) * MiB)};
                pg8::GEMM_BODY<EpiP4, SchedGrid, false>(F.lds + RING_OFF, pg8::Dims{1024, 1024, 1024}, S, E);
            } else if (sub == 4 && (MK_EN & (4 << 4))) {
                route_phase(F, args, L);
                __syncthreads();
                SchedGrid S{64, 4, F.G, cblk, (const char*)(WSP(bf16, WS_PB) + (size_t)L * M * PLE), wl + WO_WPP, (size_t)256 * 256 * 2, (size_t)256 * 256 * 2};
                EpiBf16 E{WSP(bf16, WS_PE), DM};
                pg8::GEMM_BODY<EpiBf16, SchedGrid, false>(F.lds + RING_OFF, pg8::Dims{256, 256, 256}, S, E);
            } else if (sub == 5 && (MK_EN & (4 << 5))) {
                dispatch_phase(F, L);
            } else if (sub == 6 && (MK_EN & (4 << 6))) {
                moe_offsets(F, L);
                SchedMoe S{(const volatile LAS int*)(F.lds + OFFS_OFF), F.G, cblk, 1, (const char*)WSP(bf16, WS_XG), wl + WO_WGU};
                EpiUp E{WSP(float, WS_RSC), WSP(bf16, WS_H)};
                pg8::GEMM_BODY<EpiUp, SchedMoe, true>(F.lds + RING_OFF, pg8::Dims{1024, 1024, 1024}, S, E);
            } else if (sub == 7 && (MK_EN & (4 << 7))) {
                moe_offsets(F, L);
                SchedMoe S{(const volatile LAS int*)(F.lds + OFFS_OFF), F.G, cblk, 0, (const char*)WSP(bf16, WS_H), wl + WO_WD};
                EpiDown E{WSP(float, WS_ROWG), WSP(bf16, WS_Y)};
                pg8::GEMM_BODY<EpiDown, SchedMoe, true>(F.lds + RING_OFF, pg8::Dims{512, 512, 512}, S, E);
            } else if (sub == 8 && (MK_EN & (4 << 8))) {
                combine_phase(F, L);
            } else if (MK_EN & (4 << 9)) {
                SchedGrid S{64, 4, F.G, cblk, (const char*)WSP(bf16, WS_XB), wl + WO_WPG, (size_t)256 * 1024 * 2, (size_t)256 * 1024 * 2};
                EpiP8 E{WSP(float, WS_SSQ + (size_t)(3 * L + 2) * MiB), WSP(bf16, WS_PE), F.out, F.out, WSP(bf16, WS_XB), WSP(float, WS_SSQ + (size_t)(3 * L + 3) * MiB)};
                pg8::GEMM_BODY<EpiP8, SchedGrid, false>(F.lds + RING_OFF, pg8::Dims{1024, 1024, 1024}, S, E);
            }
        }
        if (rep_ > 1) xcd_barrier(bar);
      }
        PHASE_SEAM(ph);
    }
}

#ifndef MK_OPT_PHASES
#define MK_OPT_PHASES 22
#endif
#ifndef MK_REPEAT
#define MK_REPEAT 1
#endif
#ifndef MK_SINGLE
#define MK_SINGLE 0
#endif
#if MK_OPT_PHASES < 22
static void naive_tail(hipStream_t stream, void* const* d_in, float* X, float* out, char* ws, int L0, int st0) {
    using namespace naive;
    const float* p = (const float*)d_in[1]; const float* norm_mix = (const float*)d_in[2]; const float* w_in = (const float*)d_in[3];
    const float* w_dw = (const float*)d_in[4]; const float* b_dw = (const float*)d_in[5]; const float* ln_g = (const float*)d_in[6]; const float* ln_b = (const float*)d_in[7];
    const float* w_ao = (const float*)d_in[8]; const float* w_co = (const float*)d_in[9]; const float* b_co = (const float*)d_in[10]; const float* w_out = (const float*)d_in[11];
    const float* norm_ffn = (const float*)d_in[12]; const float* w_rg = (const float*)d_in[13]; const float* b_rg = (const float*)d_in[14]; const float* w_re = (const float*)d_in[15]; const float* b_re = (const float*)d_in[16];
    const float* w_eg = (const float*)d_in[17]; const float* w_eu = (const float*)d_in[18]; const float* w_ed = (const float*)d_in[19];
    const float* norm_ple = (const float*)d_in[20]; const float* w_pp = (const float*)d_in[21]; const float* w_pg = (const float*)d_in[22]; const float* norm_final = (const float*)d_in[23];
    constexpr size_t MiB_ = 1u << 20;
    float* Hn = (float*)(ws + 0 * MiB_); float* QKV = (float*)(ws + 64 * MiB_); float* CUG = (float*)(ws + 160 * MiB_); float* GAB = (float*)(ws + 224 * MiB_);
    float* AO = (float*)(ws + 352 * MiB_); float* CO = (float*)(ws + 384 * MiB_);
    float* YA = Hn; float* YB = QKV;
    float* LG = CUG; float* LE = CUG + (size_t)M_ * 4; int* EID = (int*)(CUG + (size_t)M_ * 40); float* GT = CUG + (size_t)M_ * 48;
    float* GL = GAB; float* PE = QKV;
    for (int L = L0; L < DEPTH_; ++L) {
        const int s0 = (L == L0) ? st0 : 0;
        if (s0 <= 0) {
            hipLaunchKernelGGL(rmsnorm_k, dim3(M_ / 4), dim3(256), 0, stream, X, norm_mix + L * D_, Hn);
            const float* win = w_in + (size_t)L * D_ * WIN_;
            sgemm(stream, Hn, D_, win, WIN_, QKV, 1536, M_, 1536, D_, nullptr, nullptr);
            sgemm(stream, Hn, D_, win + 1536, WIN_, CUG, 1024, M_, 1024, D_, nullptr, nullptr);
            sgemm(stream, Hn, D_, win + 2560, WIN_, GAB, 2048, M_, 2048, D_, nullptr, nullptr);
            hipLaunchKernelGGL(rope_k, dim3(M_ * 2 * H_ * 32 / 256), dim3(256), 0, stream, QKV);
            hipLaunchKernelGGL(attn_naive_k, dim3(M_ * H_ / 4), dim3(256), 0, stream, QKV, AO);
            hipLaunchKernelGGL(conv_naive_k, dim3(M_), dim3(512), 0, stream, CUG, w_dw + (size_t)L * CK_ * CW_, b_dw + L * CW_, ln_g + L * CW_, ln_b + L * CW_, CO);
            sgemm(stream, AO, 512, w_ao + (size_t)L * 512 * D_, D_, YA, D_, M_, D_, 512, nullptr, nullptr);
            sgemm(stream, CO, 512, w_co + (size_t)L * 512 * D_, D_, YB, D_, M_, D_, 512, b_co + L * D_, nullptr);
            hipLaunchKernelGGL(merge_k, dim3(M_ * D_ / 256), dim3(256), 0, stream, GAB, YA, YB);
            sgemm(stream, GAB, 2048, w_out + (size_t)L * D_ * D_, D_, X, D_, M_, D_, D_, nullptr, X);
        }
        if (s0 <= 1) {
            hipLaunchKernelGGL(rmsnorm_k, dim3(M_ / 4), dim3(256), 0, stream, X, norm_ffn + L * D_, Hn);
            sgemm(stream, Hn, D_, w_rg + (size_t)L * D_ * NG_, NG_, LG, 4, M_, 4, D_, b_rg + L * NG_, nullptr);
            sgemm(stream, Hn, D_, w_re + (size_t)L * D_ * NE_, NE_, LE, 32, M_, 32, D_, b_re + L * NE_, nullptr);
            hipLaunchKernelGGL(route_k, dim3(M_ / 256), dim3(256), 0, stream, LG, LE, EID, GT);
            hipLaunchKernelGGL(moe_naive_k, dim3(M_), dim3(256), 0, stream, Hn, EID, GT, w_eg + (size_t)L * NE_ * D_ * FF_, w_eu + (size_t)L * NE_ * D_ * FF_, w_ed + (size_t)L * NE_ * FF_ * D_, X);
        }
        if (s0 <= 2) {
            hipLaunchKernelGGL(rmsnorm_k, dim3(M_ / 4), dim3(256), 0, stream, X, norm_ple + L * D_, Hn);
            sgemm(stream, Hn, D_, w_pg + (size_t)L * D_ * D_, D_, GL, D_, M_, D_, D_, nullptr, nullptr);
            sgemm(stream, p + (size_t)L * M_ * PLE_, PLE_, w_pp + (size_t)L * PLE_ * D_, D_, PE, D_, M_, D_, PLE_, nullptr, nullptr);
            hipLaunchKernelGGL(ple_k, dim3(M_ * D_ / 256), dim3(256), 0, stream, X, GL, PE);
        }
    }
    hipLaunchKernelGGL(rmsnorm_k, dim3(M_ / 4), dim3(256), 0, stream, X, norm_final, out);
}
#endif


#if MK_OPT_PHASES < 22
namespace dbg {
__device__ __forceinline__ float b2f(unsigned short u) { return __uint_as_float((unsigned)u << 16); }
__global__ void __launch_bounds__(256) cvt_qkv_k(const unsigned short* Q, const unsigned short* K, const unsigned short* V, float* qkv) {
    const size_t idx = (size_t)blockIdx.x * 256 + threadIdx.x;
    const int tok = (int)(idx >> 9), col = (int)(idx & 511), h = col >> 6, d = col & 63, b = tok >> 11, t = tok & 2047;
    const size_t src = ((size_t)(b * 8 + h) * 2048 + t) * 64 + d;
    qkv[(size_t)tok * 1536 + col] = b2f(Q[src]) * (1.0f / (0.125f * 1.4426950408889634f));
    qkv[(size_t)tok * 1536 + 512 + col] = b2f(K[src]);
    qkv[(size_t)tok * 1536 + 1024 + col] = b2f(V[src]);
}
__global__ void __launch_bounds__(512) conv_from_u_k(const unsigned short* __restrict__ U, const float* __restrict__ wdw, const float* __restrict__ bdw,
                                                     const float* __restrict__ lg, const float* __restrict__ lb, float* __restrict__ co) {
    __shared__ float red[16];
    const int tok = blockIdx.x, c = threadIdx.x, t = tok % 2048;
    float y = bdw[c];
    for (int j = 0; j < 31; ++j) { const int tt = t - 30 + j; if (tt >= 0) y += wdw[j * 512 + c] * b2f(U[(size_t)(tok - 30 + j) * 512 + c]); }
    float s = naive::wave_sum(y);
    if ((c & 63) == 0) red[c >> 6] = s;
    __syncthreads();
    float mu = 0.f;
    for (int i = 0; i < 8; ++i) mu += red[i];
    mu *= (1.f / 512.f);
    const float dv = y - mu;
    float s2 = naive::wave_sum(dv * dv);
    if ((c & 63) == 0) red[8 + (c >> 6)] = s2;
    __syncthreads();
    float var = 0.f;
    for (int i = 0; i < 8; ++i) var += red[8 + i];
    var *= (1.f / 512.f);
    const float yn = dv * rsqrtf(var + 1e-6f) * lg[c] + lb[c];
    co[(size_t)tok * 512 + c] = yn / (1.f + expf(-yn));
}
__global__ void __launch_bounds__(256) merge_sig_k(const unsigned short* sga, const unsigned short* sgb, const float* ya, const float* yb, float* mg) {
    const size_t idx = (size_t)blockIdx.x * 256 + threadIdx.x;
    mg[idx] = b2f(sga[idx]) * ya[idx] + b2f(sgb[idx]) * yb[idx];
}
__global__ void __launch_bounds__(256) cvt_oc_k(const unsigned short* oc, float* ao, float* co) {
    const size_t idx = (size_t)blockIdx.x * 256 + threadIdx.x;
    const size_t m = idx >> 10; const int n = (int)(idx & 1023);
    const float v = b2f(oc[idx]);
    if (n < 512) ao[m * 512 + n] = v; else co[m * 512 + n - 512] = v;
}
__global__ void __launch_bounds__(256) cvt_bf_k(const unsigned short* src, float* dst) {
    const size_t idx = (size_t)blockIdx.x * 256 + threadIdx.x; dst[idx] = b2f(src[idx]);
}
}
static void dbg_mixer_tail(hipStream_t stream, void* const* d_in, float* X, char* ws, int nopt) {
    using namespace naive;
    constexpr size_t MiB_ = 1u << 20;
    const float* w_dw = (const float*)d_in[4]; const float* b_dw = (const float*)d_in[5]; const float* ln_g = (const float*)d_in[6]; const float* ln_b = (const float*)d_in[7];
    const float* w_ao = (const float*)d_in[8]; const float* w_co = (const float*)d_in[9]; const float* b_co = (const float*)d_in[10]; const float* w_out = (const float*)d_in[11];
    float* Hn = (float*)(ws + 0 * MiB_); float* QKV = (float*)(ws + 64 * MiB_); float* YBb = (float*)(ws + 160 * MiB_); float* MGf = (float*)(ws + 224 * MiB_);
    float* AO = (float*)(ws + 288 * MiB_); float* CO = (float*)(ws + 320 * MiB_);
    const unsigned short* Qb = (const unsigned short*)(ws + WS_Q); const unsigned short* Kb = (const unsigned short*)(ws + WS_K); const unsigned short* Vb = (const unsigned short*)(ws + WS_V);
    const unsigned short* Ub = (const unsigned short*)(ws + WS_U); const unsigned short* SGAb = (const unsigned short*)(ws + WS_SGA); const unsigned short* SGBb = (const unsigned short*)(ws + WS_SGB);
    const unsigned short* OCb = (const unsigned short*)(ws + WS_OC); const unsigned short* MGb = (const unsigned short*)(ws + WS_MG);
    (void)hipMemcpyAsync(X, d_in[0], (size_t)M_ * D_ * 4, hipMemcpyDeviceToDevice, stream);
    if (nopt == 2) {
        hipLaunchKernelGGL(dbg::cvt_qkv_k, dim3(M_ * 512 / 256), dim3(256), 0, stream, Qb, Kb, Vb, QKV);
        hipLaunchKernelGGL(attn_naive_k, dim3(M_ * H_ / 4), dim3(256), 0, stream, QKV, AO);
        hipLaunchKernelGGL(dbg::conv_from_u_k, dim3(M_), dim3(512), 0, stream, Ub, w_dw, b_dw, ln_g, ln_b, CO);
    } else if (nopt == 3) {
        hipLaunchKernelGGL(dbg::cvt_oc_k, dim3(M_ * D_ / 256), dim3(256), 0, stream, OCb, AO, CO);
    }
    if (nopt <= 3) {
        sgemm(stream, AO, 512, w_ao, D_, Hn, D_, M_, D_, 512, nullptr, nullptr);
        sgemm(stream, CO, 512, w_co, D_, YBb, D_, M_, D_, 512, b_co, nullptr);
        hipLaunchKernelGGL(dbg::merge_sig_k, dim3(M_ * D_ / 256), dim3(256), 0, stream, SGAb, SGBb, Hn, YBb, MGf);
    } else {
        hipLaunchKernelGGL(dbg::cvt_bf_k, dim3(M_ * D_ / 256), dim3(256), 0, stream, MGb, MGf);
    }
    sgemm(stream, MGf, D_, w_out, D_, X, D_, M_, D_, D_, nullptr, X);
}
#endif

#if MK_OPT_PHASES < 22
namespace dbg {
__global__ void __launch_bounds__(256) hash_k(const unsigned* buf, size_t nwords, unsigned* out) {
    unsigned acc = 0u;
    for (size_t i = (size_t)blockIdx.x * 256 + threadIdx.x; i < nwords; i += (size_t)gridDim.x * 256) acc += buf[i] * (2654435761u * (unsigned)(2 * i + 1)) + (unsigned)i;
    for (int o = 1; o < 64; o <<= 1) acc += __shfl_xor(acc, o);
    if ((threadIdx.x & 63) == 0) atomicAdd(out, acc);
}
__global__ void __launch_bounds__(256) perturb_k(float* out, size_t first, size_t count, const unsigned* hash) {
    const size_t i = (size_t)blockIdx.x * 256 + threadIdx.x;
    if (i < count) out[first + i] += (float)(hash[0] >> 8) * (1.0f / 16777216.0f);
}
}
static void dbg_hash(hipStream_t st, const void* buf, size_t bytes, unsigned* cell) { hipLaunchKernelGGL(dbg::hash_k, dim3(1024), dim3(256), 0, st, (const unsigned*)buf, bytes / 4, cell); }
#endif

#if MK_OPT_PHASES < 22
#ifndef DBG_USE
#define DBG_USE 7
#endif
static void dbg_p1_tail(hipStream_t stream, void* const* d_in, float* X, char* ws) {
    using namespace naive;
    constexpr size_t MiB_ = 1u << 20;
    const float* norm_mix = (const float*)d_in[2]; const float* w_in = (const float*)d_in[3];
    const float* w_dw = (const float*)d_in[4]; const float* b_dw = (const float*)d_in[5]; const float* ln_g = (const float*)d_in[6]; const float* ln_b = (const float*)d_in[7];
    const float* w_ao = (const float*)d_in[8]; const float* w_co = (const float*)d_in[9]; const float* b_co = (const float*)d_in[10]; const float* w_out = (const float*)d_in[11];
    float* Hn = (float*)(ws + 0 * MiB_); float* QKV = (float*)(ws + 64 * MiB_); float* CUG = (float*)(ws + 160 * MiB_); float* GAB = (float*)(ws + 224 * MiB_);
    float* AO = (float*)(ws + 480 * MiB_); float* CO = (float*)(ws + 64 * MiB_); float* YA = Hn; float* YB = (float*)(ws + 96 * MiB_); float* MGf = (float*)(ws + 160 * MiB_);
    const unsigned short* Qb = (const unsigned short*)(ws + WS_Q); const unsigned short* Kb = (const unsigned short*)(ws + WS_K); const unsigned short* Vb = (const unsigned short*)(ws + WS_V);
    const unsigned short* Ub = (const unsigned short*)(ws + WS_U); const unsigned short* SGAb = (const unsigned short*)(ws + WS_SGA); const unsigned short* SGBb = (const unsigned short*)(ws + WS_SGB);
    (void)hipMemcpyAsync(X, d_in[0], (size_t)M_ * D_ * 4, hipMemcpyDeviceToDevice, stream);
    hipLaunchKernelGGL(rmsnorm_k, dim3(M_ / 4), dim3(256), 0, stream, X, norm_mix, Hn);
    if (DBG_USE & 1) hipLaunchKernelGGL(dbg::cvt_qkv_k, dim3(M_ * 512 / 256), dim3(256), 0, stream, Qb, Kb, Vb, QKV);
    else { sgemm(stream, Hn, D_, w_in, WIN_, QKV, 1536, M_, 1536, D_, nullptr, nullptr); hipLaunchKernelGGL(rope_k, dim3(M_ * 2 * H_ * 32 / 256), dim3(256), 0, stream, QKV); }
    if (!(DBG_USE & 2)) sgemm(stream, Hn, D_, w_in + 1536, WIN_, CUG, 1024, M_, 1024, D_, nullptr, nullptr);
    if (!(DBG_USE & 4)) sgemm(stream, Hn, D_, w_in + 2560, WIN_, GAB, 2048, M_, 2048, D_, nullptr, nullptr);
    hipLaunchKernelGGL(attn_naive_k, dim3(M_ * H_ / 4), dim3(256), 0, stream, QKV, AO);
    if (DBG_USE & 2) hipLaunchKernelGGL(dbg::conv_from_u_k, dim3(M_), dim3(512), 0, stream, Ub, w_dw, b_dw, ln_g, ln_b, CO);
    else hipLaunchKernelGGL(conv_naive_k, dim3(M_), dim3(512), 0, stream, CUG, w_dw, b_dw, ln_g, ln_b, CO);
    sgemm(stream, AO, 512, w_ao, D_, YA, D_, M_, D_, 512, nullptr, nullptr);
    sgemm(stream, CO, 512, w_co, D_, YB, D_, M_, D_, 512, b_co, nullptr);
    if (DBG_USE & 4) { hipLaunchKernelGGL(dbg::merge_sig_k, dim3(M_ * D_ / 256), dim3(256), 0, stream, SGAb, SGBb, YA, YB, MGf); sgemm(stream, MGf, D_, w_out, D_, X, D_, M_, D_, D_, nullptr, X); }
    else { hipLaunchKernelGGL(merge_k, dim3(M_ * D_ / 256), dim3(256), 0, stream, GAB, YA, YB); sgemm(stream, GAB, 2048, w_out, D_, X, D_, M_, D_, D_, nullptr, X); }
}
#endif

extern "C" void kernel_launch(void* const* d_in, const int* in_sizes, int n_in, void* d_out, int out_size, void* d_ws, size_t ws_size, hipStream_t stream) {
    static int grid = 0;
    if (grid == 0) {
        if (n_in != 24 || in_sizes[0] != M * DM || out_size != M * DM || ws_size < WS_END) { fprintf(stderr, "kernel_launch: unexpected shapes (n_in %d, in0 %d, out %d, ws %zu); nothing launched\n", n_in, n_in > 0 ? in_sizes[0] : -1, out_size, ws_size); grid = -1; return; }
        int dev = 0, cus = 0, per_cu = 0;
        if (hipGetDevice(&dev) != hipSuccess || hipDeviceGetAttribute(&cus, hipDeviceAttributeMultiprocessorCount, dev) != hipSuccess) { fprintf(stderr, "kernel_launch: device query failed\n"); grid = -1; return; }
        if (hipFuncSetAttribute((const void*)mk_fwd, hipFuncAttributeMaxDynamicSharedMemorySize, LDS_BYTES) != hipSuccess) { fprintf(stderr, "kernel_launch: hipFuncSetAttribute failed\n"); grid = -1; return; }
        if (hipOccupancyMaxActiveBlocksPerMultiprocessor(&per_cu, (const void*)mk_fwd, NWAVES * 64, LDS_BYTES) != hipSuccess || per_cu < 1) { fprintf(stderr, "kernel_launch: occupancy query reports %d blocks per CU\n", per_cu); }
        (void)hipGetLastError();
        grid = cus;
    }
    if (grid < 0) return;
    (void)hipMemsetAsync((char*)d_ws + WS_CTL, 0, CTL_ZERO_BYTES, stream);
    Args a{};
    for (int i = 0; i < 24; ++i) a.in[i] = (const float*)d_in[i];
    a.out = (float*)d_out; a.ws = (unsigned char*)d_ws;
    constexpr int NOPT = MK_OPT_PHASES;
#if MK_SINGLE
    a.ph_lo = 0; a.ph_hi = NOPT; a.use_bar = 1;
    hipLaunchKernelGGL(mk_fwd, dim3(grid), dim3(NWAVES * 64), LDS_BYTES, stream, a);
#else
    for (int rep = 0; rep < MK_REPEAT; ++rep)
    for (int ph = 0; ph < NOPT; ++ph) { a.ph_lo = ph; a.ph_hi = ph + 1; a.use_bar = 0; hipLaunchKernelGGL(mk_fwd, dim3(grid), dim3(NWAVES * 64), LDS_BYTES, stream, a); }
#endif
#if defined(MK_PROBE)
    {
        constexpr size_t MiB_ = 1u << 20; char* ws = (char*)d_ws; unsigned* cells = (unsigned*)(ws + 520 * MiB_);
        (void)hipMemsetAsync(cells, 0, 256, stream);
        MK_PROBE
        (void)hipMemcpyAsync(d_out, d_in[0], (size_t)M * DM * 4, hipMemcpyDeviceToDevice, stream);
        naive_tail(stream, d_in, (float*)d_out, (float*)d_out, (char*)d_ws, 0, 0);
        hipLaunchKernelGGL(dbg::perturb_k, dim3((1u << 22) / 256), dim3(256), 0, stream, (float*)d_out, (size_t)0, (size_t)1 << 22, cells);
        hipLaunchKernelGGL(dbg::perturb_k, dim3((1u << 16) / 256), dim3(256), 0, stream, (float*)d_out, (size_t)1 << 23, (size_t)1 << 16, cells + 16);
    }
#elif MK_OPT_PHASES < 22
    {
        int L0 = 0, st0 = 0;
        if (NOPT <= 1) { (void)hipMemcpyAsync(d_out, d_in[0], (size_t)M * DM * 4, hipMemcpyDeviceToDevice, stream); }
        else if (NOPT == 2) { dbg_p1_tail(stream, d_in, (float*)d_out, (char*)d_ws); L0 = 0; st0 = 1; }
        else if (NOPT >= 3 && NOPT <= 4) { dbg_mixer_tail(stream, d_in, (float*)d_out, (char*)d_ws, NOPT); L0 = 0; st0 = 1; }
        else if (NOPT == 5) { L0 = 0; st0 = 1; } else if (NOPT == 10) { L0 = 0; st0 = 2; } else if (NOPT == 11) { L0 = 1; st0 = 0; }
        else if (NOPT == 15) { L0 = 1; st0 = 1; } else if (NOPT == 20) { L0 = 1; st0 = 2; } else if (NOPT == 21) { L0 = 2; st0 = 0; }
        naive_tail(stream, d_in, (float*)d_out, (float*)d_out, (char*)d_ws, L0, st0);
    }
#endif
}
```

```cpp
#define MK_OPT_PHASES 22
#define MK_SINGLE 1
#include <hip/hip_runtime.h>
#include <cstdio>
#include <cstdint>
#include <cmath>
namespace pg8 {
#define PG8_LAS __attribute__((address_space(3)))
typedef unsigned short bf16_t;
typedef short bf16x8 __attribute__((ext_vector_type(8)));
typedef float f32x4 __attribute__((ext_vector_type(4)));
typedef float f32x2 __attribute__((ext_vector_type(2)));
typedef unsigned u32x4 __attribute__((ext_vector_type(4)));
typedef unsigned u32x2 __attribute__((ext_vector_type(2)));
constexpr int BM = 256, BK = 64, HALF = 128, HTB = HALF * BK * 2  , STAGE_BYTES = 8 * HTB, NXCD = 8, WGM = 8;

__host__ __device__ __forceinline__ int lds_byte(int r, int c) { const int st = (r >> 4) * 2 + (c >> 5), rr = r & 15, cc = c & 31, ob = rr * 64 + cc * 2; return st * 1024 + (ob ^ (((ob >> 9) & 1) << 5)); }
__host__ __device__ __forceinline__ void stage_rc(int b, int& R, int& C) { const int st = b / 1024, sb = b % 1024, swz = sb ^ (((sb >> 9) & 1) << 5); R = (st >> 1) * 16 + swz / 64; C = (st & 1) * 32 + (swz % 64) / 2; }
__host__ __device__ __forceinline__ int perm32(int rho) { const int n = rho >> 4, i = rho & 15; return 8 * (i >> 2) + 4 * n + (i & 3); }

struct Unit { int pm, pn, aux; const char* A; const char* B; };
struct Dims { int K, lda, ldb; };

__host__ __device__ __forceinline__ void tile_of(int L, int nM, int nN, int& pm, int& pn) {
    const int nwg = nM * nN; int wgid = L; { const int q = nwg / NXCD, r = nwg % NXCD, xcd = wgid % NXCD, off = wgid / NXCD; wgid = (xcd < r ? xcd * (q + 1) : r * (q + 1) + (xcd - r) * q) + off; }
    const int nig = WGM * nN, gid = wgid / nig, fm = gid * WGM, gsz = (nM - fm) < WGM ? (nM - fm) : WGM;
    pm = fm + ((wgid % nig) % gsz); pn = (wgid % nig) / gsz;
}

typedef __bf16 bf16x2v __attribute__((ext_vector_type(2)));
__device__ __forceinline__ unsigned cvt_pk_bf16(float lo, float hi) { const f32x2 v = {lo, hi}; const bf16x2v b = __builtin_convertvector(v, bf16x2v); return __builtin_bit_cast(unsigned, b); }
__device__ __forceinline__ u32x4 pack8(const f32x4 a, const f32x4 b) { u32x4 w; w.x = cvt_pk_bf16(a[0], a[1]); w.y = cvt_pk_bf16(a[2], a[3]); w.z = cvt_pk_bf16(b[0], b[1]); w.w = cvt_pk_bf16(b[2], b[3]); return w; }
__device__ __forceinline__ float bf_lo(unsigned w) { return __uint_as_float(w << 16); }
__device__ __forceinline__ float bf_hi(unsigned w) { return __uint_as_float(w & 0xffff0000u); }
__device__ __forceinline__ void unpack8(const u32x4 w, f32x4& a, f32x4& b) { a[0] = bf_lo(w.x); a[1] = bf_hi(w.x); a[2] = bf_lo(w.y); a[3] = bf_hi(w.y); b[0] = bf_lo(w.z); b[1] = bf_hi(w.z); b[2] = bf_lo(w.w); b[3] = bf_hi(w.w); }
__device__ __forceinline__ float sigm(float x) { return __builtin_amdgcn_rcpf(1.0f + __builtin_amdgcn_exp2f(-1.4426950408889634f * x)); }
__device__ __forceinline__ f32x4 sigm4(const f32x4 x) { f32x4 r; r[0] = sigm(x[0]); r[1] = sigm(x[1]); r[2] = sigm(x[2]); r[3] = sigm(x[3]); return r; }

template <class Epi, class Sched, bool ALIGN_EPI>
__device__ __forceinline__ void gemm_phase(PG8_LAS unsigned char* lds, const Dims g, const Sched& S, const Epi& E) {
    int tid_ = threadIdx.x; asm volatile("" : "+v"(tid_));
    const int tid = tid_, wid = __builtin_amdgcn_readfirstlane(tid >> 6), lane = tid & 63, wr = wid >> 2, wc = wid & 3, fr = lane & 15, fq = lane >> 4;
    const int K = g.K, nt = K / BK;
    unsigned voffA[2], voffB[2];
#pragma unroll
    for (int i = 0; i < 2; ++i) { int R, C; stage_rc(tid * 16 + i * 8192, R, C); const int Rb = Epi::PERM ? ((R & ~31) + perm32(R & 31)) : R;
        voffA[i] = (unsigned)(R * g.lda + C) * 2u; voffB[i] = (unsigned)(Rb * g.ldb + C) * 2u; }
    const size_t kstep = (size_t)(BK * 2);
    const size_t hA = (size_t)HALF * g.lda * 2, hB = (size_t)HALF * g.ldb * 2;
    const unsigned ldsw = (unsigned)wid * 1024u;
    const int aoff = lds_byte(wr * 64 + fr, fq * 8), boff = lds_byte(wc * 32 + fr, fq * 8);
#define PG8_SA(b, h) (((b) * 2 + (h)) * HTB)
#define PG8_SB(b, h) ((4 + (b) * 2 + (h)) * HTB)
#define PG8_STAGE(bufoff, gbase, voff) do { _Pragma("unroll") for (int _i = 0; _i < 2; ++_i) \
        __builtin_amdgcn_global_load_lds((const unsigned*)((const char*)(gbase) + (voff)[_i]), (PG8_LAS unsigned*)(lds + (bufoff) + ldsw + _i * 8192), 16, 0, 0); } while (0)
#define PG8_LDA(dst, b, h) do { _Pragma("unroll") for (int m = 0; m < 4; ++m) _Pragma("unroll") for (int k = 0; k < 2; ++k) dst[m][k] = *(const PG8_LAS bf16x8*)(lds + PG8_SA(b, h) + aoff + m * 2048 + k * 1024); } while (0)
#define PG8_LDB(dst, b, h) do { _Pragma("unroll") for (int n = 0; n < 2; ++n) _Pragma("unroll") for (int k = 0; k < 2; ++k) dst[n][k] = *(const PG8_LAS bf16x8*)(lds + PG8_SB(b, h) + boff + n * 2048 + k * 1024); } while (0)
#define PG8_MMA(ai, bj, At, Bt) do { __builtin_amdgcn_s_setprio(1); _Pragma("unroll") for (int m = 0; m < 4; ++m) _Pragma("unroll") for (int n = 0; n < 2; ++n) _Pragma("unroll") for (int k = 0; k < 2; ++k) \
        acc[ai][bj][m][n] = __builtin_amdgcn_mfma_f32_16x16x32_bf16(Bt[n][k], At[m][k], acc[ai][bj][m][n], 0, 0, 0); __builtin_amdgcn_s_setprio(0); } while (0)
#define PG8_WAIT_V(n) asm volatile("s_waitcnt vmcnt(" #n ")" ::: "memory")
#define PG8_WAIT_L(n) asm volatile("s_waitcnt lgkmcnt(" #n ")" ::: "memory")
#define PG8_BAR __builtin_amdgcn_s_barrier()
#define PG8_SCHED __builtin_amdgcn_sched_barrier(0)
    Unit cur, nxt; int ui = 0;
    if (!S.next(0, cur)) return;
    f32x4 acc[2][2][4][2];
#pragma unroll
    for (int a = 0; a < 2; ++a)
#pragma unroll
        for (int b = 0; b < 2; ++b)
#pragma unroll
            for (int m = 0; m < 4; ++m)
#pragma unroll
                for (int n = 0; n < 2; ++n) acc[a][b][m][n] = (f32x4){0.f, 0.f, 0.f, 0.f};
    bf16x8 At[4][2], B0[2][2], B1[2][2];
    const char* cA = cur.A; const char* cB = cur.B;
    PG8_STAGE(PG8_SB(0, 0), cB, voffB); PG8_STAGE(PG8_SB(0, 1), cB + hB, voffB); PG8_STAGE(PG8_SA(0, 0), cA, voffA); PG8_STAGE(PG8_SA(0, 1), cA + hA, voffA);
    if (wr == 1) PG8_BAR;
    PG8_WAIT_V(2); PG8_BAR;
    PG8_STAGE(PG8_SB(1, 0), cB + kstep, voffB); PG8_STAGE(PG8_SA(1, 0), cA + kstep, voffA); PG8_STAGE(PG8_SB(1, 1), cB + hB + kstep, voffB);
    PG8_WAIT_V(6); PG8_BAR;
    for (;;) {
        const bool has_next = S.next(ui + 1, nxt);
        const char* nA = has_next ? nxt.A : cA; const char* nB = has_next ? nxt.B : cB;
        for (int t = 0; t < nt; t += 2) {
            const bool last = (t == nt - 2);
            const char* a1 = cA + (size_t)(t + 1) * kstep;
            const char* a2 = last ? nA : cA + (size_t)(t + 2) * kstep; const char* b2 = last ? nB : cB + (size_t)(t + 2) * kstep;
            const char* a3 = a2 + kstep; const char* b3 = b2 + kstep;
            PG8_LDB(B0, 0, 0); PG8_LDB(B1, 0, 1); PG8_SCHED; PG8_LDA(At, 0, 0); PG8_STAGE(PG8_SA(1, 1), a1 + hA, voffA);
            PG8_WAIT_V(8); PG8_WAIT_L(0); PG8_BAR; PG8_MMA(0, 0, At, B0); PG8_MMA(0, 1, At, B1); PG8_BAR; PG8_SCHED;
            PG8_LDA(At, 0, 1); PG8_STAGE(PG8_SB(0, 0), b2, voffB); PG8_STAGE(PG8_SB(0, 1), b2 + hB, voffB); PG8_STAGE(PG8_SA(0, 0), a2, voffA);
            PG8_WAIT_V(8); PG8_WAIT_L(0); PG8_BAR; PG8_MMA(1, 0, At, B0); PG8_MMA(1, 1, At, B1); PG8_BAR; PG8_SCHED;
            PG8_LDB(B0, 1, 0); PG8_LDB(B1, 1, 1); PG8_SCHED; PG8_LDA(At, 1, 0); PG8_STAGE(PG8_SA(0, 1), a2 + hA, voffA);
            PG8_WAIT_V(8); PG8_WAIT_L(0); PG8_BAR; PG8_MMA(0, 0, At, B0); PG8_MMA(0, 1, At, B1); PG8_BAR; PG8_SCHED;
            PG8_LDA(At, 1, 1); PG8_STAGE(PG8_SB(1, 0), b3, voffB); PG8_STAGE(PG8_SB(1, 1), b3 + hB, voffB); PG8_STAGE(PG8_SA(1, 0), a3, voffA);
            PG8_WAIT_V(8); PG8_WAIT_L(0); PG8_BAR; PG8_MMA(1, 0, At, B0); PG8_MMA(1, 1, At, B1); PG8_BAR; PG8_SCHED;
        }
        if constexpr (ALIGN_EPI) { if (wr == 0) PG8_BAR; }
        E(acc, cur, wr, wc, fr, fq);
        if (!has_next) break;
#pragma unroll
        for (int a = 0; a < 2; ++a)
#pragma unroll
            for (int b = 0; b < 2; ++b)
#pragma unroll
                for (int m = 0; m < 4; ++m)
#pragma unroll
                    for (int n = 0; n < 2; ++n) acc[a][b][m][n] = (f32x4){0.f, 0.f, 0.f, 0.f};
        cur = nxt; cA = nA; cB = nB; ++ui;
        if constexpr (ALIGN_EPI) { if (wr == 1) PG8_BAR; }
    }
    PG8_WAIT_V(0);
    if constexpr (!ALIGN_EPI) { if (wr == 0) PG8_BAR; }
    PG8_BAR;
#undef PG8_SA
#undef PG8_SB
#undef PG8_STAGE
#undef PG8_LDA
#undef PG8_LDB
#undef PG8_MMA
#undef PG8_WAIT_V
#undef PG8_WAIT_L
#undef PG8_BAR
#undef PG8_SCHED
}

template <class Epi, class Sched, bool ALIGN_EPI>
__device__ __forceinline__ void gemm_phase_ref(PG8_LAS unsigned char* lds, const Dims g, const Sched& S, const Epi& E) {
    int tid_ = threadIdx.x; asm volatile("" : "+v"(tid_));
    const int tid = tid_, wid = __builtin_amdgcn_readfirstlane(tid >> 6), lane = tid & 63, wr = wid >> 2, wc = wid & 3, fr = lane & 15, fq = lane >> 4;
    typedef __bf16 bf2 __attribute__((ext_vector_type(2)));
    Unit cur;
    for (int ui = 0; S.next(ui, cur); ++ui) {
        f32x4 acc[2][2][4][2];
#pragma unroll
        for (int a = 0; a < 2; ++a)
#pragma unroll
            for (int b = 0; b < 2; ++b)
#pragma unroll
                for (int m = 0; m < 4; ++m)
#pragma unroll
                    for (int n = 0; n < 2; ++n) acc[a][b][m][n] = (f32x4){0.f, 0.f, 0.f, 0.f};
        for (int k0 = 0; k0 < g.K; k0 += 8) {
            u32x4 av[2][4];
#pragma unroll
            for (int a = 0; a < 2; ++a)
#pragma unroll
                for (int m = 0; m < 4; ++m) av[a][m] = *(const u32x4*)(cur.A + ((size_t)(128 * a + 64 * wr + 16 * m + fr) * g.lda + k0) * 2);
#pragma unroll
            for (int b = 0; b < 2; ++b)
#pragma unroll
                for (int n = 0; n < 2; ++n)
#pragma unroll
                    for (int i = 0; i < 4; ++i) {
                        const int col = Epi::PERM ? (128 * b + 32 * wc + 8 * fq + 4 * n + i) : (128 * b + 32 * wc + 16 * n + 4 * fq + i);
                        const u32x4 bv = *(const u32x4*)(cur.B + ((size_t)col * g.ldb + k0) * 2);
#pragma unroll
                        for (int a = 0; a < 2; ++a)
#pragma unroll
                            for (int m = 0; m < 4; ++m) { float s = acc[a][b][m][n][i];
                                s = __builtin_amdgcn_fdot2_f32_bf16(__builtin_bit_cast(bf2, av[a][m].x), __builtin_bit_cast(bf2, bv.x), s, false);
                                s = __builtin_amdgcn_fdot2_f32_bf16(__builtin_bit_cast(bf2, av[a][m].y), __builtin_bit_cast(bf2, bv.y), s, false);
                                s = __builtin_amdgcn_fdot2_f32_bf16(__builtin_bit_cast(bf2, av[a][m].z), __builtin_bit_cast(bf2, bv.z), s, false);
                                s = __builtin_amdgcn_fdot2_f32_bf16(__builtin_bit_cast(bf2, av[a][m].w), __builtin_bit_cast(bf2, bv.w), s, false);
                                acc[a][b][m][n][i] = s; }
                    }
        }
        E(acc, cur, wr, wc, fr, fq);
    }
}
}
#define GAS __attribute__((address_space(1)))
#define LAS __attribute__((address_space(3)))
typedef unsigned short bf16;
typedef unsigned v4u __attribute__((ext_vector_type(4)));
typedef unsigned v2u __attribute__((ext_vector_type(2)));
typedef float f32x4 __attribute__((ext_vector_type(4)));
typedef float f32x2 __attribute__((ext_vector_type(2)));
typedef short bf16x8 __attribute__((ext_vector_type(8)));
typedef __bf16 bf16x2_t __attribute__((ext_vector_type(2)));
typedef GAS unsigned gu32;
#define RLX_AGENT __ATOMIC_RELAXED, __HIP_MEMORY_SCOPE_AGENT
#define LDS_WAIT() asm volatile("s_waitcnt lgkmcnt(0)" ::: "memory")
#define VM_WAIT() asm volatile("s_waitcnt vmcnt(0)" ::: "memory")
using pg8::cvt_pk_bf16; using pg8::pack8; using pg8::unpack8; using pg8::bf_lo; using pg8::bf_hi; using pg8::sigm; using pg8::sigm4;

__device__ __forceinline__ float wave_sum(float v) {
#pragma unroll
    for (int o = 1; o < 64; o <<= 1) v += __shfl_xor(v, o);
    return v;
}
__device__ __forceinline__ float dot2bf(unsigned a, unsigned b, float acc) { return __builtin_amdgcn_fdot2_f32_bf16(__builtin_bit_cast(bf16x2_t, a), __builtin_bit_cast(bf16x2_t, b), acc, false); }

#define XB_TMO      128
#define XB_XCNT(j)  (256  + 64 * (j))
#define XB_XSUB(j)  (1280 + 64 * (j))
#define XB_XGEN(j)  (2304 + 64 * (j))
#define XB_TOP      3328
#define XB_TOPGEN   3392
#define XCD_BAR_WORDS 3456
#define XB_SPIN_CAP (1u << 18)

__device__ __forceinline__ unsigned xb_ld(unsigned* p)              { return __hip_atomic_load(p, __ATOMIC_RELAXED, __HIP_MEMORY_SCOPE_AGENT); }
__device__ __forceinline__ unsigned xb_add(unsigned* p, unsigned v) { return __hip_atomic_fetch_add(p, v, __ATOMIC_RELAXED, __HIP_MEMORY_SCOPE_AGENT); }
__device__ __forceinline__ unsigned xb_xcc_id() { return (unsigned)__builtin_amdgcn_s_getreg((3 << 11) | 20) & 0xFu; }
#define XB_SPIN(cond, bar) do { unsigned _sp = 0; while (cond) { __builtin_amdgcn_s_sleep(1); \
    if ((++_sp & 255u) == 0u) { if (xb_ld(&(bar)[XB_TMO])) break; if (_sp > XB_SPIN_CAP) { atomicAdd(&(bar)[XB_TMO], 1u); break; } } } } while (0)

struct XcdBarrier {
    unsigned* bar; unsigned x;
    volatile LAS unsigned* st;
};
__device__ __forceinline__ XcdBarrier xcd_barrier_post(unsigned* bar, volatile LAS unsigned* st) {
    XcdBarrier b; b.bar = bar; b.x = xb_xcc_id(); b.st = st;
    if (threadIdx.x == 0) (void)xb_add(&bar[XB_XCNT(b.x)], 1u);
    return b;
}
__device__ __forceinline__ void xcd_barrier_complete(unsigned* bar, unsigned x, unsigned& nloc, unsigned& nx) {
    const unsigned G = gridDim.x * gridDim.y * gridDim.z;
    unsigned sum, cnt, mine, sp = 0u;
    for (;;) {
        sum = 0u; cnt = 0u; mine = 0u;
#pragma unroll
        for (unsigned j = 0; j < 16; ++j) { const unsigned c = xb_ld(&bar[XB_XCNT(j)]); sum += c; cnt += (c > 0u) ? 1u : 0u; mine = (j == x) ? c : mine; }
        if (sum == G) break;
        __builtin_amdgcn_s_sleep(1);
        if ((++sp & 255u) == 0u) { if (xb_ld(&bar[XB_TMO])) break; if (sp > XB_SPIN_CAP) { atomicAdd(&bar[XB_TMO], 1u); break; } }
    }
    nloc = mine > 0u ? mine : 1u; nx = cnt > 0u ? cnt : 1u;
}
__device__ __forceinline__ void xcd_barrier(const XcdBarrier& b) {
    asm volatile("s_waitcnt vmcnt(0)" ::: "memory");
    __syncthreads();
    if (threadIdx.x == 0) {
        unsigned* bar = b.bar;
        __builtin_amdgcn_s_waitcnt(0);
        unsigned nloc = b.st[0], nx = b.st[1];
        if (nloc == 0u) { xcd_barrier_complete(bar, b.x, nloc, nx); b.st[0] = nloc; b.st[1] = nx; }
        const unsigned old = xb_add(&bar[XB_XSUB(b.x)], 1u);
        const unsigned gen = old / nloc;
        if (old + 1u == (gen + 1u) * nloc) {
            __builtin_amdgcn_fence(__ATOMIC_RELEASE, "agent");
            asm volatile("s_waitcnt vmcnt(0)" ::: "memory");
            const unsigned og = xb_add(&bar[XB_TOP], 1u);
            const unsigned tg = og / nx;
            if (og + 1u == (tg + 1u) * nx) xb_add(&bar[XB_TOPGEN], 1u);
            else XB_SPIN(xb_ld(&bar[XB_TOPGEN]) == tg, bar);
            __builtin_amdgcn_fence(__ATOMIC_ACQUIRE, "agent");
            xb_add(&bar[XB_XGEN(b.x)], 1u);
            asm volatile("s_waitcnt vmcnt(0)" ::: "memory");
        } else {
            XB_SPIN(xb_ld(&bar[XB_XGEN(b.x)]) == gen, bar);
            __builtin_amdgcn_fence(__ATOMIC_ACQUIRE, "agent");
            asm volatile("s_waitcnt vmcnt(0)" ::: "memory");
        }
    }
    __syncthreads();
}
constexpr int NWAVES = 8;
constexpr int BATCH = 8, SEQ = 2048, DM = 1024, M = BATCH * SEQ, DEPTH = 2, NH = 8, HD = 64, AW = 512, CW = 512, CK = 31;
constexpr int NGRP = 4, EPG = 8, NEXP = 32, FF = 512, PLE = 256, WIN = 4608;
constexpr float EPS = 1e-6f;
constexpr float QSCALE = 0.125f * 1.4426950408889634f;
constexpr int MAXROWS = 2 * M + NEXP * 256;
constexpr size_t MiB = 1u << 20;
constexpr size_t WS_CTL = 0, CTL_ZERO_BYTES = 2 * MiB;
constexpr size_t WS_COS = 2 * MiB, WS_SIN = 2 * MiB + 256 * 1024;
constexpr size_t WS_SSQ = 3 * MiB;
constexpr size_t WS_ROUTE = 10 * MiB, WS_POS = 10 * MiB + 512 * 1024, WS_RSC = 11 * MiB, WS_ROWG = 11 * MiB + 256 * 1024;
constexpr size_t WS_WR = 12 * MiB;
constexpr size_t WS_RB = 13 * MiB;
constexpr size_t WS_LG = 352 * MiB;
constexpr size_t WS_W = 16 * MiB, W_LAYER = 112 * MiB;
constexpr size_t WO_WIN = 0, WO_WAO = 9 * MiB, WO_WCO = 10 * MiB, WO_WOUT = 11 * MiB, WO_WPG = 13 * MiB, WO_WPP = 15 * MiB, WO_WGU = 16 * MiB, WO_WD = 80 * MiB;
constexpr size_t WS_XB = 240 * MiB, WS_PB = 272 * MiB, WS_PE = 288 * MiB, WS_MG = 320 * MiB;
constexpr size_t WS_Q = 352 * MiB, WS_K = 368 * MiB, WS_V = 384 * MiB, WS_U = 400 * MiB, WS_SGA = 416 * MiB, WS_SGB = 448 * MiB, WS_OC = 480 * MiB;
constexpr size_t WS_XG = 352 * MiB, WS_H = 432 * MiB, WS_Y = 352 * MiB, WS_END = 512 * MiB;
constexpr int CW_TMO = 0, CW_CODE = 1, CW_BAR = 4096, CW_CNT = 16384;
constexpr int RING_OFF = 0, RING_BYTES = 131072;
constexpr int LDSCTL_OFF = RING_BYTES, MISC_OFF = LDSCTL_OFF + 320, OFFS_OFF = LDSCTL_OFF + 1024;
constexpr int LDS_BYTES = 147456;
constexpr int PH_PER_LAYER = 10, PH_FINAL = 1 + DEPTH * PH_PER_LAYER, N_PHASES = PH_FINAL + 1;

struct Frame {
    LAS unsigned char* lds;
    volatile LAS unsigned* MISC;
    gu32* ctl;
    int tid, lane, wave, vcu, G;
    float* out; unsigned char* ws;
};
struct Args { const float* in[24]; float* out; unsigned char* ws; int ph_lo, ph_hi, use_bar, pad; };
#define WSP(T, off) ((T*)(F.ws + (off)))

__device__ __forceinline__ void transpose_item(const float* W, int ld, int colA, int colB, const float* gain, int k0, bf16* WT, int K, int row0, LAS float* scr, int lane) {
    const int kl = lane >> 4, n4 = lane & 15;
    const float* src = W + (size_t)(k0 + kl) * ld + (n4 < 8 ? colA + 4 * n4 : colB + 4 * (n4 - 8));
    f32x4 v[16];
#pragma unroll
    for (int q = 0; q < 16; ++q) v[q] = *(const GAS f32x4*)(src + (size_t)(4 * q) * ld);
#pragma unroll
    for (int q = 0; q < 16; ++q) { const int k = 4 * q + kl; if (gain) v[q] = v[q] * gain[k0 + k]; *(LAS f32x4*)(scr + k * 64 + ((4 * n4) ^ (((k >> 3) & 7) << 3))) = v[q]; }
    LDS_WAIT(); asm volatile("" ::: "memory");
    const int c = lane & 7;
#pragma unroll
    for (int j = 0; j < 8; ++j) { const int n = (lane >> 3) + 8 * j; const LAS float* s = scr + (8 * c) * 64 + (n ^ (c << 3));
        v4u o; o.x = cvt_pk_bf16(s[0 * 64], s[1 * 64]); o.y = cvt_pk_bf16(s[2 * 64], s[3 * 64]); o.z = cvt_pk_bf16(s[4 * 64], s[5 * 64]); o.w = cvt_pk_bf16(s[6 * 64], s[7 * 64]);
        *(GAS v4u*)(WT + (size_t)(row0 + n) * K + k0 + 8 * c) = o; }
    LDS_WAIT(); asm volatile("" ::: "memory");
}
__device__ __forceinline__ int win_src_col(int g) {
    const int pn = g >> 3, sub = g & 7;
    if (pn < 2) return 64 * (4 * pn + (sub & 3)) + 32 * (sub >> 2);
    if (pn < 4) return 512 + 64 * (4 * (pn - 2) + (sub & 3)) + 32 * (sub >> 2);
    if (pn < 6) return 1024 + 256 * (pn - 4) + 32 * sub;
    if (pn < 10) return (sub < 4 ? 1536 : 2048) + 128 * (pn - 6) + 32 * (sub & 3);
    return 2560 + 256 * (pn - 10) + 32 * sub;
}
constexpr int IT_WIN = 72 * 16, IT_WAO = 16 * 8, IT_WCO = 16 * 8, IT_WOUT = 16 * 16, IT_WPG = 16 * 16, IT_WPP = 16 * 4, IT_WGU = 512 * 16, IT_WD = 512 * 8;
constexpr int IT_LAYER = IT_WIN + IT_WAO + IT_WCO + IT_WOUT + IT_WPG + IT_WPP + IT_WGU + IT_WD;
__device__ __forceinline__ void conv_item(Frame& F, const Args& args, int L, int it, LAS float* scr) {
    unsigned char* wl = F.ws + WS_W + (size_t)L * W_LAYER; const int lane = F.lane;
    int r = it;
    if (r < IT_WIN) { const int gp = r >> 4, kb = r & 15; transpose_item(args.in[3] + (size_t)L * DM * WIN, WIN, win_src_col(2 * gp), win_src_col(2 * gp + 1), args.in[2] + L * DM, 64 * kb, (bf16*)(wl + WO_WIN), 1024, 64 * gp, scr, lane); return; } r -= IT_WIN;
    if (r < IT_WAO) { const int gp = r >> 3, kb = r & 7; transpose_item(args.in[8] + (size_t)L * 512 * DM, DM, 64 * gp, 64 * gp + 32, nullptr, 64 * kb, (bf16*)(wl + WO_WAO), 512, 64 * gp, scr, lane); return; } r -= IT_WAO;
    if (r < IT_WCO) { const int gp = r >> 3, kb = r & 7; transpose_item(args.in[9] + (size_t)L * 512 * DM, DM, 64 * gp, 64 * gp + 32, nullptr, 64 * kb, (bf16*)(wl + WO_WCO), 512, 64 * gp, scr, lane); return; } r -= IT_WCO;
    if (r < IT_WOUT) { const int gp = r >> 4, kb = r & 15; transpose_item(args.in[11] + (size_t)L * DM * DM, DM, 64 * gp, 64 * gp + 32, nullptr, 64 * kb, (bf16*)(wl + WO_WOUT), 1024, 64 * gp, scr, lane); return; } r -= IT_WOUT;
    if (r < IT_WPG) { const int gp = r >> 4, kb = r & 15; transpose_item(args.in[22] + (size_t)L * DM * DM, DM, 64 * gp, 64 * gp + 32, args.in[20] + L * DM, 64 * kb, (bf16*)(wl + WO_WPG), 1024, 64 * gp, scr, lane); return; } r -= IT_WPG;
    if (r < IT_WPP) { const int gp = r >> 2, kb = r & 3; transpose_item(args.in[21] + (size_t)L * PLE * DM, DM, 64 * gp, 64 * gp + 32, nullptr, 64 * kb, (bf16*)(wl + WO_WPP), 256, 64 * gp, scr, lane); return; } r -= IT_WPP;
    if (r < IT_WGU) { const int gp = r >> 4, kb = r & 15, e = gp >> 4, gl = gp & 15, tile = gl >> 2, sub = gl & 3;
        const float* src = (sub < 2 ? args.in[17] : args.in[18]) + ((size_t)L * NEXP + e) * DM * FF; const int col = 128 * tile + 64 * (sub & 1);
        transpose_item(src, FF, col, col + 32, args.in[12] + L * DM, 64 * kb, (bf16*)(wl + WO_WGU), 1024, 64 * gp, scr, lane); return; } r -= IT_WGU;
    { const int gp = r >> 3, kb = r & 7, e = gp >> 4, gl = gp & 15;
        transpose_item(args.in[19] + ((size_t)L * NEXP + e) * FF * DM, DM, 64 * gl, 64 * gl + 32, nullptr, 64 * kb, (bf16*)(wl + WO_WD), 512, 64 * gp, scr, lane); }
}
__device__ __forceinline__ void p0_prologue(Frame& F, const Args& args) {
    LAS float* scr = (LAS float*)(F.lds + RING_OFF + F.wave * 16384);
    const int gw = F.vcu * NWAVES + F.wave, NGW = F.G * NWAVES, lane = F.lane;
    const int gt = (F.vcu * NWAVES + F.wave) * 64 + lane, NGT = NGW * 64;
    { bf16* XB = WSP(bf16, WS_XB); float* SSQ = WSP(float, WS_SSQ);
      for (int m = gw; m < M; m += NGW) {
          const GAS f32x4* xr = (const GAS f32x4*)(args.in[0] + (size_t)m * DM) + lane; float s = 0.f; GAS v2u* o8 = (GAS v2u*)(XB + (size_t)m * DM) + lane;
#pragma unroll
          for (int j = 0; j < 4; ++j) { const f32x4 v = xr[64 * j]; s += (v[0] * v[0] + v[1] * v[1]) + (v[2] * v[2] + v[3] * v[3]); v2u w; w.x = cvt_pk_bf16(v[0], v[1]); w.y = cvt_pk_bf16(v[2], v[3]); o8[64 * j] = w; }
          const float tot = wave_sum(s);
          if (lane < 16) SSQ[(size_t)m * 16 + lane] = lane == 0 ? tot : 0.f;
      } }
    { const GAS f32x4* ps = (const GAS f32x4*)args.in[1]; GAS v4u* pb = (GAS v4u*)WSP(bf16, WS_PB);
      for (int i = gt; i < DEPTH * M * PLE / 8; i += NGT) { const f32x4 a = ps[2 * i], b = ps[2 * i + 1]; pb[i] = pack8(a, b); } }
    { float* ct = WSP(float, WS_COS); float* st = WSP(float, WS_SIN);
      for (int i = gt; i < SEQ * 32; i += NGT) { const int pos = i >> 5, k = i & 31; const float inv = powf(10000.0f, -(float)(2 * k) / 64.0f); const float ang = (float)pos * inv; ct[i] = cosf(ang); st[i] = sinf(ang); } }
    { bf16* wr = WSP(bf16, WS_WR);
      for (int i = gt; i < DEPTH * 256 * DM; i += NGT) { const int L = i >> 18, j = (i >> 10) & 255, k = i & 1023; float v = 0.f;
          if (j < 4) v = args.in[13][((size_t)L * DM + k) * NGRP + j]; else if (j < 36) v = args.in[15][((size_t)L * DM + k) * NEXP + (j - 4)];
          if (j < 36) v *= args.in[12][L * DM + k];
          wr[i] = (bf16)(cvt_pk_bf16(v, 0.f) & 0xffffu); }
      float* rb = WSP(float, WS_RB);
      for (int i = gt; i < DEPTH * 64; i += NGT) { const int L = i >> 6, j = i & 63; rb[i] = j < 4 ? args.in[14][L * NGRP + j] : (j < 36 ? args.in[16][L * NEXP + j - 4] : 0.f); } }
    for (int it = gw; it < DEPTH * IT_LAYER; it += NGW) { const int L = it >= IT_LAYER ? 1 : 0; conv_item(F, args, L, it - L * IT_LAYER, scr); }
}

struct SchedGrid {
    int nM, nN, G, c; const char* Ab; const char* Bb; size_t astep, bstep;
    __device__ __forceinline__ bool next(int i, pg8::Unit& u) const {
        const int L = i * G + c; if (L >= nM * nN) return false;
        pg8::tile_of(L, nM, nN, u.pm, u.pn); u.aux = 0; u.A = Ab + (size_t)u.pm * astep; u.B = Bb + (size_t)u.pn * bstep; return true; }
};
struct SchedP3 {
    int G, c; const char* OC; const char* Wa; const char* Wc;
    __device__ __forceinline__ bool next(int i, pg8::Unit& u) const {
        const int T = (i >> 1) * G + c; if (T >= 256) return false;
        pg8::tile_of(T, 64, 4, u.pm, u.pn); u.aux = i & 1;
        u.A = OC + (size_t)u.pm * (256 * 1024 * 2) + (u.aux ? 512 * 2 : 0); u.B = (u.aux ? Wc : Wa) + (size_t)u.pn * (256 * 512 * 2); return true; }
};
struct SchedMoe {
    const volatile LAS int* offs; int G, c, up; const char* Ab; const char* Bb;
    __device__ __forceinline__ bool next(int i, pg8::Unit& u) const {
        const int NB = offs[32] >> 8, L = i * G + c; if (L >= NB * 4) return false;
        const int mb = L >> 2, pn = L & 3; int e = 0;
        while (e < 31 && offs[e + 1] <= mb * 256) ++e;
        u.pm = mb; u.pn = pn; u.aux = e;
        if (up) { u.A = Ab + (size_t)mb * (256 * 1024 * 2); u.B = Bb + ((size_t)e * 1024 + pn * 256) * (1024 * 2); }
        else    { u.A = Ab + (size_t)mb * (256 * 512 * 2);  u.B = Bb + ((size_t)e * 1024 + pn * 256) * (512 * 2); }
        return true; }
};

using pg8::f32x4;
#define EPI_FOR_ROWS _Pragma("unroll") for (int ai = 0; ai < 2; ++ai) _Pragma("unroll") for (int m = 0; m < 4; ++m)
#define EPI_ROW (u.pm * 256 + ai * 128 + wr * 64 + m * 16 + fr)
__device__ __forceinline__ float rscale_of(const float* ssq, int row) {
    const f32x4* sp = (const f32x4*)(ssq + (size_t)row * 16); const f32x4 a = sp[0], b = sp[1], c = sp[2], d = sp[3];
    const float s = ((a[0] + a[1]) + (a[2] + a[3])) + ((b[0] + b[1]) + (b[2] + b[3])) + ((c[0] + c[1]) + (c[2] + c[3])) + ((d[0] + d[1]) + (d[2] + d[3]));
    return rsqrtf(s * (1.0f / DM) + EPS);
}
struct EpiP1 {
    static constexpr bool PERM = true;
    const float* ssq; const float* cosT; const float* sinT; bf16 *Q, *K, *V, *U, *SGA, *SGB;
    __device__ __forceinline__ void operator()(const f32x4 (&acc)[2][2][4][2], const pg8::Unit& u, int wr, int wc, int fr, int fq) const {
        const int pn = u.pn;
        EPI_FOR_ROWS { const int row = EPI_ROW;
            const float r = rscale_of(ssq, row); const int b = row >> 11, t = row & 2047;
            if (pn < 4) {
                const int head = 4 * (pn & 1) + wc; const float qs = pn < 2 ? QSCALE : 1.0f;
                const f32x4* cp = (const f32x4*)(cosT + t * 32 + 8 * fq); const f32x4* sp = (const f32x4*)(sinT + t * 32 + 8 * fq);
                f32x4 o1[2], o2[2];
#pragma unroll
                for (int n = 0; n < 2; ++n) { const f32x4 c = cp[n], s = sp[n], t1 = acc[ai][0][m][n] * (r * qs), t2 = acc[ai][1][m][n] * (r * qs); o1[n] = t1 * c - t2 * s; o2[n] = t1 * s + t2 * c; }
                bf16* dst = (pn < 2 ? Q : K) + ((size_t)(b * NH + head) * SEQ + t) * HD + 8 * fq;
                *(v4u*)dst = pack8(o1[0], o1[1]); *(v4u*)(dst + 32) = pack8(o2[0], o2[1]);
            } else if (pn < 6) {
#pragma unroll
                for (int bj = 0; bj < 2; ++bj) { const int head = 4 * (pn - 4) + 2 * bj + (wc >> 1), dim = 32 * (wc & 1) + 8 * fq;
                    *(v4u*)(V + ((size_t)(b * NH + head) * SEQ + t) * HD + dim) = pack8(acc[ai][bj][m][0] * r, acc[ai][bj][m][1] * r); }
            } else if (pn < 10) {
                f32x4 o[2];
#pragma unroll
                for (int n = 0; n < 2; ++n) o[n] = (acc[ai][0][m][n] * r) * sigm4(acc[ai][1][m][n] * r);
                *(v4u*)(U + (size_t)row * CW + 128 * (pn - 6) + 32 * wc + 8 * fq) = pack8(o[0], o[1]);
            } else {
                bf16* base = (pn < 14 ? SGA + 256 * (pn - 10) : SGB + 256 * (pn - 14)) + (size_t)row * DM + 32 * wc + 8 * fq;
#pragma unroll
                for (int bj = 0; bj < 2; ++bj) *(v4u*)(base + 128 * bj) = pack8(sigm4(acc[ai][bj][m][0] * r), sigm4(acc[ai][bj][m][1] * r));
            }
        }
    }
};
struct EpiP3 {
    static constexpr bool PERM = true;
    const bf16* SGA; const bf16* SGB; const float* bco; bf16* MG;
    __device__ __forceinline__ void operator()(const f32x4 (&acc)[2][2][4][2], const pg8::Unit& u, int wr, int wc, int fr, int fq) const {
        const int kind = u.aux;
        EPI_FOR_ROWS { const int row = EPI_ROW;
#pragma unroll
            for (int bj = 0; bj < 2; ++bj) { const int col = u.pn * 256 + 128 * bj + 32 * wc + 8 * fq; const size_t off = (size_t)row * DM + col;
                f32x4 g0, g1; unpack8(*(const v4u*)((kind ? SGB : SGA) + off), g0, g1);
                f32x4 v0 = acc[ai][bj][m][0], v1 = acc[ai][bj][m][1];
                if (kind) { const f32x4 b0 = *(const f32x4*)(bco + col), b1 = *(const f32x4*)(bco + col + 4); f32x4 p0, p1; unpack8(*(const v4u*)(MG + off), p0, p1); v0 = p0 + g0 * (v0 + b0); v1 = p1 + g1 * (v1 + b1); }
                else { v0 = g0 * v0; v1 = g1 * v1; }
                *(v4u*)(MG + off) = pack8(v0, v1); }
        }
    }
};
#define RESID_STORE(DELTA0, DELTA1) { const f32x4 x0 = *(const f32x4*)(resid + off), x1 = *(const f32x4*)(resid + off + 4); const f32x4 v0 = x0 + (DELTA0), v1 = x1 + (DELTA1); \
        *(f32x4*)(X + off) = v0; *(f32x4*)(X + off + 4) = v1; *(v4u*)(XB + off) = pack8(v0, v1); \
        ss += ((v0[0] * v0[0] + v0[1] * v0[1]) + (v0[2] * v0[2] + v0[3] * v0[3])) + ((v1[0] * v1[0] + v1[1] * v1[1]) + (v1[2] * v1[2] + v1[3] * v1[3])); }
#define SSQ_STORE() { ss += __shfl_xor(ss, 16); ss += __shfl_xor(ss, 32); if (fq == 0) ssq_out[(size_t)row * 16 + u.pn * 4 + wc] = ss; }
struct EpiP4 {
    static constexpr bool PERM = true;
    const float* resid; float* X; bf16* XB; float* ssq_out;
    __device__ __forceinline__ void operator()(const f32x4 (&acc)[2][2][4][2], const pg8::Unit& u, int wr, int wc, int fr, int fq) const {
        EPI_FOR_ROWS { const int row = EPI_ROW;
            float ss = 0.f;
#pragma unroll
            for (int bj = 0; bj < 2; ++bj) { const size_t off = (size_t)row * DM + u.pn * 256 + 128 * bj + 32 * wc + 8 * fq; RESID_STORE(acc[ai][bj][m][0], acc[ai][bj][m][1]) }
            SSQ_STORE()
        }
    }
};
struct EpiP8 {
    static constexpr bool PERM = true;
    const float* ssq_in; const bf16* PE; const float* resid; float* X; bf16* XB; float* ssq_out;
    __device__ __forceinline__ void operator()(const f32x4 (&acc)[2][2][4][2], const pg8::Unit& u, int wr, int wc, int fr, int fq) const {
        EPI_FOR_ROWS { const int row = EPI_ROW;
            const float r = rscale_of(ssq_in, row); float ss = 0.f;
#pragma unroll
            for (int bj = 0; bj < 2; ++bj) { const size_t off = (size_t)row * DM + u.pn * 256 + 128 * bj + 32 * wc + 8 * fq;
                f32x4 p0, p1; unpack8(*(const v4u*)(PE + off), p0, p1);
                RESID_STORE(sigm4(acc[ai][bj][m][0] * r) * p0, sigm4(acc[ai][bj][m][1] * r) * p1) }
            SSQ_STORE()
        }
    }
};
struct EpiBf16 {
    static constexpr bool PERM = true;
    bf16* O; int ldc;
    __device__ __forceinline__ void operator()(const f32x4 (&acc)[2][2][4][2], const pg8::Unit& u, int wr, int wc, int fr, int fq) const {
        EPI_FOR_ROWS { const int row = EPI_ROW;
#pragma unroll
            for (int bj = 0; bj < 2; ++bj) *(v4u*)(O + (size_t)row * ldc + u.pn * 256 + 128 * bj + 32 * wc + 8 * fq) = pack8(acc[ai][bj][m][0], acc[ai][bj][m][1]);
        }
    }
};
struct EpiUp {
    static constexpr bool PERM = true;
    const float* RSC; bf16* H;
    __device__ __forceinline__ void operator()(const f32x4 (&acc)[2][2][4][2], const pg8::Unit& u, int wr, int wc, int fr, int fq) const {
        EPI_FOR_ROWS { const int row = EPI_ROW;
            const float r = RSC[row]; f32x4 o[2];
#pragma unroll
            for (int n = 0; n < 2; ++n) { const f32x4 g = acc[ai][0][m][n] * r; o[n] = g * sigm4(g) * (acc[ai][1][m][n] * r); }
            *(v4u*)(H + (size_t)row * FF + 128 * u.pn + 32 * wc + 8 * fq) = pack8(o[0], o[1]);
        }
    }
};
struct EpiDown {
    static constexpr bool PERM = true;
    const float* ROWG; bf16* Y;
    __device__ __forceinline__ void operator()(const f32x4 (&acc)[2][2][4][2], const pg8::Unit& u, int wr, int wc, int fr, int fq) const {
        EPI_FOR_ROWS { const int row = EPI_ROW;
            const float gt = ROWG[row];
#pragma unroll
            for (int bj = 0; bj < 2; ++bj) *(v4u*)(Y + (size_t)row * DM + u.pn * 256 + 128 * bj + 32 * wc + 8 * fq) = pack8(acc[ai][bj][m][0] * gt, acc[ai][bj][m][1] * gt);
        }
    }
};


struct EpiRoute {
    static constexpr bool PERM = true;
    const float* ssq; const float* bias; float* LG;
    __device__ __forceinline__ void operator()(const f32x4 (&acc)[2][2][4][2], const pg8::Unit& u, int wr, int wc, int fr, int fq) const {
        if (wc < 2) {
            const f32x4 b0 = *(const f32x4*)(bias + 32 * wc + 8 * fq), b1 = *(const f32x4*)(bias + 32 * wc + 8 * fq + 4);
            EPI_FOR_ROWS { const int row = EPI_ROW; const float r = rscale_of(ssq, row);
                float* dst = LG + (size_t)row * 64 + 32 * wc + 8 * fq;
                *(f32x4*)dst = acc[ai][0][m][0] * r + b0; *(f32x4*)(dst + 4) = acc[ai][0][m][1] * r + b1; }
        }
    }
};
__device__ __forceinline__ void route_decide(Frame& F, int L, int pm) {
    if (F.tid < 256) {
        const int t = pm * 256 + F.tid;
        const float* lp = WSP(float, WS_LG) + (size_t)t * 64; const float* SSQ = WSP(float, WS_SSQ + (size_t)(3 * L + 1) * MiB);
        int* ROUTE = WSP(int, WS_ROUTE); unsigned* cnt = (unsigned*)(F.ctl + CW_CNT + 64 * L);
        const f32x4 g4 = *(const f32x4*)lp;
        float mxv = g4[0]; int gs = 0;
#pragma unroll
        for (int i = 1; i < 4; ++i) if (g4[i] > mxv) { mxv = g4[i]; gs = i; }
        float se = 0.f;
#pragma unroll
        for (int i = 0; i < 4; ++i) se += __expf(g4[i] - mxv);
        const float pg = 1.0f / se;
        const f32x4 e0 = *(const f32x4*)(lp + 4 + gs * 8), e1 = *(const f32x4*)(lp + 8 + gs * 8);
        float v1 = -1e30f, v2 = -1e30f; int i1 = 0, i2 = 0;
#pragma unroll
        for (int i = 0; i < 8; ++i) { const float v = i < 4 ? e0[i] : e1[i - 4]; if (v > v1) { v2 = v1; i2 = i1; v1 = v; i1 = i; } else if (v > v2) { v2 = v; i2 = i; } }
        const float e2 = __expf(v2 - v1), s1 = 1.0f / (1.0f + e2);
        const int ea = gs * 8 + i1, eb = gs * 8 + i2;
        const unsigned ia = atomicAdd(cnt + ea, 1u), ib = atomicAdd(cnt + eb, 1u);
        v4u r0, r1; r0.x = (unsigned)ea; r0.y = (unsigned)eb; r0.z = ia; r0.w = ib; r1.x = __float_as_uint(pg * s1); r1.y = __float_as_uint(pg * e2 * s1); r1.z = __float_as_uint(rscale_of(SSQ, t)); r1.w = 0u;
        *(GAS v4u*)(ROUTE + (size_t)t * 8) = r0; *(GAS v4u*)(ROUTE + (size_t)t * 8 + 4) = r1;
    }
}

__device__ __forceinline__ void attn_simple(Frame& F) {
    const bf16* Q = WSP(bf16, WS_Q); const bf16* Kb = WSP(bf16, WS_K); const bf16* Vb = WSP(bf16, WS_V); bf16* OC = WSP(bf16, WS_OC);
    const int lane = F.lane;
    for (int unit = F.vcu * NWAVES + F.wave; unit < BATCH * NH * (SEQ / 64); unit += F.G * NWAVES) {
        const int bh = unit >> 5, t = ((unit & 31) << 6) + lane;
        unsigned qw[32];
        { const GAS v4u* qp = (const GAS v4u*)(Q + ((size_t)bh * SEQ + t) * HD);
#pragma unroll
          for (int i = 0; i < 8; ++i) { const v4u w = qp[i]; qw[4 * i] = w.x; qw[4 * i + 1] = w.y; qw[4 * i + 2] = w.z; qw[4 * i + 3] = w.w; } }
        float o[64];
#pragma unroll
        for (int i = 0; i < 64; ++i) o[i] = 0.f;
        float mx = -1e30f, l = 0.f;
        for (int g = 0; g < 3; ++g) {
            const int d = g == 0 ? 1 : (g == 1 ? 4 : 16);
            for (int j0 = 0; j0 <= 128; j0 += 4) {
                if (!__any(t - j0 * d >= 0)) break;
                float s[4]; int pc[4];
#pragma unroll
                for (int c = 0; c < 4; ++c) { const int j = j0 + c, pos = t - j * d; const bool valid = pos >= 0 && j <= 128; pc[c] = valid ? pos : t;
                    const GAS v4u* kp = (const GAS v4u*)(Kb + ((size_t)bh * SEQ + pc[c]) * HD); float a = 0.f;
#pragma unroll
                    for (int i = 0; i < 8; ++i) { const v4u w = kp[i]; a = dot2bf(qw[4 * i], w.x, a); a = dot2bf(qw[4 * i + 1], w.y, a); a = dot2bf(qw[4 * i + 2], w.z, a); a = dot2bf(qw[4 * i + 3], w.w, a); }
                    s[c] = valid ? a : -1e30f; }
                const float mc = fmaxf(fmaxf(s[0], s[1]), fmaxf(s[2], s[3])), mn = fmaxf(mx, mc), sc = __builtin_amdgcn_exp2f(mx - mn);
                l *= sc;
#pragma unroll
                for (int i = 0; i < 64; ++i) o[i] *= sc;
                mx = mn;
#pragma unroll
                for (int c = 0; c < 4; ++c) { const float p = __builtin_amdgcn_exp2f(s[c] - mn); l += p;
                    const GAS v4u* vp = (const GAS v4u*)(Vb + ((size_t)bh * SEQ + pc[c]) * HD);
#pragma unroll
                    for (int i = 0; i < 8; ++i) { const v4u w = vp[i];
                        o[8 * i + 0] += p * bf_lo(w.x); o[8 * i + 1] += p * bf_hi(w.x); o[8 * i + 2] += p * bf_lo(w.y); o[8 * i + 3] += p * bf_hi(w.y);
                        o[8 * i + 4] += p * bf_lo(w.z); o[8 * i + 5] += p * bf_hi(w.z); o[8 * i + 6] += p * bf_lo(w.w); o[8 * i + 7] += p * bf_hi(w.w); } }
            }
        }
        const float inv = 1.0f / l; const int b = bh >> 3, h = bh & 7;
        GAS v4u* op = (GAS v4u*)(OC + ((size_t)(b * SEQ + t)) * DM + h * HD);
#pragma unroll
        for (int i = 0; i < 8; ++i) { v4u w; w.x = cvt_pk_bf16(o[8 * i] * inv, o[8 * i + 1] * inv); w.y = cvt_pk_bf16(o[8 * i + 2] * inv, o[8 * i + 3] * inv); w.z = cvt_pk_bf16(o[8 * i + 4] * inv, o[8 * i + 5] * inv); w.w = cvt_pk_bf16(o[8 * i + 6] * inv, o[8 * i + 7] * inv); op[i] = w; }
    }
}

typedef float f32x16 __attribute__((ext_vector_type(16)));
typedef short v4i16_t __attribute__((ext_vector_type(4)));
struct AttnStep { int p0, st, mode, T; };
__device__ __forceinline__ void attn_desc(int idx, int qb, int c, int i, int hi, int n1, int n0, int nb2, AttnStep& d) {
    if (idx < n1) { const int kb = qb - idx; d.p0 = 128 * kb + c; d.st = 4; d.mode = (idx == 0) ? 2 : ((idx == 4) ? 1 : 0); d.T = i - 4 * hi; }
    else if (idx < n1 + n0) { const int kb = (qb ? 0 : 4) + (idx - n1); d.st = 1;
        if (kb < 4) { d.p0 = 128 * (qb - 1) + 32 * kb; d.mode = 1; d.T = 4 * i + c - 32 * kb - 4 * hi; }
        else { d.p0 = 128 * qb + 32 * (kb - 4); d.mode = 2; d.T = 4 * i + c - 32 * (kb - 4) - 4 * hi; } }
    else { const int e = idx - n1 - n0, a = e / nb2, kb = e - a * nb2; d.p0 = 512 * kb + 4 * a + c; d.st = 16; d.mode = 2; d.T = ((i & 3) == a) ? (8 * qb + (i >> 2) - 32 * kb - 4 * hi) : -100; }
}
__device__ __forceinline__ void attn_dma(LAS unsigned char* slot, const bf16* Kh, const bf16* Vh, int p0, int st, int lane) {
    const int rl = lane >> 3, pos = lane & 7;
#pragma unroll
    for (int pc = 0; pc < 4; ++pc) {
        const int row = 8 * pc + rl; const size_t rowoff = (size_t)(p0 + st * row) * HD;
        const int chk = pos ^ ((row >> 1) & 7);
        const int chv = (((pos >> 1) ^ (((row >> 1) & 1) << 1)) << 1) | (pos & 1);
        __builtin_amdgcn_global_load_lds((const unsigned*)(Kh + rowoff + chk * 8), (LAS unsigned*)(slot + pc * 1024), 16, 0, 0);
        __builtin_amdgcn_global_load_lds((const unsigned*)(Vh + rowoff + chv * 8), (LAS unsigned*)(slot + 4096 + pc * 1024), 16, 0, 0);
    }
}
__device__ __forceinline__ void attn_mfma(Frame& F) {
    const bf16* Q = WSP(bf16, WS_Q); const bf16* Kb = WSP(bf16, WS_K); const bf16* Vb = WSP(bf16, WS_V); bf16* OC = WSP(bf16, WS_OC);
    const int lane = F.lane, i = lane & 31, hi = lane >> 5;
    LAS unsigned char* ring = F.lds + RING_OFF + F.wave * 16384;
    int koff[4];
#pragma unroll
    for (int s = 0; s < 4; ++s) koff[s] = i * 128 + (((2 * s + hi) ^ ((i >> 1) & 7)) << 4);
    const int g2 = (lane >> 4) & 1, q4 = (lane & 15) >> 2, p4 = lane & 3;
    int voff[2][2];
#pragma unroll
    for (int s = 0; s < 2; ++s)
#pragma unroll
        for (int db = 0; db < 2; ++db) { const int row = 16 * s + 4 * hi + q4; voff[s][db] = 4096 + row * 128 + (((2 * db + g2) ^ (((row >> 1) & 1) << 1)) << 5) + p4 * 8; }
    for (int pass = 0; pass < 2; ++pass) {
        const int gw = F.vcu * NWAVES + F.wave;
        const int T = pass == 0 ? gw : (BATCH * NH * 4 * 16 - 1 - gw);
        if (gw >= BATCH * NH * 4 * 16 / 2) break;
        const int qb = T & 15, c = (T >> 4) & 3, bh = T >> 6;
        const bf16* Kh = Kb + (size_t)bh * SEQ * HD; const bf16* Vh = Vb + (size_t)bh * SEQ * HD;
        const int tq = 128 * qb + 4 * i + c;
        bf16x8 qf[4];
        { const GAS bf16x8* qp = (const GAS bf16x8*)(Q + ((size_t)bh * SEQ + tq) * HD + 8 * hi);
#pragma unroll
          for (int s = 0; s < 4; ++s) qf[s] = qp[2 * s]; }
        const int n1 = (qb < 4 ? qb : 4) + 1, n0 = qb ? 8 : 4, nb2 = (qb >> 2) + 1, nsteps = n1 + n0 + 4 * nb2;
        f32x16 o0, o1;
#pragma unroll
        for (int r = 0; r < 16; ++r) { o0[r] = 0.f; o1[r] = 0.f; }
        float mrun = -1e30f, lrun = 0.f;
        AttnStep cur; attn_desc(0, qb, c, i, hi, n1, n0, nb2, cur);
        attn_dma(ring, Kh, Vh, cur.p0, cur.st, lane);
        for (int idx = 0; idx < nsteps; ++idx) {
            LAS unsigned char* slot = ring + (idx & 1) * 8192;
            AttnStep nxt = cur;
            if (idx + 1 < nsteps) { attn_desc(idx + 1, qb, c, i, hi, n1, n0, nb2, nxt); attn_dma(ring + ((idx + 1) & 1) * 8192, Kh, Vh, nxt.p0, nxt.st, lane); asm volatile("s_waitcnt vmcnt(8)" ::: "memory"); }
            else { asm volatile("s_waitcnt vmcnt(0)" ::: "memory"); }
            f32x16 sacc;
#pragma unroll
            for (int r = 0; r < 16; ++r) sacc[r] = 0.f;
#pragma unroll
            for (int s = 0; s < 4; ++s) { const bf16x8 kf = *(const LAS bf16x8*)(slot + koff[s]); sacc = __builtin_amdgcn_mfma_f32_32x32x16_bf16(kf, qf[s], sacc, 0, 0, 0); }
            if (cur.mode == 1) {
#pragma unroll
                for (int r = 0; r < 16; ++r) sacc[r] = ((r & 3) + 8 * (r >> 2) >= cur.T) ? sacc[r] : -1e30f;
            } else if (cur.mode == 2) {
#pragma unroll
                for (int r = 0; r < 16; ++r) sacc[r] = ((r & 3) + 8 * (r >> 2) <= cur.T) ? sacc[r] : -1e30f;
            }
            float mloc = sacc[0];
#pragma unroll
            for (int r = 1; r < 16; ++r) mloc = fmaxf(mloc, sacc[r]);
            { auto rr = __builtin_amdgcn_permlane32_swap(__float_as_uint(mloc), __float_as_uint(mloc), false, false); mloc = fmaxf(__uint_as_float(rr[0]), __uint_as_float(rr[1])); }
            const float mnew = fmaxf(mrun, mloc), alpha = __builtin_amdgcn_exp2f(mrun - mnew);
            mrun = mnew;
            float psum = 0.f;
#pragma unroll
            for (int r = 0; r < 16; ++r) { sacc[r] = __builtin_amdgcn_exp2f(sacc[r] - mnew); psum += sacc[r]; }
            lrun = lrun * alpha + psum;
#pragma unroll
            for (int r = 0; r < 16; ++r) { o0[r] *= alpha; o1[r] *= alpha; }
            bf16x8 pf[2];
#pragma unroll
            for (int s = 0; s < 2; ++s) { v4u w; w.x = cvt_pk_bf16(sacc[8 * s], sacc[8 * s + 1]); w.y = cvt_pk_bf16(sacc[8 * s + 2], sacc[8 * s + 3]); w.z = cvt_pk_bf16(sacc[8 * s + 4], sacc[8 * s + 5]); w.w = cvt_pk_bf16(sacc[8 * s + 6], sacc[8 * s + 7]); pf[s] = __builtin_bit_cast(bf16x8, w); }
#pragma unroll
            for (int s = 0; s < 2; ++s)
#pragma unroll
                for (int db = 0; db < 2; ++db) {
                    const v4i16_t lo = __builtin_amdgcn_ds_read_tr16_b64_v4i16((LAS v4i16_t*)(slot + voff[s][db]));
                    const v4i16_t hh = __builtin_amdgcn_ds_read_tr16_b64_v4i16((LAS v4i16_t*)(slot + voff[s][db] + 8 * 128));
                    const bf16x8 vf = (bf16x8){lo[0], lo[1], lo[2], lo[3], hh[0], hh[1], hh[2], hh[3]};
                    if (db == 0) o0 = __builtin_amdgcn_mfma_f32_32x32x16_bf16(vf, pf[s], o0, 0, 0, 0); else o1 = __builtin_amdgcn_mfma_f32_32x32x16_bf16(vf, pf[s], o1, 0, 0, 0);
                }
            cur = nxt;
        }
        { auto rr = __builtin_amdgcn_permlane32_swap(__float_as_uint(lrun), __float_as_uint(lrun), false, false); lrun = __uint_as_float(rr[0]) + __uint_as_float(rr[1]); }
        const float inv = 1.0f / lrun; const int b = bh >> 3, h = bh & 7;
        bf16* op = OC + ((size_t)(b * SEQ + tq)) * DM + h * HD + 4 * hi;
#pragma unroll
        for (int g = 0; g < 4; ++g) {
            v2u w0, w1; w0.x = cvt_pk_bf16(o0[4 * g] * inv, o0[4 * g + 1] * inv); w0.y = cvt_pk_bf16(o0[4 * g + 2] * inv, o0[4 * g + 3] * inv);
            w1.x = cvt_pk_bf16(o1[4 * g] * inv, o1[4 * g + 1] * inv); w1.y = cvt_pk_bf16(o1[4 * g + 2] * inv, o1[4 * g + 3] * inv);
            *(GAS v2u*)(op + 8 * g) = w0; *(GAS v2u*)(op + 32 + 8 * g) = w1; }
    }
    asm volatile("s_waitcnt vmcnt(0)" ::: "memory");
}

__device__ __forceinline__ void conv_simple(Frame& F, const Args& args, int L) {
    LAS float* ybuf = (LAS float*)(F.lds + RING_OFF); LAS float* stats = ybuf + 16 * 512;
    const bf16* U = WSP(bf16, WS_U); bf16* OC = WSP(bf16, WS_OC);
    const int c = F.tid, lane = F.lane;
    float w[CK];
#pragma unroll
    for (int j = 0; j < CK; ++j) w[j] = args.in[4][((size_t)L * CK + j) * CW + c];
    const float bias = args.in[5][L * CW + c], lg = args.in[6][L * CW + c], lb = args.in[7][L * CW + c];
    for (int unit = F.vcu; unit < M / 16; unit += F.G) {
        const int row0 = unit * 16, t0 = row0 & (SEQ - 1);
        float uu[46];
#pragma unroll
        for (int i = 0; i < 46; ++i) { const int tt = t0 - 30 + i; uu[i] = tt >= 0 ? __uint_as_float((unsigned)U[(size_t)(row0 - 30 + i) * CW + c] << 16) : 0.f; }
        float y[16];
#pragma unroll
        for (int tt = 0; tt < 16; ++tt) { float a = bias;
#pragma unroll
            for (int j = 0; j < CK; ++j) a += w[j] * uu[tt + j];
            y[tt] = a; ybuf[tt * 512 + c] = a; }
        __syncthreads();
#pragma unroll
        for (int q = 0; q < 2; ++q) { const int tt = 2 * F.wave + q; float v[8]; float s = 0.f;
#pragma unroll
            for (int i = 0; i < 8; ++i) { v[i] = ybuf[tt * 512 + lane + 64 * i]; s += v[i]; }
            const float mu = wave_sum(s) * (1.0f / 512.0f); float s2 = 0.f;
#pragma unroll
            for (int i = 0; i < 8; ++i) { const float dd = v[i] - mu; s2 += dd * dd; }
            const float var = wave_sum(s2) * (1.0f / 512.0f);
            if (lane == 0) { stats[2 * tt] = mu; stats[2 * tt + 1] = rsqrtf(var + EPS); } }
        __syncthreads();
#pragma unroll
        for (int tt = 0; tt < 16; ++tt) { const float yn = (y[tt] - stats[2 * tt]) * stats[2 * tt + 1] * lg + lb; const float ov = yn * sigm(yn);
            OC[(size_t)(row0 + tt) * DM + 512 + c] = (bf16)(cvt_pk_bf16(ov, 0.f) & 0xffffu); }
        __syncthreads();
    }
}
__device__ __forceinline__ void route_phase(Frame& F, const Args& args, int L) {
    LAS float* lgs = (LAS float*)(F.lds + RING_OFF) + F.wave * (8 * 40);
    const bf16* XB = WSP(bf16, WS_XB); const float* SSQ = WSP(float, WS_SSQ + (size_t)(3 * L + 1) * MiB); const bf16* WR = WSP(bf16, WS_WR) + (size_t)L * 64 * DM;
    int* ROUTE = WSP(int, WS_ROUTE); unsigned* cnt = (unsigned*)(F.ctl + CW_CNT + 64 * L);
    const int lane = F.lane, gw = F.vcu * NWAVES + F.wave, NGW = F.G * NWAVES;
    int vz = 0; asm volatile("" : "+v"(vz));
    const float bias = lane < 4 ? args.in[14][L * NGRP + lane] : (lane < 36 ? args.in[16][L * NEXP + lane - 4] : 0.f);
    for (int tb = gw; tb < M / 8; tb += NGW) {
        const int t0 = tb * 8;
        const GAS v4u* wp = (const GAS v4u*)(WR + (size_t)lane * DM);
        float a[8];
#pragma unroll
        for (int tt = 0; tt < 8; ++tt) a[tt] = 0.f;
        for (int kc = 0; kc < 128; ++kc) { const v4u w = wp[kc];
#pragma unroll
            for (int tt = 0; tt < 8; ++tt) { const v4u x = *((const GAS v4u*)(XB + (size_t)(t0 + tt) * DM) + kc + vz);
                a[tt] = dot2bf(w.x, x.x, a[tt]); a[tt] = dot2bf(w.y, x.y, a[tt]); a[tt] = dot2bf(w.z, x.z, a[tt]); a[tt] = dot2bf(w.w, x.w, a[tt]); } }
        float rr = 0.f;
#pragma unroll
        for (int tt = 0; tt < 8; ++tt) { const float r = rscale_of(SSQ + vz, t0 + tt); if (lane == tt) rr = r; if (lane < 36) lgs[tt * 40 + lane] = a[tt] * r + bias; }
        LDS_WAIT(); asm volatile("" ::: "memory");
        if (lane < 8) {
            const int t = t0 + lane; const LAS float* lp = lgs + lane * 40;
            float mxv = -1e30f; int gs = 0; float l4[4];
#pragma unroll
            for (int i = 0; i < 4; ++i) { l4[i] = lp[i]; if (l4[i] > mxv) { mxv = l4[i]; gs = i; } }
            float se = 0.f;
#pragma unroll
            for (int i = 0; i < 4; ++i) se += __expf(l4[i] - mxv);
            const float pg = 1.0f / se;
            float v1 = -1e30f, v2 = -1e30f; int i1 = 0, i2 = 0;
#pragma unroll
            for (int i = 0; i < 8; ++i) { const float v = lp[4 + gs * 8 + i]; if (v > v1) { v2 = v1; i2 = i1; v1 = v; i1 = i; } else if (v > v2) { v2 = v; i2 = i; } }
            const float e2 = __expf(v2 - v1), s1 = 1.0f / (1.0f + e2);
            const int ea = gs * 8 + i1, eb = gs * 8 + i2;
            const unsigned ia = atomicAdd(cnt + ea, 1u), ib = atomicAdd(cnt + eb, 1u);
            v4u r0, r1; r0.x = (unsigned)ea; r0.y = (unsigned)eb; r0.z = ia; r0.w = ib; r1.x = __float_as_uint(pg * s1); r1.y = __float_as_uint(pg * e2 * s1); r1.z = __float_as_uint(rr); r1.w = 0u;
            *(GAS v4u*)(ROUTE + (size_t)t * 8) = r0; *(GAS v4u*)(ROUTE + (size_t)t * 8 + 4) = r1;
        }
        LDS_WAIT(); asm volatile("" ::: "memory");
    }
}
__device__ __forceinline__ void moe_offsets(Frame& F, int L) {
    volatile LAS int* offs = (volatile LAS int*)(F.lds + OFFS_OFF);
    __syncthreads();
    if (F.tid == 0) { int acc = 0;
        for (int e = 0; e < NEXP; ++e) { offs[e] = acc; const unsigned c = __hip_atomic_load(F.ctl + CW_CNT + 64 * L + e, RLX_AGENT); acc += (int)((c + 255u) & ~255u); }
        offs[NEXP] = acc; }
    __syncthreads();
}
__device__ __forceinline__ void dispatch_phase(Frame& F, int L) {
    moe_offsets(F, L);
    const volatile LAS int* offs = (const volatile LAS int*)(F.lds + OFFS_OFF);
    const bf16* XB = WSP(bf16, WS_XB); bf16* XG = WSP(bf16, WS_XG); const int* ROUTE = WSP(int, WS_ROUTE); int* POS = WSP(int, WS_POS); float* RSC = WSP(float, WS_RSC); float* ROWG = WSP(float, WS_ROWG);
    const int lane = F.lane, gw = F.vcu * NWAVES + F.wave, NGW = F.G * NWAVES;
    int vz = 0; asm volatile("" : "+v"(vz));
    for (int t = gw; t < M; t += NGW) {
        const v4u r0 = *(const GAS v4u*)(ROUTE + (size_t)t * 8 + vz), r1 = *(const GAS v4u*)(ROUTE + (size_t)t * 8 + 4 + vz);
        const int s0 = offs[r0.x] + (int)r0.z, s1 = offs[r0.y] + (int)r0.w;
        const GAS v4u* src = (const GAS v4u*)(XB + (size_t)t * DM) + lane; const v4u a = src[0], b = src[64];
        GAS v4u* d0 = (GAS v4u*)(XG + (size_t)s0 * DM) + lane; GAS v4u* d1 = (GAS v4u*)(XG + (size_t)s1 * DM) + lane;
        d0[0] = a; d0[64] = b; d1[0] = a; d1[64] = b;
        if (lane == 0) { POS[2 * t] = s0; POS[2 * t + 1] = s1; RSC[s0] = __uint_as_float(r1.z); RSC[s1] = __uint_as_float(r1.z); ROWG[s0] = __uint_as_float(r1.x); ROWG[s1] = __uint_as_float(r1.y); }
    }
}
__device__ __forceinline__ void combine_phase(Frame& F, int L) {
    float* X = F.out; bf16* XB = WSP(bf16, WS_XB); const bf16* Y = WSP(bf16, WS_Y); const int* POS = WSP(int, WS_POS); float* SSQ = WSP(float, WS_SSQ + (size_t)(3 * L + 2) * MiB);
    const int lane = F.lane, gw = F.vcu * NWAVES + F.wave, NGW = F.G * NWAVES;
    int vz = 0; asm volatile("" : "+v"(vz));
    for (int t = gw; t < M; t += NGW) {
        const int s0 = POS[2 * t + vz], s1 = POS[2 * t + 1 + vz];
        GAS f32x4* xr = (GAS f32x4*)(X + (size_t)t * DM) + lane; const GAS v2u* y0 = (const GAS v2u*)(Y + (size_t)s0 * DM) + lane; const GAS v2u* y1 = (const GAS v2u*)(Y + (size_t)s1 * DM) + lane;
        GAS v2u* xb = (GAS v2u*)(XB + (size_t)t * DM) + lane; float s = 0.f;
#pragma unroll
        for (int j = 0; j < 4; ++j) { f32x4 v = xr[64 * j]; const v2u a = y0[64 * j], b = y1[64 * j];
            v[0] += bf_lo(a.x) + bf_lo(b.x); v[1] += bf_hi(a.x) + bf_hi(b.x); v[2] += bf_lo(a.y) + bf_lo(b.y); v[3] += bf_hi(a.y) + bf_hi(b.y);
            xr[64 * j] = v; v2u w; w.x = cvt_pk_bf16(v[0], v[1]); w.y = cvt_pk_bf16(v[2], v[3]); xb[64 * j] = w;
            s += (v[0] * v[0] + v[1] * v[1]) + (v[2] * v[2] + v[3] * v[3]); }
        const float tot = wave_sum(s);
        if (lane < 16) SSQ[(size_t)t * 16 + lane] = lane == 0 ? tot : 0.f;
    }
}
__device__ __forceinline__ void final_norm_phase(Frame& F, const Args& args) {
    float* X = F.out; const float* g = args.in[23];
    const int lane = F.lane, gw = F.vcu * NWAVES + F.wave, NGW = F.G * NWAVES;
    for (int t = gw; t < M; t += NGW) {
        GAS f32x4* xr = (GAS f32x4*)(X + (size_t)t * DM) + lane; f32x4 v[4]; float s = 0.f;
#pragma unroll
        for (int j = 0; j < 4; ++j) { v[j] = xr[64 * j]; s += (v[j][0] * v[j][0] + v[j][1] * v[j][1]) + (v[j][2] * v[j][2] + v[j][3] * v[j][3]); }
        const float r = rsqrtf(wave_sum(s) * (1.0f / DM) + EPS);
#pragma unroll
        for (int j = 0; j < 4; ++j) { const f32x4 gv = *((const f32x4*)g + lane + 64 * j); xr[64 * j] = v[j] * r * gv; }
    }
}
#ifndef MK_DUP
#define MK_DUP (-1)
#endif
#ifdef MK_REFGEMM
#define GEMM_BODY gemm_phase_ref
#else
#define GEMM_BODY gemm_phase
#endif
#ifndef MK_EN
#define MK_EN 0xfff
#endif
__global__ void __launch_bounds__(NWAVES * 64, 2) mk_fwd(Args args) {
    extern __shared__ __attribute__((aligned(16))) unsigned char lds[];
    Frame F;
    F.lds = (LAS unsigned char*)lds;
    F.MISC = (volatile LAS unsigned*)(F.lds + MISC_OFF);
    F.tid = threadIdx.x; F.lane = F.tid & 63; F.wave = __builtin_amdgcn_readfirstlane(F.tid >> 6);
    F.G = gridDim.x; { const int bx = blockIdx.x; F.vcu = (F.G % 8 == 0) ? (bx % 8) * (F.G / 8) + bx / 8 : bx; }
    F.ws = args.ws; F.out = args.out; F.ctl = (gu32*)(args.ws + WS_CTL);
    for (int u = F.tid; u < (LDS_BYTES - LDSCTL_OFF) / 4; u += NWAVES * 64) ((LAS unsigned*)(F.lds + LDSCTL_OFF))[u] = 0u;
    __syncthreads();
    XcdBarrier bar; bar.bar = (unsigned*)(F.ctl + CW_BAR); bar.x = 0; bar.st = nullptr;
    if (args.use_bar) bar = xcd_barrier_post((unsigned*)(F.ctl + CW_BAR), F.MISC + 8);
    const int cblk = (int)blockIdx.x;
#define PHASE_SEAM(ph_) do { if ((ph_) + 1 < args.ph_hi) { if (args.use_bar) { xcd_barrier(bar); } else { VM_WAIT(); __syncthreads(); } } } while (0)
    int ph0 = args.ph_lo;
    if (ph0 == 0 && (MK_EN & 1)) { p0_prologue(F, args); if (MK_DUP == 0) { xcd_barrier(bar); p0_prologue(F, args); } PHASE_SEAM(0); ph0 = 1; }
    for (int ph = ph0; ph < args.ph_hi; ++ph) {
      for (int rep_ = (ph == MK_DUP ? 2 : 1); rep_ > 0; --rep_) {
        { int t_ = threadIdx.x; asm volatile("" : "+v"(t_)); F.tid = t_; F.lane = t_ & 63; F.wave = __builtin_amdgcn_readfirstlane(t_ >> 6); }
        if (ph == PH_FINAL && (MK_EN & 2)) {
            final_norm_phase(F, args);
        } else {
            const int L = (ph - 1) / PH_PER_LAYER, sub = (ph - 1) % PH_PER_LAYER;
            const char* wl = (const char*)(F.ws + WS_W + (size_t)L * W_LAYER);
            float* SSQ0 = WSP(float, WS_SSQ + (size_t)(3 * L) * MiB);
            if (sub == 0 && (MK_EN & (4 << 0))) {
                SchedGrid S{64, 18, F.G, cblk, (const char*)WSP(bf16, WS_XB), wl + WO_WIN, (size_t)256 * 1024 * 2, (size_t)256 * 1024 * 2};
                EpiP1 E{SSQ0, WSP(float, WS_COS), WSP(float, WS_SIN), WSP(bf16, WS_Q), WSP(bf16, WS_K), WSP(bf16, WS_V), WSP(bf16, WS_U), WSP(bf16, WS_SGA), WSP(bf16, WS_SGB)};
                pg8::GEMM_BODY<EpiP1, SchedGrid, true>(F.lds + RING_OFF, pg8::Dims{1024, 1024, 1024}, S, E);
            } else if (sub == 1 && (MK_EN & (4 << 1))) {
#ifdef MK_ATTN_SIMPLE
                attn_simple(F);
#else
                attn_mfma(F); __syncthreads();
#endif
                conv_simple(F, args, L);
            } else if (sub == 2 && (MK_EN & (4 << 2))) {
                SchedP3 S{F.G, cblk, (const char*)WSP(bf16, WS_OC), wl + WO_WAO, wl + WO_WCO};
                EpiP3 E{WSP(bf16, WS_SGA), WSP(bf16, WS_SGB), args.in[10] + L * DM, WSP(bf16, WS_MG)};
                pg8::GEMM_BODY<EpiP3, SchedP3, true>(F.lds + RING_OFF, pg8::Dims{512, 1024, 512}, S, E);
            } else if (sub == 3 && (MK_EN & (4 << 3))) {
                SchedGrid S{64, 4, F.G, cblk, (const char*)WSP(bf16, WS_MG), wl + WO_WOUT, (size_t)256 * 1024 * 2, (size_t)256 * 1024 * 2};
                EpiP4 E{L == 0 ? args.in[0] : F.out, F.out, WSP(bf16, WS_XB), WSP(float, WS_SSQ + (size_t)(3 * L + 1) * MiB)};
                pg8::GEMM_BODY<EpiP4, SchedGrid, false>(F.lds + RING_OFF, pg8::Dims{1024, 1024, 1024}, S, E);
            } else if (sub == 4 && (MK_EN & (4 << 4))) {
                {
                    SchedGrid S{64, 1, F.G, cblk, (const char*)WSP(bf16, WS_XB), (const char*)(WSP(bf16, WS_WR) + (size_t)L * 256 * DM), (size_t)256 * 1024 * 2, (size_t)0};
                    EpiRoute E{WSP(float, WS_SSQ + (size_t)(3 * L + 1) * MiB), WSP(float, WS_RB) + L * 64, WSP(float, WS_LG)};
                    pg8::GEMM_BODY<EpiRoute, SchedGrid, false>(F.lds + RING_OFF, pg8::Dims{1024, 1024, 1024}, S, E);
                    VM_WAIT(); __syncthreads();
                    for (int l_ = cblk; l_ < 64; l_ += F.G) { int pm_, pn_; pg8::tile_of(l_, 64, 1, pm_, pn_); route_decide(F, L, pm_); }
                }
                {
                    const bool split = F.G >= 128;
                    SchedGrid S{64, 4, split ? F.G - 64 : F.G, split ? (cblk >= 64 ? cblk - 64 : 256) : cblk, (const char*)(WSP(bf16, WS_PB) + (size_t)L * M * PLE), wl + WO_WPP, (size_t)256 * 256 * 2, (size_t)256 * 256 * 2};
                    EpiBf16 E{WSP(bf16, WS_PE), DM};
                    pg8::GEMM_BODY<EpiBf16, SchedGrid, false>(F.lds + RING_OFF, pg8::Dims{256, 256, 256}, S, E);
                }
            } else if (sub == 5 && (MK_EN & (4 << 5))) {
                dispatch_phase(F, L);
            } else if (sub == 6 && (MK_EN & (4 << 6))) {
                moe_offsets(F, L);
                SchedMoe S{(const volatile LAS int*)(F.lds + OFFS_OFF), F.G, cblk, 1, (const char*)WSP(bf16, WS_XG), wl + WO_WGU};
                EpiUp E{WSP(float, WS_RSC), WSP(bf16, WS_H)};
                pg8::GEMM_BODY<EpiUp, SchedMoe, true>(F.lds + RING_OFF, pg8::Dims{1024, 1024, 1024}, S, E);
            } else if (sub == 7 && (MK_EN & (4 << 7))) {
                moe_offsets(F, L);
                SchedMoe S{(const volatile LAS int*)(F.lds + OFFS_OFF), F.G, cblk, 0, (const char*)WSP(bf16, WS_H), wl + WO_WD};
                EpiDown E{WSP(float, WS_ROWG), WSP(bf16, WS_Y)};
                pg8::GEMM_BODY<EpiDown, SchedMoe, true>(F.lds + RING_OFF, pg8::Dims{512, 512, 512}, S, E);
            } else if (sub == 8 && (MK_EN & (4 << 8))) {
                combine_phase(F, L);
            } else if (MK_EN & (4 << 9)) {
                SchedGrid S{64, 4, F.G, cblk, (const char*)WSP(bf16, WS_XB), wl + WO_WPG, (size_t)256 * 1024 * 2, (size_t)256 * 1024 * 2};
                EpiP8 E{WSP(float, WS_SSQ + (size_t)(3 * L + 2) * MiB), WSP(bf16, WS_PE), F.out, F.out, WSP(bf16, WS_XB), WSP(float, WS_SSQ + (size_t)(3 * L + 3) * MiB)};
                pg8::GEMM_BODY<EpiP8, SchedGrid, false>(F.lds + RING_OFF, pg8::Dims{1024, 1024, 1024}, S, E);
            }
        }
        if (rep_ > 1) xcd_barrier(bar);
      }
        PHASE_SEAM(ph);
    }
}

#ifndef MK_OPT_PHASES
#define MK_OPT_PHASES 22
#endif
#ifndef MK_REPEAT
#define MK_REPEAT 1
#endif
#ifndef MK_SINGLE
#define MK_SINGLE 0
#endif
#if MK_OPT_PHASES < 22
static void naive_tail(hipStream_t stream, void* const* d_in, float* X, float* out, char* ws, int L0, int st0) {
    using namespace naive;
    const float* p = (const float*)d_in[1]; const float* norm_mix = (const float*)d_in[2]; const float* w_in = (const float*)d_in[3];
    const float* w_dw = (const float*)d_in[4]; const float* b_dw = (const float*)d_in[5]; const float* ln_g = (const float*)d_in[6]; const float* ln_b = (const float*)d_in[7];
    const float* w_ao = (const float*)d_in[8]; const float* w_co = (const float*)d_in[9]; const float* b_co = (const float*)d_in[10]; const float* w_out = (const float*)d_in[11];
    const float* norm_ffn = (const float*)d_in[12]; const float* w_rg = (const float*)d_in[13]; const float* b_rg = (const float*)d_in[14]; const float* w_re = (const float*)d_in[15]; const float* b_re = (const float*)d_in[16];
    const float* w_eg = (const float*)d_in[17]; const float* w_eu = (const float*)d_in[18]; const float* w_ed = (const float*)d_in[19];
    const float* norm_ple = (const float*)d_in[20]; const float* w_pp = (const float*)d_in[21]; const float* w_pg = (const float*)d_in[22]; const float* norm_final = (const float*)d_in[23];
    constexpr size_t MiB_ = 1u << 20;
    float* Hn = (float*)(ws + 0 * MiB_); float* QKV = (float*)(ws + 64 * MiB_); float* CUG = (float*)(ws + 160 * MiB_); float* GAB = (float*)(ws + 224 * MiB_);
    float* AO = (float*)(ws + 352 * MiB_); float* CO = (float*)(ws + 384 * MiB_);
    float* YA = Hn; float* YB = QKV;
    float* LG = CUG; float* LE = CUG + (size_t)M_ * 4; int* EID = (int*)(CUG + (size_t)M_ * 40); float* GT = CUG + (size_t)M_ * 48;
    float* GL = GAB; float* PE = QKV;
    for (int L = L0; L < DEPTH_; ++L) {
        const int s0 = (L == L0) ? st0 : 0;
        if (s0 <= 0) {
            hipLaunchKernelGGL(rmsnorm_k, dim3(M_ / 4), dim3(256), 0, stream, X, norm_mix + L * D_, Hn);
            const float* win = w_in + (size_t)L * D_ * WIN_;
            sgemm(stream, Hn, D_, win, WIN_, QKV, 1536, M_, 1536, D_, nullptr, nullptr);
            sgemm(stream, Hn, D_, win + 1536, WIN_, CUG, 1024, M_, 1024, D_, nullptr, nullptr);
            sgemm(stream, Hn, D_, win + 2560, WIN_, GAB, 2048, M_, 2048, D_, nullptr, nullptr);
            hipLaunchKernelGGL(rope_k, dim3(M_ * 2 * H_ * 32 / 256), dim3(256), 0, stream, QKV);
            hipLaunchKernelGGL(attn_naive_k, dim3(M_ * H_ / 4), dim3(256), 0, stream, QKV, AO);
            hipLaunchKernelGGL(conv_naive_k, dim3(M_), dim3(512), 0, stream, CUG, w_dw + (size_t)L * CK_ * CW_, b_dw + L * CW_, ln_g + L * CW_, ln_b + L * CW_, CO);
            sgemm(stream, AO, 512, w_ao + (size_t)L * 512 * D_, D_, YA, D_, M_, D_, 512, nullptr, nullptr);
            sgemm(stream, CO, 512, w_co + (size_t)L * 512 * D_, D_, YB, D_, M_, D_, 512, b_co + L * D_, nullptr);
            hipLaunchKernelGGL(merge_k, dim3(M_ * D_ / 256), dim3(256), 0, stream, GAB, YA, YB);
            sgemm(stream, GAB, 2048, w_out + (size_t)L * D_ * D_, D_, X, D_, M_, D_, D_, nullptr, X);
        }
        if (s0 <= 1) {
            hipLaunchKernelGGL(rmsnorm_k, dim3(M_ / 4), dim3(256), 0, stream, X, norm_ffn + L * D_, Hn);
            sgemm(stream, Hn, D_, w_rg + (size_t)L * D_ * NG_, NG_, LG, 4, M_, 4, D_, b_rg + L * NG_, nullptr);
            sgemm(stream, Hn, D_, w_re + (size_t)L * D_ * NE_, NE_, LE, 32, M_, 32, D_, b_re + L * NE_, nullptr);
            hipLaunchKernelGGL(route_k, dim3(M_ / 256), dim3(256), 0, stream, LG, LE, EID, GT);
            hipLaunchKernelGGL(moe_naive_k, dim3(M_), dim3(256), 0, stream, Hn, EID, GT, w_eg + (size_t)L * NE_ * D_ * FF_, w_eu + (size_t)L * NE_ * D_ * FF_, w_ed + (size_t)L * NE_ * FF_ * D_, X);
        }
        if (s0 <= 2) {
            hipLaunchKernelGGL(rmsnorm_k, dim3(M_ / 4), dim3(256), 0, stream, X, norm_ple + L * D_, Hn);
            sgemm(stream, Hn, D_, w_pg + (size_t)L * D_ * D_, D_, GL, D_, M_, D_, D_, nullptr, nullptr);
            sgemm(stream, p + (size_t)L * M_ * PLE_, PLE_, w_pp + (size_t)L * PLE_ * D_, D_, PE, D_, M_, D_, PLE_, nullptr, nullptr);
            hipLaunchKernelGGL(ple_k, dim3(M_ * D_ / 256), dim3(256), 0, stream, X, GL, PE);
        }
    }
    hipLaunchKernelGGL(rmsnorm_k, dim3(M_ / 4), dim3(256), 0, stream, X, norm_final, out);
}
#endif


#if MK_OPT_PHASES < 22
namespace dbg {
__device__ __forceinline__ float b2f(unsigned short u) { return __uint_as_float((unsigned)u << 16); }
__global__ void __launch_bounds__(256) cvt_qkv_k(const unsigned short* Q, const unsigned short* K, const unsigned short* V, float* qkv) {
    const size_t idx = (size_t)blockIdx.x * 256 + threadIdx.x;
    const int tok = (int)(idx >> 9), col = (int)(idx & 511), h = col >> 6, d = col & 63, b = tok >> 11, t = tok & 2047;
    const size_t src = ((size_t)(b * 8 + h) * 2048 + t) * 64 + d;
    qkv[(size_t)tok * 1536 + col] = b2f(Q[src]) * (1.0f / (0.125f * 1.4426950408889634f));
    qkv[(size_t)tok * 1536 + 512 + col] = b2f(K[src]);
    qkv[(size_t)tok * 1536 + 1024 + col] = b2f(V[src]);
}
__global__ void __launch_bounds__(512) conv_from_u_k(const unsigned short* __restrict__ U, const float* __restrict__ wdw, const float* __restrict__ bdw,
                                                     const float* __restrict__ lg, const float* __restrict__ lb, float* __restrict__ co) {
    __shared__ float red[16];
    const int tok = blockIdx.x, c = threadIdx.x, t = tok % 2048;
    float y = bdw[c];
    for (int j = 0; j < 31; ++j) { const int tt = t - 30 + j; if (tt >= 0) y += wdw[j * 512 + c] * b2f(U[(size_t)(tok - 30 + j) * 512 + c]); }
    float s = naive::wave_sum(y);
    if ((c & 63) == 0) red[c >> 6] = s;
    __syncthreads();
    float mu = 0.f;
    for (int i = 0; i < 8; ++i) mu += red[i];
    mu *= (1.f / 512.f);
    const float dv = y - mu;
    float s2 = naive::wave_sum(dv * dv);
    if ((c & 63) == 0) red[8 + (c >> 6)] = s2;
    __syncthreads();
    float var = 0.f;
    for (int i = 0; i < 8; ++i) var += red[8 + i];
    var *= (1.f / 512.f);
    const float yn = dv * rsqrtf(var + 1e-6f) * lg[c] + lb[c];
    co[(size_t)tok * 512 + c] = yn / (1.f + expf(-yn));
}
__global__ void __launch_bounds__(256) merge_sig_k(const unsigned short* sga, const unsigned short* sgb, const float* ya, const float* yb, float* mg) {
    const size_t idx = (size_t)blockIdx.x * 256 + threadIdx.x;
    mg[idx] = b2f(sga[idx]) * ya[idx] + b2f(sgb[idx]) * yb[idx];
}
__global__ void __launch_bounds__(256) cvt_oc_k(const unsigned short* oc, float* ao, float* co) {
    const size_t idx = (size_t)blockIdx.x * 256 + threadIdx.x;
    const size_t m = idx >> 10; const int n = (int)(idx & 1023);
    const float v = b2f(oc[idx]);
    if (n < 512) ao[m * 512 + n] = v; else co[m * 512 + n - 512] = v;
}
__global__ void __launch_bounds__(256) cvt_bf_k(const unsigned short* src, float* dst) {
    const size_t idx = (size_t)blockIdx.x * 256 + threadIdx.x; dst[idx] = b2f(src[idx]);
}
}
static void dbg_mixer_tail(hipStream_t stream, void* const* d_in, float* X, char* ws, int nopt) {
    using namespace naive;
    constexpr size_t MiB_ = 1u << 20;
    const float* w_dw = (const float*)d_in[4]; const float* b_dw = (const float*)d_in[5]; const float* ln_g = (const float*)d_in[6]; const float* ln_b = (const float*)d_in[7];
    const float* w_ao = (const float*)d_in[8]; const float* w_co = (const float*)d_in[9]; const float* b_co = (const float*)d_in[10]; const float* w_out = (const float*)d_in[11];
    float* Hn = (float*)(ws + 0 * MiB_); float* QKV = (float*)(ws + 64 * MiB_); float* YBb = (float*)(ws + 160 * MiB_); float* MGf = (float*)(ws + 224 * MiB_);
    float* AO = (float*)(ws + 288 * MiB_); float* CO = (float*)(ws + 320 * MiB_);
    const unsigned short* Qb = (const unsigned short*)(ws + WS_Q); const unsigned short* Kb = (const unsigned short*)(ws + WS_K); const unsigned short* Vb = (const unsigned short*)(ws + WS_V);
    const unsigned short* Ub = (const unsigned short*)(ws + WS_U); const unsigned short* SGAb = (const unsigned short*)(ws + WS_SGA); const unsigned short* SGBb = (const unsigned short*)(ws + WS_SGB);
    const unsigned short* OCb = (const unsigned short*)(ws + WS_OC); const unsigned short* MGb = (const unsigned short*)(ws + WS_MG);
    (void)hipMemcpyAsync(X, d_in[0], (size_t)M_ * D_ * 4, hipMemcpyDeviceToDevice, stream);
    if (nopt == 2) {
        hipLaunchKernelGGL(dbg::cvt_qkv_k, dim3(M_ * 512 / 256), dim3(256), 0, stream, Qb, Kb, Vb, QKV);
        hipLaunchKernelGGL(attn_naive_k, dim3(M_ * H_ / 4), dim3(256), 0, stream, QKV, AO);
        hipLaunchKernelGGL(dbg::conv_from_u_k, dim3(M_), dim3(512), 0, stream, Ub, w_dw, b_dw, ln_g, ln_b, CO);
    } else if (nopt == 3) {
        hipLaunchKernelGGL(dbg::cvt_oc_k, dim3(M_ * D_ / 256), dim3(256), 0, stream, OCb, AO, CO);
    }
    if (nopt <= 3) {
        sgemm(stream, AO, 512, w_ao, D_, Hn, D_, M_, D_, 512, nullptr, nullptr);
        sgemm(stream, CO, 512, w_co, D_, YBb, D_, M_, D_, 512, b_co, nullptr);
        hipLaunchKernelGGL(dbg::merge_sig_k, dim3(M_ * D_ / 256), dim3(256), 0, stream, SGAb, SGBb, Hn, YBb, MGf);
    } else {
        hipLaunchKernelGGL(dbg::cvt_bf_k, dim3(M_ * D_ / 256), dim3(256), 0, stream, MGb, MGf);
    }
    sgemm(stream, MGf, D_, w_out, D_, X, D_, M_, D_, D_, nullptr, X);
}
#endif

#if MK_OPT_PHASES < 22
namespace dbg {
__global__ void __launch_bounds__(256) hash_k(const unsigned* buf, size_t nwords, unsigned* out) {
    unsigned acc = 0u;
    for (size_t i = (size_t)blockIdx.x * 256 + threadIdx.x; i < nwords; i += (size_t)gridDim.x * 256) acc += buf[i] * (2654435761u * (unsigned)(2 * i + 1)) + (unsigned)i;
    for (int o = 1; o < 64; o <<= 1) acc += __shfl_xor(acc, o);
    if ((threadIdx.x & 63) == 0) atomicAdd(out, acc);
}
__global__ void __launch_bounds__(256) perturb_k(float* out, size_t first, size_t count, const unsigned* hash) {
    const size_t i = (size_t)blockIdx.x * 256 + threadIdx.x;
    if (i < count) out[first + i] += (float)(hash[0] >> 8) * (1.0f / 16777216.0f);
}
}
static void dbg_hash(hipStream_t st, const void* buf, size_t bytes, unsigned* cell) { hipLaunchKernelGGL(dbg::hash_k, dim3(1024), dim3(256), 0, st, (const unsigned*)buf, bytes / 4, cell); }
#endif

#if MK_OPT_PHASES < 22
#ifndef DBG_USE
#define DBG_USE 7
#endif
static void dbg_p1_tail(hipStream_t stream, void* const* d_in, float* X, char* ws) {
    using namespace naive;
    constexpr size_t MiB_ = 1u << 20;
    const float* norm_mix = (const float*)d_in[2]; const float* w_in = (const float*)d_in[3];
    const float* w_dw = (const float*)d_in[4]; const float* b_dw = (const float*)d_in[5]; const float* ln_g = (const float*)d_in[6]; const float* ln_b = (const float*)d_in[7];
    const float* w_ao = (const float*)d_in[8]; const float* w_co = (const float*)d_in[9]; const float* b_co = (const float*)d_in[10]; const float* w_out = (const float*)d_in[11];
    float* Hn = (float*)(ws + 0 * MiB_); float* QKV = (float*)(ws + 64 * MiB_); float* CUG = (float*)(ws + 160 * MiB_); float* GAB = (float*)(ws + 224 * MiB_);
    float* AO = (float*)(ws + 480 * MiB_); float* CO = (float*)(ws + 64 * MiB_); float* YA = Hn; float* YB = (float*)(ws + 96 * MiB_); float* MGf = (float*)(ws + 160 * MiB_);
    const unsigned short* Qb = (const unsigned short*)(ws + WS_Q); const unsigned short* Kb = (const unsigned short*)(ws + WS_K); const unsigned short* Vb = (const unsigned short*)(ws + WS_V);
    const unsigned short* Ub = (const unsigned short*)(ws + WS_U); const unsigned short* SGAb = (const unsigned short*)(ws + WS_SGA); const unsigned short* SGBb = (const unsigned short*)(ws + WS_SGB);
    (void)hipMemcpyAsync(X, d_in[0], (size_t)M_ * D_ * 4, hipMemcpyDeviceToDevice, stream);
    hipLaunchKernelGGL(rmsnorm_k, dim3(M_ / 4), dim3(256), 0, stream, X, norm_mix, Hn);
    if (DBG_USE & 1) hipLaunchKernelGGL(dbg::cvt_qkv_k, dim3(M_ * 512 / 256), dim3(256), 0, stream, Qb, Kb, Vb, QKV);
    else { sgemm(stream, Hn, D_, w_in, WIN_, QKV, 1536, M_, 1536, D_, nullptr, nullptr); hipLaunchKernelGGL(rope_k, dim3(M_ * 2 * H_ * 32 / 256), dim3(256), 0, stream, QKV); }
    if (!(DBG_USE & 2)) sgemm(stream, Hn, D_, w_in + 1536, WIN_, CUG, 1024, M_, 1024, D_, nullptr, nullptr);
    if (!(DBG_USE & 4)) sgemm(stream, Hn, D_, w_in + 2560, WIN_, GAB, 2048, M_, 2048, D_, nullptr, nullptr);
    hipLaunchKernelGGL(attn_naive_k, dim3(M_ * H_ / 4), dim3(256), 0, stream, QKV, AO);
    if (DBG_USE & 2) hipLaunchKernelGGL(dbg::conv_from_u_k, dim3(M_), dim3(512), 0, stream, Ub, w_dw, b_dw, ln_g, ln_b, CO);
    else hipLaunchKernelGGL(conv_naive_k, dim3(M_), dim3(512), 0, stream, CUG, w_dw, b_dw, ln_g, ln_b, CO);
    sgemm(stream, AO, 512, w_ao, D_, YA, D_, M_, D_, 512, nullptr, nullptr);
    sgemm(stream, CO, 512, w_co, D_, YB, D_, M_, D_, 512, b_co, nullptr);
    if (DBG_USE & 4) { hipLaunchKernelGGL(dbg::merge_sig_k, dim3(M_ * D_ / 256), dim3(256), 0, stream, SGAb, SGBb, YA, YB, MGf); sgemm(stream, MGf, D_, w_out, D_, X, D_, M_, D_, D_, nullptr, X); }
    else { hipLaunchKernelGGL(merge_k, dim3(M_ * D_ / 256), dim3(256), 0, stream, GAB, YA, YB); sgemm(stream, GAB, 2048, w_out, D_, X, D_, M_, D_, D_, nullptr, X); }
}
#endif

extern "C" void kernel_launch(void* const* d_in, const int* in_sizes, int n_in, void* d_out, int out_size, void* d_ws, size_t ws_size, hipStream_t stream) {
    static int grid = 0;
    if (grid == 0) {
        if (n_in != 24 || in_sizes[0] != M * DM || out_size != M * DM || ws_size < WS_END) { fprintf(stderr, "kernel_launch: unexpected shapes (n_in %d, in0 %d, out %d, ws %zu); nothing launched\n", n_in, n_in > 0 ? in_sizes[0] : -1, out_size, ws_size); grid = -1; return; }
        int dev = 0, cus = 0, per_cu = 0;
        if (hipGetDevice(&dev) != hipSuccess || hipDeviceGetAttribute(&cus, hipDeviceAttributeMultiprocessorCount, dev) != hipSuccess) { fprintf(stderr, "kernel_launch: device query failed\n"); grid = -1; return; }
        if (hipFuncSetAttribute((const void*)mk_fwd, hipFuncAttributeMaxDynamicSharedMemorySize, LDS_BYTES) != hipSuccess) { fprintf(stderr, "kernel_launch: hipFuncSetAttribute failed\n"); grid = -1; return; }
        if (hipOccupancyMaxActiveBlocksPerMultiprocessor(&per_cu, (const void*)mk_fwd, NWAVES * 64, LDS_BYTES) != hipSuccess || per_cu < 1) { fprintf(stderr, "kernel_launch: occupancy query reports %d blocks per CU\n", per_cu); }
        (void)hipGetLastError();
        grid = cus;
    }
    if (grid < 0) return;
    (void)hipMemsetAsync((char*)d_ws + WS_CTL, 0, CTL_ZERO_BYTES, stream);
    Args a{};
    for (int i = 0; i < 24; ++i) a.in[i] = (const float*)d_in[i];
    a.out = (float*)d_out; a.ws = (unsigned char*)d_ws;
    constexpr int NOPT = MK_OPT_PHASES;
#if MK_SINGLE
    a.ph_lo = 0; a.ph_hi = NOPT; a.use_bar = 1;
    hipLaunchKernelGGL(mk_fwd, dim3(grid), dim3(NWAVES * 64), LDS_BYTES, stream, a);
#else
    for (int rep = 0; rep < MK_REPEAT; ++rep)
    for (int ph = 0; ph < NOPT; ++ph) { a.ph_lo = ph; a.ph_hi = ph + 1; a.use_bar = 0; hipLaunchKernelGGL(mk_fwd, dim3(grid), dim3(NWAVES * 64), LDS_BYTES, stream, a); }
#endif
#if defined(MK_PROBE)
    {
        constexpr size_t MiB_ = 1u << 20; char* ws = (char*)d_ws; unsigned* cells = (unsigned*)(ws + 520 * MiB_);
        (void)hipMemsetAsync(cells, 0, 256, stream);
        MK_PROBE
        (void)hipMemcpyAsync(d_out, d_in[0], (size_t)M * DM * 4, hipMemcpyDeviceToDevice, stream);
        naive_tail(stream, d_in, (float*)d_out, (float*)d_out, (char*)d_ws, 0, 0);
        hipLaunchKernelGGL(dbg::perturb_k, dim3((1u << 22) / 256), dim3(256), 0, stream, (float*)d_out, (size_t)0, (size_t)1 << 22, cells);
        hipLaunchKernelGGL(dbg::perturb_k, dim3((1u << 16) / 256), dim3(256), 0, stream, (float*)d_out, (size_t)1 << 23, (size_t)1 << 16, cells + 16);
    }
#elif MK_OPT_PHASES < 22
    {
        int L0 = 0, st0 = 0;
        if (NOPT <= 1) { (void)hipMemcpyAsync(d_out, d_in[0], (size_t)M * DM * 4, hipMemcpyDeviceToDevice, stream); }
        else if (NOPT == 2) { dbg_p1_tail(stream, d_in, (float*)d_out, (char*)d_ws); L0 = 0; st0 = 1; }
        else if (NOPT >= 3 && NOPT <= 4) { dbg_mixer_tail(stream, d_in, (float*)d_out, (char*)d_ws, NOPT); L0 = 0; st0 = 1; }
        else if (NOPT == 5) { L0 = 0; st0 = 1; } else if (NOPT == 10) { L0 = 0; st0 = 2; } else if (NOPT == 11) { L0 = 1; st0 = 0; }
        else if (NOPT == 15) { L0 = 1; st0 = 1; } else if (NOPT == 20) { L0 = 1; st0 = 2; } else if (NOPT == 21) { L0 = 2; st0 = 0; }
        naive_tail(stream, d_in, (float*)d_out, (float*)d_out, (char*)d_ws, L0, st0);
    }
#endif
}
```

```cpp
#define MK_OPT_PHASES 22
#define MK_SINGLE 1
#include <hip/hip_runtime.h>
#include <cstdio>
#include <cstdint>
#include <cmath>
namespace pg8 {
#define PG8_LAS __attribute__((address_space(3)))
typedef unsigned short bf16_t;
typedef short bf16x8 __attribute__((ext_vector_type(8)));
typedef float f32x4 __attribute__((ext_vector_type(4)));
typedef float f32x2 __attribute__((ext_vector_type(2)));
typedef unsigned u32x4 __attribute__((ext_vector_type(4)));
typedef unsigned u32x2 __attribute__((ext_vector_type(2)));
constexpr int BM = 256, BK = 64, HALF = 128, HTB = HALF * BK * 2  , STAGE_BYTES = 8 * HTB, NXCD = 8, WGM = 8;

__host__ __device__ __forceinline__ int lds_byte(int r, int c) { const int st = (r >> 4) * 2 + (c >> 5), rr = r & 15, cc = c & 31, ob = rr * 64 + cc * 2; return st * 1024 + (ob ^ (((ob >> 9) & 1) << 5)); }
__host__ __device__ __forceinline__ void stage_rc(int b, int& R, int& C) { const int st = b / 1024, sb = b % 1024, swz = sb ^ (((sb >> 9) & 1) << 5); R = (st >> 1) * 16 + swz / 64; C = (st & 1) * 32 + (swz % 64) / 2; }
__host__ __device__ __forceinline__ int perm32(int rho) { const int n = rho >> 4, i = rho & 15; return 8 * (i >> 2) + 4 * n + (i & 3); }

struct Unit { int pm, pn, aux; const char* A; const char* B; };
struct Dims { int K, lda, ldb; };

__host__ __device__ __forceinline__ void tile_of(int L, int nM, int nN, int& pm, int& pn) {
    const int nwg = nM * nN; int wgid = L; { const int q = nwg / NXCD, r = nwg % NXCD, xcd = wgid % NXCD, off = wgid / NXCD; wgid = (xcd < r ? xcd * (q + 1) : r * (q + 1) + (xcd - r) * q) + off; }
    const int nig = WGM * nN, gid = wgid / nig, fm = gid * WGM, gsz = (nM - fm) < WGM ? (nM - fm) : WGM;
    pm = fm + ((wgid % nig) % gsz); pn = (wgid % nig) / gsz;
}

typedef __bf16 bf16x2v __attribute__((ext_vector_type(2)));
__device__ __forceinline__ unsigned cvt_pk_bf16(float lo, float hi) { const f32x2 v = {lo, hi}; const bf16x2v b = __builtin_convertvector(v, bf16x2v); return __builtin_bit_cast(unsigned, b); }
__device__ __forceinline__ u32x4 pack8(const f32x4 a, const f32x4 b) { u32x4 w; w.x = cvt_pk_bf16(a[0], a[1]); w.y = cvt_pk_bf16(a[2], a[3]); w.z = cvt_pk_bf16(b[0], b[1]); w.w = cvt_pk_bf16(b[2], b[3]); return w; }
__device__ __forceinline__ float bf_lo(unsigned w) { return __uint_as_float(w << 16); }
__device__ __forceinline__ float bf_hi(unsigned w) { return __uint_as_float(w & 0xffff0000u); }
__device__ __forceinline__ void unpack8(const u32x4 w, f32x4& a, f32x4& b) { a[0] = bf_lo(w.x); a[1] = bf_hi(w.x); a[2] = bf_lo(w.y); a[3] = bf_hi(w.y); b[0] = bf_lo(w.z); b[1] = bf_hi(w.z); b[2] = bf_lo(w.w); b[3] = bf_hi(w.w); }
__device__ __forceinline__ float sigm(float x) { return __builtin_amdgcn_rcpf(1.0f + __builtin_amdgcn_exp2f(-1.4426950408889634f * x)); }
__device__ __forceinline__ f32x4 sigm4(const f32x4 x) { f32x4 r; r[0] = sigm(x[0]); r[1] = sigm(x[1]); r[2] = sigm(x[2]); r[3] = sigm(x[3]); return r; }

template <class Epi, class Sched, bool ALIGN_EPI>
__device__ __forceinline__ void gemm_phase(PG8_LAS unsigned char* lds, const Dims g, const Sched& S, const Epi& E) {
    int tid_ = threadIdx.x; asm volatile("" : "+v"(tid_));
    const int tid = tid_, wid = __builtin_amdgcn_readfirstlane(tid >> 6), lane = tid & 63, wr = wid >> 2, wc = wid & 3, fr = lane & 15, fq = lane >> 4;
    const int K = g.K, nt = K / BK;
    unsigned voffA[2], voffB[2];
#pragma unroll
    for (int i = 0; i < 2; ++i) { int R, C; stage_rc(tid * 16 + i * 8192, R, C); const int Rb = Epi::PERM ? ((R & ~31) + perm32(R & 31)) : R;
        voffA[i] = (unsigned)(R * g.lda + C) * 2u; voffB[i] = (unsigned)(Rb * g.ldb + C) * 2u; }
    const size_t kstep = (size_t)(BK * 2);
    const size_t hA = (size_t)HALF * g.lda * 2, hB = (size_t)HALF * g.ldb * 2;
    const unsigned ldsw = (unsigned)wid * 1024u;
    const int aoff = lds_byte(wr * 64 + fr, fq * 8), boff = lds_byte(wc * 32 + fr, fq * 8);
#define PG8_SA(b, h) (((b) * 2 + (h)) * HTB)
#define PG8_SB(b, h) ((4 + (b) * 2 + (h)) * HTB)
#define PG8_STAGE(bufoff, gbase, voff) do { _Pragma("unroll") for (int _i = 0; _i < 2; ++_i) \
        __builtin_amdgcn_global_load_lds((const unsigned*)((const char*)(gbase) + (voff)[_i]), (PG8_LAS unsigned*)(lds + (bufoff) + ldsw + _i * 8192), 16, 0, 0); } while (0)
#define PG8_LDA(dst, b, h) do { _Pragma("unroll") for (int m = 0; m < 4; ++m) _Pragma("unroll") for (int k = 0; k < 2; ++k) dst[m][k] = *(const PG8_LAS bf16x8*)(lds + PG8_SA(b, h) + aoff + m * 2048 + k * 1024); } while (0)
#define PG8_LDB(dst, b, h) do { _Pragma("unroll") for (int n = 0; n < 2; ++n) _Pragma("unroll") for (int k = 0; k < 2; ++k) dst[n][k] = *(const PG8_LAS bf16x8*)(lds + PG8_SB(b, h) + boff + n * 2048 + k * 1024); } while (0)
#define PG8_MMA(ai, bj, At, Bt) do { __builtin_amdgcn_s_setprio(1); _Pragma("unroll") for (int m = 0; m < 4; ++m) _Pragma("unroll") for (int n = 0; n < 2; ++n) _Pragma("unroll") for (int k = 0; k < 2; ++k) \
        acc[ai][bj][m][n] = __builtin_amdgcn_mfma_f32_16x16x32_bf16(Bt[n][k], At[m][k], acc[ai][bj][m][n], 0, 0, 0); __builtin_amdgcn_s_setprio(0); } while (0)
#define PG8_WAIT_V(n) asm volatile("s_waitcnt vmcnt(" #n ")" ::: "memory")
#define PG8_WAIT_L(n) asm volatile("s_waitcnt lgkmcnt(" #n ")" ::: "memory")
#define PG8_BAR __builtin_amdgcn_s_barrier()
#define PG8_SCHED __builtin_amdgcn_sched_barrier(0)
    Unit cur, nxt; int ui = 0;
    if (!S.next(0, cur)) return;
    f32x4 acc[2][2][4][2];
#pragma unroll
    for (int a = 0; a < 2; ++a)
#pragma unroll
        for (int b = 0; b < 2; ++b)
#pragma unroll
            for (int m = 0; m < 4; ++m)
#pragma unroll
                for (int n = 0; n < 2; ++n) acc[a][b][m][n] = (f32x4){0.f, 0.f, 0.f, 0.f};
    bf16x8 At[4][2], B0[2][2], B1[2][2];
    const char* cA = cur.A; const char* cB = cur.B;
    PG8_STAGE(PG8_SB(0, 0), cB, voffB); PG8_STAGE(PG8_SB(0, 1), cB + hB, voffB); PG8_STAGE(PG8_SA(0, 0), cA, voffA); PG8_STAGE(PG8_SA(0, 1), cA + hA, voffA);
    if (wr == 1) PG8_BAR;
    PG8_WAIT_V(2); PG8_BAR;
    PG8_STAGE(PG8_SB(1, 0), cB + kstep, voffB); PG8_STAGE(PG8_SA(1, 0), cA + kstep, voffA); PG8_STAGE(PG8_SB(1, 1), cB + hB + kstep, voffB);
    PG8_WAIT_V(6); PG8_BAR;
    for (;;) {
        const bool has_next = S.next(ui + 1, nxt);
        const char* nA = has_next ? nxt.A : cA; const char* nB = has_next ? nxt.B : cB;
        for (int t = 0; t < nt; t += 2) {
            const bool last = (t == nt - 2);
            const char* a1 = cA + (size_t)(t + 1) * kstep;
            const char* a2 = last ? nA : cA + (size_t)(t + 2) * kstep; const char* b2 = last ? nB : cB + (size_t)(t + 2) * kstep;
            const char* a3 = a2 + kstep; const char* b3 = b2 + kstep;
            PG8_LDB(B0, 0, 0); PG8_LDB(B1, 0, 1); PG8_SCHED; PG8_LDA(At, 0, 0); PG8_STAGE(PG8_SA(1, 1), a1 + hA, voffA);
            PG8_WAIT_V(8); PG8_WAIT_L(0); PG8_BAR; PG8_MMA(0, 0, At, B0); PG8_MMA(0, 1, At, B1); PG8_BAR; PG8_SCHED;
            PG8_LDA(At, 0, 1); PG8_STAGE(PG8_SB(0, 0), b2, voffB); PG8_STAGE(PG8_SB(0, 1), b2 + hB, voffB); PG8_STAGE(PG8_SA(0, 0), a2, voffA);
            PG8_WAIT_V(8); PG8_WAIT_L(0); PG8_BAR; PG8_MMA(1, 0, At, B0); PG8_MMA(1, 1, At, B1); PG8_BAR; PG8_SCHED;
            PG8_LDB(B0, 1, 0); PG8_LDB(B1, 1, 1); PG8_SCHED; PG8_LDA(At, 1, 0); PG8_STAGE(PG8_SA(0, 1), a2 + hA, voffA);
            PG8_WAIT_V(8); PG8_WAIT_L(0); PG8_BAR; PG8_MMA(0, 0, At, B0); PG8_MMA(0, 1, At, B1); PG8_BAR; PG8_SCHED;
            PG8_LDA(At, 1, 1); PG8_STAGE(PG8_SB(1, 0), b3, voffB); PG8_STAGE(PG8_SB(1, 1), b3 + hB, voffB); PG8_STAGE(PG8_SA(1, 0), a3, voffA);
            PG8_WAIT_V(8); PG8_WAIT_L(0); PG8_BAR; PG8_MMA(1, 0, At, B0); PG8_MMA(1, 1, At, B1); PG8_BAR; PG8_SCHED;
        }
        if constexpr (ALIGN_EPI) { if (wr == 0) PG8_BAR; }
        E(acc, cur, wr, wc, fr, fq);
        if (!has_next) break;
#pragma unroll
        for (int a = 0; a < 2; ++a)
#pragma unroll
            for (int b = 0; b < 2; ++b)
#pragma unroll
                for (int m = 0; m < 4; ++m)
#pragma unroll
                    for (int n = 0; n < 2; ++n) acc[a][b][m][n] = (f32x4){0.f, 0.f, 0.f, 0.f};
        cur = nxt; cA = nA; cB = nB; ++ui;
        if constexpr (ALIGN_EPI) { if (wr == 1) PG8_BAR; }
    }
    PG8_WAIT_V(0);
    if constexpr (!ALIGN_EPI) { if (wr == 0) PG8_BAR; }
    PG8_BAR;
#undef PG8_SA
#undef PG8_SB
#undef PG8_STAGE
#undef PG8_LDA
#undef PG8_LDB
#undef PG8_MMA
#undef PG8_WAIT_V
#undef PG8_WAIT_L
#undef PG8_BAR
#undef PG8_SCHED
}

template <class Epi, class Sched, bool ALIGN_EPI>
__device__ __forceinline__ void gemm_phase_ref(PG8_LAS unsigned char* lds, const Dims g, const Sched& S, const Epi& E) {
    int tid_ = threadIdx.x; asm volatile("" : "+v"(tid_));
    const int tid = tid_, wid = __builtin_amdgcn_readfirstlane(tid >> 6), lane = tid & 63, wr = wid >> 2, wc = wid & 3, fr = lane & 15, fq = lane >> 4;
    typedef __bf16 bf2 __attribute__((ext_vector_type(2)));
    Unit cur;
    for (int ui = 0; S.next(ui, cur); ++ui) {
        f32x4 acc[2][2][4][2];
#pragma unroll
        for (int a = 0; a < 2; ++a)
#pragma unroll
            for (int b = 0; b < 2; ++b)
#pragma unroll
                for (int m = 0; m < 4; ++m)
#pragma unroll
                    for (int n = 0; n < 2; ++n) acc[a][b][m][n] = (f32x4){0.f, 0.f, 0.f, 0.f};
        for (int k0 = 0; k0 < g.K; k0 += 8) {
            u32x4 av[2][4];
#pragma unroll
            for (int a = 0; a < 2; ++a)
#pragma unroll
                for (int m = 0; m < 4; ++m) av[a][m] = *(const u32x4*)(cur.A + ((size_t)(128 * a + 64 * wr + 16 * m + fr) * g.lda + k0) * 2);
#pragma unroll
            for (int b = 0; b < 2; ++b)
#pragma unroll
                for (int n = 0; n < 2; ++n)
#pragma unroll
                    for (int i = 0; i < 4; ++i) {
                        const int col = Epi::PERM ? (128 * b + 32 * wc + 8 * fq + 4 * n + i) : (128 * b + 32 * wc + 16 * n + 4 * fq + i);
                        const u32x4 bv = *(const u32x4*)(cur.B + ((size_t)col * g.ldb + k0) * 2);
#pragma unroll
                        for (int a = 0; a < 2; ++a)
#pragma unroll
                            for (int m = 0; m < 4; ++m) { float s = acc[a][b][m][n][i];
                                s = __builtin_amdgcn_fdot2_f32_bf16(__builtin_bit_cast(bf2, av[a][m].x), __builtin_bit_cast(bf2, bv.x), s, false);
                                s = __builtin_amdgcn_fdot2_f32_bf16(__builtin_bit_cast(bf2, av[a][m].y), __builtin_bit_cast(bf2, bv.y), s, false);
                                s = __builtin_amdgcn_fdot2_f32_bf16(__builtin_bit_cast(bf2, av[a][m].z), __builtin_bit_cast(bf2, bv.z), s, false);
                                s = __builtin_amdgcn_fdot2_f32_bf16(__builtin_bit_cast(bf2, av[a][m].w), __builtin_bit_cast(bf2, bv.w), s, false);
                                acc[a][b][m][n][i] = s; }
                    }
        }
        E(acc, cur, wr, wc, fr, fq);
    }
}
}
#define GAS __attribute__((address_space(1)))
#define LAS __attribute__((address_space(3)))
typedef unsigned short bf16;
typedef unsigned v4u __attribute__((ext_vector_type(4)));
typedef unsigned v2u __attribute__((ext_vector_type(2)));
typedef float f32x4 __attribute__((ext_vector_type(4)));
typedef float f32x2 __attribute__((ext_vector_type(2)));
typedef short bf16x8 __attribute__((ext_vector_type(8)));
typedef __bf16 bf16x2_t __attribute__((ext_vector_type(2)));
typedef GAS unsigned gu32;
#define RLX_AGENT __ATOMIC_RELAXED, __HIP_MEMORY_SCOPE_AGENT
#define LDS_WAIT() asm volatile("s_waitcnt lgkmcnt(0)" ::: "memory")
#define VM_WAIT() asm volatile("s_waitcnt vmcnt(0)" ::: "memory")
using pg8::cvt_pk_bf16; using pg8::pack8; using pg8::unpack8; using pg8::bf_lo; using pg8::bf_hi; using pg8::sigm; using pg8::sigm4;

__device__ __forceinline__ float wave_sum(float v) {
#pragma unroll
    for (int o = 1; o < 64; o <<= 1) v += __shfl_xor(v, o);
    return v;
}
__device__ __forceinline__ float dot2bf(unsigned a, unsigned b, float acc) { return __builtin_amdgcn_fdot2_f32_bf16(__builtin_bit_cast(bf16x2_t, a), __builtin_bit_cast(bf16x2_t, b), acc, false); }

#define XB_TMO      128
#define XB_XCNT(j)  (256  + 64 * (j))
#define XB_XSUB(j)  (1280 + 64 * (j))
#define XB_XGEN(j)  (2304 + 64 * (j))
#define XB_TOP      3328
#define XB_TOPGEN   3392
#define XCD_BAR_WORDS 3456
#define XB_SPIN_CAP (1u << 18)

__device__ __forceinline__ unsigned xb_ld(unsigned* p)              { return __hip_atomic_load(p, __ATOMIC_RELAXED, __HIP_MEMORY_SCOPE_AGENT); }
__device__ __forceinline__ unsigned xb_add(unsigned* p, unsigned v) { return __hip_atomic_fetch_add(p, v, __ATOMIC_RELAXED, __HIP_MEMORY_SCOPE_AGENT); }
__device__ __forceinline__ unsigned xb_xcc_id() { return (unsigned)__builtin_amdgcn_s_getreg((3 << 11) | 20) & 0xFu; }
#define XB_SPIN(cond, bar) do { unsigned _sp = 0; while (cond) { __builtin_amdgcn_s_sleep(1); \
    if ((++_sp & 255u) == 0u) { if (xb_ld(&(bar)[XB_TMO])) break; if (_sp > XB_SPIN_CAP) { atomicAdd(&(bar)[XB_TMO], 1u); break; } } } } while (0)

struct XcdBarrier {
    unsigned* bar; unsigned x;
    volatile LAS unsigned* st;
};
__device__ __forceinline__ XcdBarrier xcd_barrier_post(unsigned* bar, volatile LAS unsigned* st) {
    XcdBarrier b; b.bar = bar; b.x = xb_xcc_id(); b.st = st;
    if (threadIdx.x == 0) (void)xb_add(&bar[XB_XCNT(b.x)], 1u);
    return b;
}
__device__ __forceinline__ void xcd_barrier_complete(unsigned* bar, unsigned x, unsigned& nloc, unsigned& nx) {
    const unsigned G = gridDim.x * gridDim.y * gridDim.z;
    unsigned sum, cnt, mine, sp = 0u;
    for (;;) {
        sum = 0u; cnt = 0u; mine = 0u;
#pragma unroll
        for (unsigned j = 0; j < 16; ++j) { const unsigned c = xb_ld(&bar[XB_XCNT(j)]); sum += c; cnt += (c > 0u) ? 1u : 0u; mine = (j == x) ? c : mine; }
        if (sum == G) break;
        __builtin_amdgcn_s_sleep(1);
        if ((++sp & 255u) == 0u) { if (xb_ld(&bar[XB_TMO])) break; if (sp > XB_SPIN_CAP) { atomicAdd(&bar[XB_TMO], 1u); break; } }
    }
    nloc = mine > 0u ? mine : 1u; nx = cnt > 0u ? cnt : 1u;
}
__device__ __forceinline__ void xcd_barrier(const XcdBarrier& b) {
    asm volatile("s_waitcnt vmcnt(0)" ::: "memory");
    __syncthreads();
    if (threadIdx.x == 0) {
        unsigned* bar = b.bar;
        __builtin_amdgcn_s_waitcnt(0);
        unsigned nloc = b.st[0], nx = b.st[1];
        if (nloc == 0u) { xcd_barrier_complete(bar, b.x, nloc, nx); b.st[0] = nloc; b.st[1] = nx; }
        const unsigned old = xb_add(&bar[XB_XSUB(b.x)], 1u);
        const unsigned gen = old / nloc;
        if (old + 1u == (gen + 1u) * nloc) {
            __builtin_amdgcn_fence(__ATOMIC_RELEASE, "agent");
            asm volatile("s_waitcnt vmcnt(0)" ::: "memory");
            const unsigned og = xb_add(&bar[XB_TOP], 1u);
            const unsigned tg = og / nx;
            if (og + 1u == (tg + 1u) * nx) xb_add(&bar[XB_TOPGEN], 1u);
            else XB_SPIN(xb_ld(&bar[XB_TOPGEN]) == tg, bar);
            __builtin_amdgcn_fence(__ATOMIC_ACQUIRE, "agent");
            xb_add(&bar[XB_XGEN(b.x)], 1u);
            asm volatile("s_waitcnt vmcnt(0)" ::: "memory");
        } else {
            XB_SPIN(xb_ld(&bar[XB_XGEN(b.x)]) == gen, bar);
            __builtin_amdgcn_fence(__ATOMIC_ACQUIRE, "agent");
            asm volatile("s_waitcnt vmcnt(0)" ::: "memory");
        }
    }
    __syncthreads();
}
constexpr int NWAVES = 8;
constexpr int BATCH = 8, SEQ = 2048, DM = 1024, M = BATCH * SEQ, DEPTH = 2, NH = 8, HD = 64, AW = 512, CW = 512, CK = 31;
constexpr int NGRP = 4, EPG = 8, NEXP = 32, FF = 512, PLE = 256, WIN = 4608;
constexpr float EPS = 1e-6f;
constexpr float QSCALE = 0.125f * 1.4426950408889634f;
constexpr int MAXROWS = 2 * M + NEXP * 256;
constexpr size_t MiB = 1u << 20;
constexpr size_t WS_CTL = 0, CTL_ZERO_BYTES = 2 * MiB;
constexpr size_t WS_COS = 2 * MiB, WS_SIN = 2 * MiB + 256 * 1024;
constexpr size_t WS_SSQ = 3 * MiB;
constexpr size_t WS_ROUTE = 10 * MiB, WS_POS = 10 * MiB + 512 * 1024, WS_RSC = 11 * MiB, WS_ROWG = 11 * MiB + 256 * 1024;
constexpr size_t WS_WR = 12 * MiB;
constexpr size_t WS_RB = 13 * MiB;
constexpr size_t WS_LG = 352 * MiB;
constexpr size_t WS_W = 16 * MiB, W_LAYER = 112 * MiB;
constexpr size_t WO_WIN = 0, WO_WAO = 9 * MiB, WO_WCO = 10 * MiB, WO_WOUT = 11 * MiB, WO_WPG = 13 * MiB, WO_WPP = 15 * MiB, WO_WGU = 16 * MiB, WO_WD = 80 * MiB;
constexpr size_t WS_XB = 240 * MiB, WS_PB = 272 * MiB, WS_PE = 288 * MiB, WS_MG = 320 * MiB;
constexpr size_t WS_Q = 352 * MiB, WS_K = 368 * MiB, WS_V = 384 * MiB, WS_U = 400 * MiB, WS_SGA = 416 * MiB, WS_SGB = 448 * MiB, WS_OC = 480 * MiB;
constexpr size_t WS_XG = 352 * MiB, WS_H = 432 * MiB, WS_Y = 352 * MiB, WS_END = 512 * MiB;
constexpr int CW_TMO = 0, CW_CODE = 1, CW_BAR = 4096, CW_CNT = 16384;
constexpr int RING_OFF = 0, RING_BYTES = 131072;
constexpr int LDSCTL_OFF = RING_BYTES, MISC_OFF = LDSCTL_OFF + 320, OFFS_OFF = LDSCTL_OFF + 1024;
constexpr int LDS_BYTES = 147456;
constexpr int PH_PER_LAYER = 10, PH_FINAL = 1 + DEPTH * PH_PER_LAYER, N_PHASES = PH_FINAL + 1;

struct Frame {
    LAS unsigned char* lds;
    volatile LAS unsigned* MISC;
    gu32* ctl;
    int tid, lane, wave, vcu, G;
    float* out; unsigned char* ws;
};
#define XCUR(L) ((L) == 0 ? WSP(bf16, WS_XB) : (bf16*)F.out)
#define XNXT(L) ((L) == 0 ? (bf16*)F.out : WSP(bf16, WS_XB))
struct Args { const float* in[24]; float* out; unsigned char* ws; int ph_lo, ph_hi, use_bar, pad; };
#define WSP(T, off) ((T*)(F.ws + (off)))

__device__ __forceinline__ void transpose_item(const float* W, int ld, int colA, int colB, const float* gain, int k0, bf16* WT, int K, int row0, LAS float* scr, int lane) {
    const int kl = lane >> 4, n4 = lane & 15;
    const float* src = W + (size_t)(k0 + kl) * ld + (n4 < 8 ? colA + 4 * n4 : colB + 4 * (n4 - 8));
    f32x4 v[16];
#pragma unroll
    for (int q = 0; q < 16; ++q) v[q] = *(const GAS f32x4*)(src + (size_t)(4 * q) * ld);
#pragma unroll
    for (int q = 0; q < 16; ++q) { const int k = 4 * q + kl; if (gain) v[q] = v[q] * gain[k0 + k]; *(LAS f32x4*)(scr + k * 64 + ((4 * n4) ^ (((k >> 3) & 7) << 3))) = v[q]; }
    LDS_WAIT(); asm volatile("" ::: "memory");
    const int c = lane & 7;
#pragma unroll
    for (int j = 0; j < 8; ++j) { const int n = (lane >> 3) + 8 * j; const LAS float* s = scr + (8 * c) * 64 + (n ^ (c << 3));
        v4u o; o.x = cvt_pk_bf16(s[0 * 64], s[1 * 64]); o.y = cvt_pk_bf16(s[2 * 64], s[3 * 64]); o.z = cvt_pk_bf16(s[4 * 64], s[5 * 64]); o.w = cvt_pk_bf16(s[6 * 64], s[7 * 64]);
        *(GAS v4u*)(WT + (size_t)(row0 + n) * K + k0 + 8 * c) = o; }
    LDS_WAIT(); asm volatile("" ::: "memory");
}
__device__ __forceinline__ int win_src_col(int g) {
    const int pn = g >> 3, sub = g & 7;
    if (pn < 2) return 64 * (4 * pn + (sub & 3)) + 32 * (sub >> 2);
    if (pn < 4) return 512 + 64 * (4 * (pn - 2) + (sub & 3)) + 32 * (sub >> 2);
    if (pn < 6) return 1024 + 256 * (pn - 4) + 32 * sub;
    if (pn < 10) return (sub < 4 ? 1536 : 2048) + 128 * (pn - 6) + 32 * (sub & 3);
    return 2560 + 256 * (pn - 10) + 32 * sub;
}
constexpr int IT_WIN = 72 * 16, IT_WAO = 16 * 8, IT_WCO = 16 * 8, IT_WOUT = 16 * 16, IT_WPG = 16 * 16, IT_WPP = 16 * 4, IT_WGU = 512 * 16, IT_WD = 512 * 8;
constexpr int IT_LAYER = IT_WIN + IT_WAO + IT_WCO + IT_WOUT + IT_WPG + IT_WPP + IT_WGU + IT_WD;
__device__ __forceinline__ void conv_item(Frame& F, const Args& args, int L, int it, LAS float* scr) {
    unsigned char* wl = F.ws + WS_W + (size_t)L * W_LAYER; const int lane = F.lane;
    int r = it;
    if (r < IT_WIN) { const int gp = r >> 4, kb = r & 15; transpose_item(args.in[3] + (size_t)L * DM * WIN, WIN, win_src_col(2 * gp), win_src_col(2 * gp + 1), args.in[2] + L * DM, 64 * kb, (bf16*)(wl + WO_WIN), 1024, 64 * gp, scr, lane); return; } r -= IT_WIN;
    if (r < IT_WAO) { const int gp = r >> 3, kb = r & 7; transpose_item(args.in[8] + (size_t)L * 512 * DM, DM, 64 * gp, 64 * gp + 32, nullptr, 64 * kb, (bf16*)(wl + WO_WAO), 512, 64 * gp, scr, lane); return; } r -= IT_WAO;
    if (r < IT_WCO) { const int gp = r >> 3, kb = r & 7; transpose_item(args.in[9] + (size_t)L * 512 * DM, DM, 64 * gp, 64 * gp + 32, nullptr, 64 * kb, (bf16*)(wl + WO_WCO), 512, 64 * gp, scr, lane); return; } r -= IT_WCO;
    if (r < IT_WOUT) { const int gp = r >> 4, kb = r & 15; transpose_item(args.in[11] + (size_t)L * DM * DM, DM, 64 * gp, 64 * gp + 32, nullptr, 64 * kb, (bf16*)(wl + WO_WOUT), 1024, 64 * gp, scr, lane); return; } r -= IT_WOUT;
    if (r < IT_WPG) { const int gp = r >> 4, kb = r & 15; transpose_item(args.in[22] + (size_t)L * DM * DM, DM, 64 * gp, 64 * gp + 32, args.in[20] + L * DM, 64 * kb, (bf16*)(wl + WO_WPG), 1024, 64 * gp, scr, lane); return; } r -= IT_WPG;
    if (r < IT_WPP) { const int gp = r >> 2, kb = r & 3; transpose_item(args.in[21] + (size_t)L * PLE * DM, DM, 64 * gp, 64 * gp + 32, nullptr, 64 * kb, (bf16*)(wl + WO_WPP), 256, 64 * gp, scr, lane); return; } r -= IT_WPP;
    if (r < IT_WGU) { const int gp = r >> 4, kb = r & 15, e = gp >> 4, gl = gp & 15, tile = gl >> 2, sub = gl & 3;
        const float* src = (sub < 2 ? args.in[17] : args.in[18]) + ((size_t)L * NEXP + e) * DM * FF; const int col = 128 * tile + 64 * (sub & 1);
        transpose_item(src, FF, col, col + 32, args.in[12] + L * DM, 64 * kb, (bf16*)(wl + WO_WGU), 1024, 64 * gp, scr, lane); return; } r -= IT_WGU;
    { const int gp = r >> 3, kb = r & 7, e = gp >> 4, gl = gp & 15;
        transpose_item(args.in[19] + ((size_t)L * NEXP + e) * FF * DM, DM, 64 * gl, 64 * gl + 32, nullptr, 64 * kb, (bf16*)(wl + WO_WD), 512, 64 * gp, scr, lane); }
}
__device__ __forceinline__ void p0_prologue(Frame& F, const Args& args) {
    LAS float* scr = (LAS float*)(F.lds + RING_OFF + F.wave * 16384);
    const int gw = F.vcu * NWAVES + F.wave, NGW = F.G * NWAVES, lane = F.lane;
    const int gt = (F.vcu * NWAVES + F.wave) * 64 + lane, NGT = NGW * 64;
    { bf16* XB = WSP(bf16, WS_XB); float* SSQ = WSP(float, WS_SSQ);
      for (int m = gw; m < M; m += NGW) {
          const GAS f32x4* xr = (const GAS f32x4*)(args.in[0] + (size_t)m * DM) + lane; float s = 0.f; GAS v2u* o8 = (GAS v2u*)(XB + (size_t)m * DM) + lane;
#pragma unroll
          for (int j = 0; j < 4; ++j) { const f32x4 v = xr[64 * j]; s += (v[0] * v[0] + v[1] * v[1]) + (v[2] * v[2] + v[3] * v[3]); v2u w; w.x = cvt_pk_bf16(v[0], v[1]); w.y = cvt_pk_bf16(v[2], v[3]); o8[64 * j] = w; }
          const float tot = wave_sum(s);
          if (lane < 16) SSQ[(size_t)m * 16 + lane] = lane == 0 ? tot : 0.f;
      } }
    { const GAS f32x4* ps = (const GAS f32x4*)args.in[1]; GAS v4u* pb = (GAS v4u*)WSP(bf16, WS_PB);
      for (int i = gt; i < DEPTH * M * PLE / 8; i += NGT) { const f32x4 a = ps[2 * i], b = ps[2 * i + 1]; pb[i] = pack8(a, b); } }
    { float* ct = WSP(float, WS_COS); float* st = WSP(float, WS_SIN);
      for (int i = gt; i < SEQ * 32; i += NGT) { const int pos = i >> 5, k = i & 31; const float inv = powf(10000.0f, -(float)(2 * k) / 64.0f); const float ang = (float)pos * inv; ct[i] = cosf(ang); st[i] = sinf(ang); } }
    { bf16* wr = WSP(bf16, WS_WR);
      for (int i = gt; i < DEPTH * 256 * DM; i += NGT) { const int L = i >> 18, j = (i >> 10) & 255, k = i & 1023; float v = 0.f;
          if (j < 4) v = args.in[13][((size_t)L * DM + k) * NGRP + j]; else if (j < 36) v = args.in[15][((size_t)L * DM + k) * NEXP + (j - 4)];
          if (j < 36) v *= args.in[12][L * DM + k];
          wr[i] = (bf16)(cvt_pk_bf16(v, 0.f) & 0xffffu); }
      float* rb = WSP(float, WS_RB);
      for (int i = gt; i < DEPTH * 64; i += NGT) { const int L = i >> 6, j = i & 63; rb[i] = j < 4 ? args.in[14][L * NGRP + j] : (j < 36 ? args.in[16][L * NEXP + j - 4] : 0.f); } }
    for (int it = gw; it < DEPTH * IT_LAYER; it += NGW) { const int L = it >= IT_LAYER ? 1 : 0; conv_item(F, args, L, it - L * IT_LAYER, scr); }
}

struct SchedGrid {
    int nM, nN, G, c; const char* Ab; const char* Bb; size_t astep, bstep;
    __device__ __forceinline__ bool next(int i, pg8::Unit& u) const {
        const int L = i * G + c; if (L >= nM * nN) return false;
        pg8::tile_of(L, nM, nN, u.pm, u.pn); u.aux = 0; u.A = Ab + (size_t)u.pm * astep; u.B = Bb + (size_t)u.pn * bstep; return true; }
};
struct SchedP3 {
    int G, c; const char* OC; const char* Wa; const char* Wc;
    __device__ __forceinline__ bool next(int i, pg8::Unit& u) const {
        const int T = (i >> 1) * G + c; if (T >= 256) return false;
        pg8::tile_of(T, 64, 4, u.pm, u.pn); u.aux = i & 1;
        u.A = OC + (size_t)u.pm * (256 * 1024 * 2) + (u.aux ? 512 * 2 : 0); u.B = (u.aux ? Wc : Wa) + (size_t)u.pn * (256 * 512 * 2); return true; }
};
struct SchedMoe {
    const volatile LAS int* offs; int G, c, up; const char* Ab; const char* Bb;
    __device__ __forceinline__ bool next(int i, pg8::Unit& u) const {
        const int NB = offs[32] >> 8, L = i * G + c; if (L >= NB * 4) return false;
        const int mb = L >> 2, pn = L & 3; int e = 0;
        while (e < 31 && offs[e + 1] <= mb * 256) ++e;
        u.pm = mb; u.pn = pn; u.aux = e;
        if (up) { u.A = Ab + (size_t)mb * (256 * 1024 * 2); u.B = Bb + ((size_t)e * 1024 + pn * 256) * (1024 * 2); }
        else    { u.A = Ab + (size_t)mb * (256 * 512 * 2);  u.B = Bb + ((size_t)e * 1024 + pn * 256) * (512 * 2); }
        return true; }
};

using pg8::f32x4;
#define EPI_FOR_ROWS _Pragma("unroll") for (int ai = 0; ai < 2; ++ai) _Pragma("unroll") for (int m = 0; m < 4; ++m)
#define EPI_ROW (u.pm * 256 + ai * 128 + wr * 64 + m * 16 + fr)
__device__ __forceinline__ float rscale_of(const float* ssq, int row) {
    const f32x4* sp = (const f32x4*)(ssq + (size_t)row * 16); const f32x4 a = sp[0], b = sp[1], c = sp[2], d = sp[3];
    const float s = ((a[0] + a[1]) + (a[2] + a[3])) + ((b[0] + b[1]) + (b[2] + b[3])) + ((c[0] + c[1]) + (c[2] + c[3])) + ((d[0] + d[1]) + (d[2] + d[3]));
    return rsqrtf(s * (1.0f / DM) + EPS);
}
struct EpiP1 {
    static constexpr bool PERM = true;
    const float* ssq; const float* cosT; const float* sinT; bf16 *Q, *K, *V, *U, *SGA, *SGB;
    __device__ __forceinline__ void operator()(const f32x4 (&acc)[2][2][4][2], const pg8::Unit& u, int wr, int wc, int fr, int fq) const {
        const int pn = u.pn;
        EPI_FOR_ROWS { const int row = EPI_ROW;
            const float r = rscale_of(ssq, row); const int b = row >> 11, t = row & 2047;
            if (pn < 4) {
                const int head = 4 * (pn & 1) + wc; const float qs = pn < 2 ? QSCALE : 1.0f;
                const f32x4* cp = (const f32x4*)(cosT + t * 32 + 8 * fq); const f32x4* sp = (const f32x4*)(sinT + t * 32 + 8 * fq);
                f32x4 o1[2], o2[2];
#pragma unroll
                for (int n = 0; n < 2; ++n) { const f32x4 c = cp[n], s = sp[n], t1 = acc[ai][0][m][n] * (r * qs), t2 = acc[ai][1][m][n] * (r * qs); o1[n] = t1 * c - t2 * s; o2[n] = t1 * s + t2 * c; }
                bf16* dst = (pn < 2 ? Q : K) + ((size_t)(b * NH + head) * SEQ + t) * HD + 8 * fq;
                *(v4u*)dst = pack8(o1[0], o1[1]); *(v4u*)(dst + 32) = pack8(o2[0], o2[1]);
            } else if (pn < 6) {
#pragma unroll
                for (int bj = 0; bj < 2; ++bj) { const int head = 4 * (pn - 4) + 2 * bj + (wc >> 1), dim = 32 * (wc & 1) + 8 * fq;
                    *(v4u*)(V + ((size_t)(b * NH + head) * SEQ + t) * HD + dim) = pack8(acc[ai][bj][m][0] * r, acc[ai][bj][m][1] * r); }
            } else if (pn < 10) {
                f32x4 o[2];
#pragma unroll
                for (int n = 0; n < 2; ++n) o[n] = (acc[ai][0][m][n] * r) * sigm4(acc[ai][1][m][n] * r);
                *(v4u*)(U + (size_t)row * CW + 128 * (pn - 6) + 32 * wc + 8 * fq) = pack8(o[0], o[1]);
            } else {
                bf16* base = (pn < 14 ? SGA + 256 * (pn - 10) : SGB + 256 * (pn - 14)) + (size_t)row * DM + 32 * wc + 8 * fq;
#pragma unroll
                for (int bj = 0; bj < 2; ++bj) *(v4u*)(base + 128 * bj) = pack8(sigm4(acc[ai][bj][m][0] * r), sigm4(acc[ai][bj][m][1] * r));
            }
        }
    }
};
struct EpiP3 {
    static constexpr bool PERM = true;
    const bf16* SGA; const bf16* SGB; const float* bco; bf16* MG;
    __device__ __forceinline__ void operator()(const f32x4 (&acc)[2][2][4][2], const pg8::Unit& u, int wr, int wc, int fr, int fq) const {
        const int kind = u.aux;
        EPI_FOR_ROWS { const int row = EPI_ROW;
#pragma unroll
            for (int bj = 0; bj < 2; ++bj) { const int col = u.pn * 256 + 128 * bj + 32 * wc + 8 * fq; const size_t off = (size_t)row * DM + col;
                f32x4 g0, g1; unpack8(*(const v4u*)((kind ? SGB : SGA) + off), g0, g1);
                f32x4 v0 = acc[ai][bj][m][0], v1 = acc[ai][bj][m][1];
                if (kind) { const f32x4 b0 = *(const f32x4*)(bco + col), b1 = *(const f32x4*)(bco + col + 4); f32x4 p0, p1; unpack8(*(const v4u*)(MG + off), p0, p1); v0 = p0 + g0 * (v0 + b0); v1 = p1 + g1 * (v1 + b1); }
                else { v0 = g0 * v0; v1 = g1 * v1; }
                *(v4u*)(MG + off) = pack8(v0, v1); }
        }
    }
};
#define RESID_STORE(DELTA0, DELTA1) { f32x4 x0, x1; unpack8(*(const v4u*)(XI + off), x0, x1); const f32x4 v0 = x0 + (DELTA0), v1 = x1 + (DELTA1); \
        *(v4u*)(XO + off) = pack8(v0, v1); \
        ss += ((v0[0] * v0[0] + v0[1] * v0[1]) + (v0[2] * v0[2] + v0[3] * v0[3])) + ((v1[0] * v1[0] + v1[1] * v1[1]) + (v1[2] * v1[2] + v1[3] * v1[3])); }
#define SSQ_STORE() { ss += __shfl_xor(ss, 16); ss += __shfl_xor(ss, 32); if (fq == 0) ssq_out[(size_t)row * 16 + u.pn * 4 + wc] = ss; }
struct EpiP4 {
    static constexpr bool PERM = true;
    const bf16* XI; bf16* XO; float* ssq_out;
    __device__ __forceinline__ void operator()(const f32x4 (&acc)[2][2][4][2], const pg8::Unit& u, int wr, int wc, int fr, int fq) const {
        EPI_FOR_ROWS { const int row = EPI_ROW;
            float ss = 0.f;
#pragma unroll
            for (int bj = 0; bj < 2; ++bj) { const size_t off = (size_t)row * DM + u.pn * 256 + 128 * bj + 32 * wc + 8 * fq; RESID_STORE(acc[ai][bj][m][0], acc[ai][bj][m][1]) }
            SSQ_STORE()
        }
    }
};
struct EpiP8 {
    static constexpr bool PERM = true;
    const float* ssq_in; const bf16* PE; const bf16* XI; bf16* XO; float* ssq_out;
    __device__ __forceinline__ void operator()(const f32x4 (&acc)[2][2][4][2], const pg8::Unit& u, int wr, int wc, int fr, int fq) const {
        EPI_FOR_ROWS { const int row = EPI_ROW;
            const float r = rscale_of(ssq_in, row); float ss = 0.f;
#pragma unroll
            for (int bj = 0; bj < 2; ++bj) { const size_t off = (size_t)row * DM + u.pn * 256 + 128 * bj + 32 * wc + 8 * fq;
                f32x4 p0, p1; unpack8(*(const v4u*)(PE + off), p0, p1);
                RESID_STORE(sigm4(acc[ai][bj][m][0] * r) * p0, sigm4(acc[ai][bj][m][1] * r) * p1) }
            SSQ_STORE()
        }
    }
};
struct EpiBf16 {
    static constexpr bool PERM = true;
    bf16* O; int ldc;
    __device__ __forceinline__ void operator()(const f32x4 (&acc)[2][2][4][2], const pg8::Unit& u, int wr, int wc, int fr, int fq) const {
        EPI_FOR_ROWS { const int row = EPI_ROW;
#pragma unroll
            for (int bj = 0; bj < 2; ++bj) *(v4u*)(O + (size_t)row * ldc + u.pn * 256 + 128 * bj + 32 * wc + 8 * fq) = pack8(acc[ai][bj][m][0], acc[ai][bj][m][1]);
        }
    }
};
struct EpiUp {
    static constexpr bool PERM = true;
    const float* RSC; bf16* H;
    __device__ __forceinline__ void operator()(const f32x4 (&acc)[2][2][4][2], const pg8::Unit& u, int wr, int wc, int fr, int fq) const {
        EPI_FOR_ROWS { const int row = EPI_ROW;
            const float r = RSC[row]; f32x4 o[2];
#pragma unroll
            for (int n = 0; n < 2; ++n) { const f32x4 g = acc[ai][0][m][n] * r; o[n] = g * sigm4(g) * (acc[ai][1][m][n] * r); }
            *(v4u*)(H + (size_t)row * FF + 128 * u.pn + 32 * wc + 8 * fq) = pack8(o[0], o[1]);
        }
    }
};
struct EpiDown {
    static constexpr bool PERM = true;
    const float* ROWG; bf16* Y;
    __device__ __forceinline__ void operator()(const f32x4 (&acc)[2][2][4][2], const pg8::Unit& u, int wr, int wc, int fr, int fq) const {
        EPI_FOR_ROWS { const int row = EPI_ROW;
            const float gt = ROWG[row];
#pragma unroll
            for (int bj = 0; bj < 2; ++bj) *(v4u*)(Y + (size_t)row * DM + u.pn * 256 + 128 * bj + 32 * wc + 8 * fq) = pack8(acc[ai][bj][m][0] * gt, acc[ai][bj][m][1] * gt);
        }
    }
};


struct EpiRoute {
    static constexpr bool PERM = true;
    const float* ssq; const float* bias; float* LG;
    __device__ __forceinline__ void operator()(const f32x4 (&acc)[2][2][4][2], const pg8::Unit& u, int wr, int wc, int fr, int fq) const {
        if (wc < 2) {
            const f32x4 b0 = *(const f32x4*)(bias + 32 * wc + 8 * fq), b1 = *(const f32x4*)(bias + 32 * wc + 8 * fq + 4);
            EPI_FOR_ROWS { const int row = EPI_ROW; const float r = rscale_of(ssq, row);
                float* dst = LG + (size_t)row * 64 + 32 * wc + 8 * fq;
                *(f32x4*)dst = acc[ai][0][m][0] * r + b0; *(f32x4*)(dst + 4) = acc[ai][0][m][1] * r + b1; }
        }
    }
};
__device__ __forceinline__ void route_decide(Frame& F, int L, int pm) {
    if (F.tid < 256) {
        const int t = pm * 256 + F.tid;
        const float* lp = WSP(float, WS_LG) + (size_t)t * 64; const float* SSQ = WSP(float, WS_SSQ + (size_t)(3 * L + 1) * MiB);
        int* ROUTE = WSP(int, WS_ROUTE); unsigned* cnt = (unsigned*)(F.ctl + CW_CNT + 64 * L);
        const f32x4 g4 = *(const f32x4*)lp;
        float mxv = g4[0]; int gs = 0;
#pragma unroll
        for (int i = 1; i < 4; ++i) if (g4[i] > mxv) { mxv = g4[i]; gs = i; }
        float se = 0.f;
#pragma unroll
        for (int i = 0; i < 4; ++i) se += __expf(g4[i] - mxv);
        const float pg = 1.0f / se;
        const f32x4 e0 = *(const f32x4*)(lp + 4 + gs * 8), e1 = *(const f32x4*)(lp + 8 + gs * 8);
        float v1 = -1e30f, v2 = -1e30f; int i1 = 0, i2 = 0;
#pragma unroll
        for (int i = 0; i < 8; ++i) { const float v = i < 4 ? e0[i] : e1[i - 4]; if (v > v1) { v2 = v1; i2 = i1; v1 = v; i1 = i; } else if (v > v2) { v2 = v; i2 = i; } }
        const float e2 = __expf(v2 - v1), s1 = 1.0f / (1.0f + e2);
        const int ea = gs * 8 + i1, eb = gs * 8 + i2;
        const unsigned ia = atomicAdd(cnt + ea, 1u), ib = atomicAdd(cnt + eb, 1u);
        v4u r0, r1; r0.x = (unsigned)ea; r0.y = (unsigned)eb; r0.z = ia; r0.w = ib; r1.x = __float_as_uint(pg * s1); r1.y = __float_as_uint(pg * e2 * s1); r1.z = __float_as_uint(rscale_of(SSQ, t)); r1.w = 0u;
        *(GAS v4u*)(ROUTE + (size_t)t * 8) = r0; *(GAS v4u*)(ROUTE + (size_t)t * 8 + 4) = r1;
    }
}

__device__ __forceinline__ void attn_simple(Frame& F) {
    const bf16* Q = WSP(bf16, WS_Q); const bf16* Kb = WSP(bf16, WS_K); const bf16* Vb = WSP(bf16, WS_V); bf16* OC = WSP(bf16, WS_OC);
    const int lane = F.lane;
    for (int unit = F.vcu * NWAVES + F.wave; unit < BATCH * NH * (SEQ / 64); unit += F.G * NWAVES) {
        const int bh = unit >> 5, t = ((unit & 31) << 6) + lane;
        unsigned qw[32];
        { const GAS v4u* qp = (const GAS v4u*)(Q + ((size_t)bh * SEQ + t) * HD);
#pragma unroll
          for (int i = 0; i < 8; ++i) { const v4u w = qp[i]; qw[4 * i] = w.x; qw[4 * i + 1] = w.y; qw[4 * i + 2] = w.z; qw[4 * i + 3] = w.w; } }
        float o[64];
#pragma unroll
        for (int i = 0; i < 64; ++i) o[i] = 0.f;
        float mx = -1e30f, l = 0.f;
        for (int g = 0; g < 3; ++g) {
            const int d = g == 0 ? 1 : (g == 1 ? 4 : 16);
            for (int j0 = 0; j0 <= 128; j0 += 4) {
                if (!__any(t - j0 * d >= 0)) break;
                float s[4]; int pc[4];
#pragma unroll
                for (int c = 0; c < 4; ++c) { const int j = j0 + c, pos = t - j * d; const bool valid = pos >= 0 && j <= 128; pc[c] = valid ? pos : t;
                    const GAS v4u* kp = (const GAS v4u*)(Kb + ((size_t)bh * SEQ + pc[c]) * HD); float a = 0.f;
#pragma unroll
                    for (int i = 0; i < 8; ++i) { const v4u w = kp[i]; a = dot2bf(qw[4 * i], w.x, a); a = dot2bf(qw[4 * i + 1], w.y, a); a = dot2bf(qw[4 * i + 2], w.z, a); a = dot2bf(qw[4 * i + 3], w.w, a); }
                    s[c] = valid ? a : -1e30f; }
                const float mc = fmaxf(fmaxf(s[0], s[1]), fmaxf(s[2], s[3])), mn = fmaxf(mx, mc), sc = __builtin_amdgcn_exp2f(mx - mn);
                l *= sc;
#pragma unroll
                for (int i = 0; i < 64; ++i) o[i] *= sc;
                mx = mn;
#pragma unroll
                for (int c = 0; c < 4; ++c) { const float p = __builtin_amdgcn_exp2f(s[c] - mn); l += p;
                    const GAS v4u* vp = (const GAS v4u*)(Vb + ((size_t)bh * SEQ + pc[c]) * HD);
#pragma unroll
                    for (int i = 0; i < 8; ++i) { const v4u w = vp[i];
                        o[8 * i + 0] += p * bf_lo(w.x); o[8 * i + 1] += p * bf_hi(w.x); o[8 * i + 2] += p * bf_lo(w.y); o[8 * i + 3] += p * bf_hi(w.y);
                        o[8 * i + 4] += p * bf_lo(w.z); o[8 * i + 5] += p * bf_hi(w.z); o[8 * i + 6] += p * bf_lo(w.w); o[8 * i + 7] += p * bf_hi(w.w); } }
            }
        }
        const float inv = 1.0f / l; const int b = bh >> 3, h = bh & 7;
        GAS v4u* op = (GAS v4u*)(OC + ((size_t)(b * SEQ + t)) * DM + h * HD);
#pragma unroll
        for (int i = 0; i < 8; ++i) { v4u w; w.x = cvt_pk_bf16(o[8 * i] * inv, o[8 * i + 1] * inv); w.y = cvt_pk_bf16(o[8 * i + 2] * inv, o[8 * i + 3] * inv); w.z = cvt_pk_bf16(o[8 * i + 4] * inv, o[8 * i + 5] * inv); w.w = cvt_pk_bf16(o[8 * i + 6] * inv, o[8 * i + 7] * inv); op[i] = w; }
    }
}

typedef float f32x16 __attribute__((ext_vector_type(16)));
typedef short v4i16_t __attribute__((ext_vector_type(4)));
struct AttnStep { int p0, st, mode, T; };
__device__ __forceinline__ void attn_desc(int idx, int qb, int c, int i, int hi, int n1, int n0, int nb2, AttnStep& d) {
    if (idx < n1) { const int kb = qb - idx; d.p0 = 128 * kb + c; d.st = 4; d.mode = (idx == 0) ? 2 : ((idx == 4) ? 1 : 0); d.T = i - 4 * hi; }
    else if (idx < n1 + n0) { const int kb = (qb ? 0 : 4) + (idx - n1); d.st = 1;
        if (kb < 4) { d.p0 = 128 * (qb - 1) + 32 * kb; d.mode = 1; d.T = 4 * i + c - 32 * kb - 4 * hi; }
        else { d.p0 = 128 * qb + 32 * (kb - 4); d.mode = 2; d.T = 4 * i + c - 32 * (kb - 4) - 4 * hi; } }
    else { const int e = idx - n1 - n0, a = e / nb2, kb = e - a * nb2; d.p0 = 512 * kb + 4 * a + c; d.st = 16; d.mode = 2; d.T = ((i & 3) == a) ? (8 * qb + (i >> 2) - 32 * kb - 4 * hi) : -100; }
}
__device__ __forceinline__ void attn_dma(LAS unsigned char* slot, const bf16* Kh, const bf16* Vh, int p0, int st, int lane) {
    const int rl = lane >> 3, pos = lane & 7;
#pragma unroll
    for (int pc = 0; pc < 4; ++pc) {
        const int row = 8 * pc + rl; const size_t rowoff = (size_t)(p0 + st * row) * HD;
        const int chk = pos ^ ((row >> 1) & 7);
        const int chv = (((pos >> 1) ^ (((row >> 1) & 1) << 1)) << 1) | (pos & 1);
        __builtin_amdgcn_global_load_lds((const unsigned*)(Kh + rowoff + chk * 8), (LAS unsigned*)(slot + pc * 1024), 16, 0, 0);
        __builtin_amdgcn_global_load_lds((const unsigned*)(Vh + rowoff + chv * 8), (LAS unsigned*)(slot + 4096 + pc * 1024), 16, 0, 0);
    }
}
__device__ __forceinline__ void attn_mfma(Frame& F) {
    const bf16* Q = WSP(bf16, WS_Q); const bf16* Kb = WSP(bf16, WS_K); const bf16* Vb = WSP(bf16, WS_V); bf16* OC = WSP(bf16, WS_OC);
    const int lane = F.lane, i = lane & 31, hi = lane >> 5;
    LAS unsigned char* ring = F.lds + RING_OFF + F.wave * 16384;
    int koff[4];
#pragma unroll
    for (int s = 0; s < 4; ++s) koff[s] = i * 128 + (((2 * s + hi) ^ ((i >> 1) & 7)) << 4);
    const int g2 = (lane >> 4) & 1, q4 = (lane & 15) >> 2, p4 = lane & 3;
    int voff[2][2];
#pragma unroll
    for (int s = 0; s < 2; ++s)
#pragma unroll
        for (int db = 0; db < 2; ++db) { const int row = 16 * s + 4 * hi + q4; voff[s][db] = 4096 + row * 128 + (((2 * db + g2) ^ (((row >> 1) & 1) << 1)) << 5) + p4 * 8; }
    for (int pass = 0; pass < 2; ++pass) {
        const int gw = F.vcu * NWAVES + F.wave;
        const int T = pass == 0 ? gw : (BATCH * NH * 4 * 16 - 1 - gw);
        if (gw >= BATCH * NH * 4 * 16 / 2) break;
        const int qb = T & 15, c = (T >> 4) & 3, bh = T >> 6;
        const bf16* Kh = Kb + (size_t)bh * SEQ * HD; const bf16* Vh = Vb + (size_t)bh * SEQ * HD;
        const int tq = 128 * qb + 4 * i + c;
        bf16x8 qf[4];
        { const GAS bf16x8* qp = (const GAS bf16x8*)(Q + ((size_t)bh * SEQ + tq) * HD + 8 * hi);
#pragma unroll
          for (int s = 0; s < 4; ++s) qf[s] = qp[2 * s]; }
        const int n1 = (qb < 4 ? qb : 4) + 1, n0 = qb ? 8 : 4, nb2 = (qb >> 2) + 1, nsteps = n1 + n0 + 4 * nb2;
        f32x16 o0, o1;
#pragma unroll
        for (int r = 0; r < 16; ++r) { o0[r] = 0.f; o1[r] = 0.f; }
        float mrun = -1e30f, lrun = 0.f;
        AttnStep cur; attn_desc(0, qb, c, i, hi, n1, n0, nb2, cur);
        attn_dma(ring, Kh, Vh, cur.p0, cur.st, lane);
        for (int idx = 0; idx < nsteps; ++idx) {
            LAS unsigned char* slot = ring + (idx & 1) * 8192;
            AttnStep nxt = cur;
            if (idx + 1 < nsteps) { attn_desc(idx + 1, qb, c, i, hi, n1, n0, nb2, nxt); attn_dma(ring + ((idx + 1) & 1) * 8192, Kh, Vh, nxt.p0, nxt.st, lane); asm volatile("s_waitcnt vmcnt(8)" ::: "memory"); }
            else { asm volatile("s_waitcnt vmcnt(0)" ::: "memory"); }
            f32x16 sacc;
#pragma unroll
            for (int r = 0; r < 16; ++r) sacc[r] = 0.f;
#pragma unroll
            for (int s = 0; s < 4; ++s) { const bf16x8 kf = *(const LAS bf16x8*)(slot + koff[s]); sacc = __builtin_amdgcn_mfma_f32_32x32x16_bf16(kf, qf[s], sacc, 0, 0, 0); }
            if (cur.mode == 1) {
#pragma unroll
                for (int r = 0; r < 16; ++r) sacc[r] = ((r & 3) + 8 * (r >> 2) >= cur.T) ? sacc[r] : -1e30f;
            } else if (cur.mode == 2) {
#pragma unroll
                for (int r = 0; r < 16; ++r) sacc[r] = ((r & 3) + 8 * (r >> 2) <= cur.T) ? sacc[r] : -1e30f;
            }
            float mloc = sacc[0];
#pragma unroll
            for (int r = 1; r < 16; ++r) mloc = fmaxf(mloc, sacc[r]);
            { auto rr = __builtin_amdgcn_permlane32_swap(__float_as_uint(mloc), __float_as_uint(mloc), false, false); mloc = fmaxf(__uint_as_float(rr[0]), __uint_as_float(rr[1])); }
            const float mnew = fmaxf(mrun, mloc), alpha = __builtin_amdgcn_exp2f(mrun - mnew);
            mrun = mnew;
            float psum = 0.f;
#pragma unroll
            for (int r = 0; r < 16; ++r) { sacc[r] = __builtin_amdgcn_exp2f(sacc[r] - mnew); psum += sacc[r]; }
            lrun = lrun * alpha + psum;
#pragma unroll
            for (int r = 0; r < 16; ++r) { o0[r] *= alpha; o1[r] *= alpha; }
            bf16x8 pf[2];
#pragma unroll
            for (int s = 0; s < 2; ++s) { v4u w; w.x = cvt_pk_bf16(sacc[8 * s], sacc[8 * s + 1]); w.y = cvt_pk_bf16(sacc[8 * s + 2], sacc[8 * s + 3]); w.z = cvt_pk_bf16(sacc[8 * s + 4], sacc[8 * s + 5]); w.w = cvt_pk_bf16(sacc[8 * s + 6], sacc[8 * s + 7]); pf[s] = __builtin_bit_cast(bf16x8, w); }
#pragma unroll
            for (int s = 0; s < 2; ++s)
#pragma unroll
                for (int db = 0; db < 2; ++db) {
                    const v4i16_t lo = __builtin_amdgcn_ds_read_tr16_b64_v4i16((LAS v4i16_t*)(slot + voff[s][db]));
                    const v4i16_t hh = __builtin_amdgcn_ds_read_tr16_b64_v4i16((LAS v4i16_t*)(slot + voff[s][db] + 8 * 128));
                    const bf16x8 vf = (bf16x8){lo[0], lo[1], lo[2], lo[3], hh[0], hh[1], hh[2], hh[3]};
                    if (db == 0) o0 = __builtin_amdgcn_mfma_f32_32x32x16_bf16(vf, pf[s], o0, 0, 0, 0); else o1 = __builtin_amdgcn_mfma_f32_32x32x16_bf16(vf, pf[s], o1, 0, 0, 0);
                }
            cur = nxt;
        }
        { auto rr = __builtin_amdgcn_permlane32_swap(__float_as_uint(lrun), __float_as_uint(lrun), false, false); lrun = __uint_as_float(rr[0]) + __uint_as_float(rr[1]); }
        const float inv = 1.0f / lrun; const int b = bh >> 3, h = bh & 7;
        bf16* op = OC + ((size_t)(b * SEQ + tq)) * DM + h * HD + 4 * hi;
#pragma unroll
        for (int g = 0; g < 4; ++g) {
            v2u w0, w1; w0.x = cvt_pk_bf16(o0[4 * g] * inv, o0[4 * g + 1] * inv); w0.y = cvt_pk_bf16(o0[4 * g + 2] * inv, o0[4 * g + 3] * inv);
            w1.x = cvt_pk_bf16(o1[4 * g] * inv, o1[4 * g + 1] * inv); w1.y = cvt_pk_bf16(o1[4 * g + 2] * inv, o1[4 * g + 3] * inv);
            *(GAS v2u*)(op + 8 * g) = w0; *(GAS v2u*)(op + 32 + 8 * g) = w1; }
    }
    asm volatile("s_waitcnt vmcnt(0)" ::: "memory");
}

__device__ __forceinline__ void conv_simple(Frame& F, const Args& args, int L) {
    LAS float* ybuf = (LAS float*)(F.lds + RING_OFF); LAS float* stats = ybuf + 16 * 512;
    const bf16* U = WSP(bf16, WS_U); bf16* OC = WSP(bf16, WS_OC);
    const int c = F.tid, lane = F.lane;
    float w[CK];
#pragma unroll
    for (int j = 0; j < CK; ++j) w[j] = args.in[4][((size_t)L * CK + j) * CW + c];
    const float bias = args.in[5][L * CW + c], lg = args.in[6][L * CW + c], lb = args.in[7][L * CW + c];
    for (int unit = F.vcu; unit < M / 16; unit += F.G) {
        const int row0 = unit * 16, t0 = row0 & (SEQ - 1);
        float uu[46];
#pragma unroll
        for (int i = 0; i < 46; ++i) { const int tt = t0 - 30 + i; uu[i] = tt >= 0 ? __uint_as_float((unsigned)U[(size_t)(row0 - 30 + i) * CW + c] << 16) : 0.f; }
        float y[16];
#pragma unroll
        for (int tt = 0; tt < 16; ++tt) { float a = bias;
#pragma unroll
            for (int j = 0; j < CK; ++j) a += w[j] * uu[tt + j];
            y[tt] = a; ybuf[tt * 512 + c] = a; }
        __syncthreads();
#pragma unroll
        for (int q = 0; q < 2; ++q) { const int tt = 2 * F.wave + q; float v[8]; float s = 0.f;
#pragma unroll
            for (int i = 0; i < 8; ++i) { v[i] = ybuf[tt * 512 + lane + 64 * i]; s += v[i]; }
            const float mu = wave_sum(s) * (1.0f / 512.0f); float s2 = 0.f;
#pragma unroll
            for (int i = 0; i < 8; ++i) { const float dd = v[i] - mu; s2 += dd * dd; }
            const float var = wave_sum(s2) * (1.0f / 512.0f);
            if (lane == 0) { stats[2 * tt] = mu; stats[2 * tt + 1] = rsqrtf(var + EPS); } }
        __syncthreads();
#pragma unroll
        for (int tt = 0; tt < 16; ++tt) { const float yn = (y[tt] - stats[2 * tt]) * stats[2 * tt + 1] * lg + lb; const float ov = yn * sigm(yn);
            OC[(size_t)(row0 + tt) * DM + 512 + c] = (bf16)(cvt_pk_bf16(ov, 0.f) & 0xffffu); }
        __syncthreads();
    }
}

__device__ __forceinline__ void conv_v2(Frame& F, const Args& args, int L) {
    LAS float* ybuf = (LAS float*)(F.lds + RING_OFF);
    LAS float* stats = (LAS float*)(F.lds + OFFS_OFF + 256);
    const bf16* U = WSP(bf16, WS_U); bf16* OC = WSP(bf16, WS_OC);
    const int cp = F.tid & 255, half = F.tid >> 8, lane = F.lane;
    f32x2 w[CK];
#pragma unroll
    for (int j = 0; j < CK; ++j) w[j] = *(const f32x2*)(args.in[4] + ((size_t)L * CK + j) * CW + 2 * cp);
    const f32x2 bias = *(const f32x2*)(args.in[5] + L * CW + 2 * cp), lg = *(const f32x2*)(args.in[6] + L * CW + 2 * cp), lb = *(const f32x2*)(args.in[7] + L * CW + 2 * cp);
    for (int unit = F.vcu; unit < M / 64; unit += F.G) {
        const int row0 = unit * 64 + half * 32, t0 = row0 & (SEQ - 1);
#pragma unroll 1
        for (int sub = 0; sub < 2; ++sub) {
            float wl[46], wh[46];
#pragma unroll
            for (int i = 0; i < 46; ++i) { const int tt = t0 + 16 * sub - 30 + i; const int ri = row0 + 16 * sub - 30 + i; const int rc = tt >= 0 ? ri : row0;
                unsigned u = *(const GAS unsigned*)(U + (size_t)rc * CW + 2 * cp); u = tt >= 0 ? u : 0u; wl[i] = bf_lo(u); wh[i] = bf_hi(u); }
#pragma unroll
            for (int tt = 0; tt < 16; ++tt) { f32x2 a = bias;
#pragma unroll
                for (int j = 0; j < CK; ++j) { a.x += w[j].x * wl[tt + j]; a.y += w[j].y * wh[tt + j]; }
                *(LAS f32x2*)(ybuf + (half * 32 + 16 * sub + tt) * 512 + 2 * cp) = a; }
        }
        __syncthreads();
#pragma unroll
        for (int q = 0; q < 8; ++q) { const int tk = 8 * F.wave + q; float s = 0.f, s2 = 0.f;
#pragma unroll
            for (int i = 0; i < 2; ++i) { const f32x4 v = *(const LAS f32x4*)(ybuf + tk * 512 + 4 * lane + 256 * i); s += (v[0] + v[1]) + (v[2] + v[3]); s2 += (v[0] * v[0] + v[1] * v[1]) + (v[2] * v[2] + v[3] * v[3]); }
            s = wave_sum(s); s2 = wave_sum(s2);
            const float mu = s * (1.0f / 512.0f), var = fmaxf(s2 * (1.0f / 512.0f) - mu * mu, 0.f);
            if (lane == 0) { stats[2 * tk] = mu; stats[2 * tk + 1] = rsqrtf(var + EPS); } }
        __syncthreads();
#pragma unroll
        for (int tt = 0; tt < 32; ++tt) { const f32x2 st = *(const LAS f32x2*)(stats + 2 * (half * 32 + tt));
            const f32x2 yv = *(const LAS f32x2*)(ybuf + (half * 32 + tt) * 512 + 2 * cp);
            const float y0 = (yv.x - st.x) * st.y * lg.x + lb.x, y1 = (yv.y - st.x) * st.y * lg.y + lb.y;
            *(GAS unsigned*)(OC + (size_t)(row0 + tt) * DM + 512 + 2 * cp) = cvt_pk_bf16(y0 * sigm(y0), y1 * sigm(y1)); }
        __syncthreads();
    }
}

__device__ __forceinline__ void route_phase(Frame& F, const Args& args, int L) {
    LAS float* lgs = (LAS float*)(F.lds + RING_OFF) + F.wave * (8 * 40);
    const bf16* XB = WSP(bf16, WS_XB); const float* SSQ = WSP(float, WS_SSQ + (size_t)(3 * L + 1) * MiB); const bf16* WR = WSP(bf16, WS_WR) + (size_t)L * 64 * DM;
    int* ROUTE = WSP(int, WS_ROUTE); unsigned* cnt = (unsigned*)(F.ctl + CW_CNT + 64 * L);
    const int lane = F.lane, gw = F.vcu * NWAVES + F.wave, NGW = F.G * NWAVES;
    int vz = 0; asm volatile("" : "+v"(vz));
    const float bias = lane < 4 ? args.in[14][L * NGRP + lane] : (lane < 36 ? args.in[16][L * NEXP + lane - 4] : 0.f);
    for (int tb = gw; tb < M / 8; tb += NGW) {
        const int t0 = tb * 8;
        const GAS v4u* wp = (const GAS v4u*)(WR + (size_t)lane * DM);
        float a[8];
#pragma unroll
        for (int tt = 0; tt < 8; ++tt) a[tt] = 0.f;
        for (int kc = 0; kc < 128; ++kc) { const v4u w = wp[kc];
#pragma unroll
            for (int tt = 0; tt < 8; ++tt) { const v4u x = *((const GAS v4u*)(XB + (size_t)(t0 + tt) * DM) + kc + vz);
                a[tt] = dot2bf(w.x, x.x, a[tt]); a[tt] = dot2bf(w.y, x.y, a[tt]); a[tt] = dot2bf(w.z, x.z, a[tt]); a[tt] = dot2bf(w.w, x.w, a[tt]); } }
        float rr = 0.f;
#pragma unroll
        for (int tt = 0; tt < 8; ++tt) { const float r = rscale_of(SSQ + vz, t0 + tt); if (lane == tt) rr = r; if (lane < 36) lgs[tt * 40 + lane] = a[tt] * r + bias; }
        LDS_WAIT(); asm volatile("" ::: "memory");
        if (lane < 8) {
            const int t = t0 + lane; const LAS float* lp = lgs + lane * 40;
            float mxv = -1e30f; int gs = 0; float l4[4];
#pragma unroll
            for (int i = 0; i < 4; ++i) { l4[i] = lp[i]; if (l4[i] > mxv) { mxv = l4[i]; gs = i; } }
            float se = 0.f;
#pragma unroll
            for (int i = 0; i < 4; ++i) se += __expf(l4[i] - mxv);
            const float pg = 1.0f / se;
            float v1 = -1e30f, v2 = -1e30f; int i1 = 0, i2 = 0;
#pragma unroll
            for (int i = 0; i < 8; ++i) { const float v = lp[4 + gs * 8 + i]; if (v > v1) { v2 = v1; i2 = i1; v1 = v; i1 = i; } else if (v > v2) { v2 = v; i2 = i; } }
            const float e2 = __expf(v2 - v1), s1 = 1.0f / (1.0f + e2);
            const int ea = gs * 8 + i1, eb = gs * 8 + i2;
            const unsigned ia = atomicAdd(cnt + ea, 1u), ib = atomicAdd(cnt + eb, 1u);
            v4u r0, r1; r0.x = (unsigned)ea; r0.y = (unsigned)eb; r0.z = ia; r0.w = ib; r1.x = __float_as_uint(pg * s1); r1.y = __float_as_uint(pg * e2 * s1); r1.z = __float_as_uint(rr); r1.w = 0u;
            *(GAS v4u*)(ROUTE + (size_t)t * 8) = r0; *(GAS v4u*)(ROUTE + (size_t)t * 8 + 4) = r1;
        }
        LDS_WAIT(); asm volatile("" ::: "memory");
    }
}
__device__ __forceinline__ void moe_offsets(Frame& F, int L) {
    volatile LAS int* offs = (volatile LAS int*)(F.lds + OFFS_OFF);
    __syncthreads();
    if (F.tid == 0) { int acc = 0;
        for (int e = 0; e < NEXP; ++e) { offs[e] = acc; const unsigned c = __hip_atomic_load(F.ctl + CW_CNT + 64 * L + e, RLX_AGENT); acc += (int)((c + 255u) & ~255u); }
        offs[NEXP] = acc; }
    __syncthreads();
}
__device__ __forceinline__ void dispatch_phase(Frame& F, int L) {
    moe_offsets(F, L);
    const volatile LAS int* offs = (const volatile LAS int*)(F.lds + OFFS_OFF);
    const bf16* XB = XCUR(L); bf16* XG = WSP(bf16, WS_XG); const int* ROUTE = WSP(int, WS_ROUTE); int* POS = WSP(int, WS_POS); float* RSC = WSP(float, WS_RSC); float* ROWG = WSP(float, WS_ROWG);
    const int lane = F.lane, gw = F.vcu * NWAVES + F.wave, NGW = F.G * NWAVES;
    int vz = 0; asm volatile("" : "+v"(vz));
    for (int t = gw; t < M; t += NGW) {
        const v4u r0 = *(const GAS v4u*)(ROUTE + (size_t)t * 8 + vz), r1 = *(const GAS v4u*)(ROUTE + (size_t)t * 8 + 4 + vz);
        const int s0 = offs[r0.x] + (int)r0.z, s1 = offs[r0.y] + (int)r0.w;
        const GAS v4u* src = (const GAS v4u*)(XB + (size_t)t * DM) + lane; const v4u a = src[0], b = src[64];
        GAS v4u* d0 = (GAS v4u*)(XG + (size_t)s0 * DM) + lane; GAS v4u* d1 = (GAS v4u*)(XG + (size_t)s1 * DM) + lane;
        d0[0] = a; d0[64] = b; d1[0] = a; d1[64] = b;
        if (lane == 0) { POS[2 * t] = s0; POS[2 * t + 1] = s1; RSC[s0] = __uint_as_float(r1.z); RSC[s1] = __uint_as_float(r1.z); ROWG[s0] = __uint_as_float(r1.x); ROWG[s1] = __uint_as_float(r1.y); }
    }
}
__device__ __forceinline__ void combine_phase(Frame& F, int L) {
    bf16* XB = XCUR(L); const bf16* Y = WSP(bf16, WS_Y); const int* POS = WSP(int, WS_POS); float* SSQ = WSP(float, WS_SSQ + (size_t)(3 * L + 2) * MiB);
    const int lane = F.lane, gw = F.vcu * NWAVES + F.wave, NGW = F.G * NWAVES;
    int vz = 0; asm volatile("" : "+v"(vz));
    for (int t = gw; t < M; t += NGW) {
        const int s0 = POS[2 * t + vz], s1 = POS[2 * t + 1 + vz];
        GAS v4u* xb = (GAS v4u*)(XB + (size_t)t * DM) + lane; const GAS v4u* y0 = (const GAS v4u*)(Y + (size_t)s0 * DM) + lane; const GAS v4u* y1 = (const GAS v4u*)(Y + (size_t)s1 * DM) + lane;
        float s = 0.f;
#pragma unroll
        for (int j = 0; j < 2; ++j) { f32x4 xa, xc, aa, ac, ba, bc; unpack8(xb[64 * j], xa, xc); unpack8(y0[64 * j], aa, ac); unpack8(y1[64 * j], ba, bc);
            const f32x4 v0 = xa + aa + ba, v1 = xc + ac + bc; xb[64 * j] = pack8(v0, v1);
            s += ((v0[0] * v0[0] + v0[1] * v0[1]) + (v0[2] * v0[2] + v0[3] * v0[3])) + ((v1[0] * v1[0] + v1[1] * v1[1]) + (v1[2] * v1[2] + v1[3] * v1[3])); }
        const float tot = wave_sum(s);
        if (lane < 16) SSQ[(size_t)t * 16 + lane] = lane == 0 ? tot : 0.f;
    }
}
__device__ __forceinline__ void final_norm_phase(Frame& F, const Args& args) {
    float* X = F.out; const bf16* XB = WSP(bf16, WS_XB); const float* g = args.in[23];
    const int lane = F.lane, gw = F.vcu * NWAVES + F.wave, NGW = F.G * NWAVES;
    for (int t = gw; t < M; t += NGW) {
        const GAS v4u* xb = (const GAS v4u*)(XB + (size_t)t * DM) + lane; f32x4 v[4]; float s = 0.f;
#pragma unroll
        for (int j = 0; j < 2; ++j) { unpack8(xb[64 * j], v[2 * j], v[2 * j + 1]); }
#pragma unroll
        for (int j = 0; j < 4; ++j) s += (v[j][0] * v[j][0] + v[j][1] * v[j][1]) + (v[j][2] * v[j][2] + v[j][3] * v[j][3]);
        const float r = rsqrtf(wave_sum(s) * (1.0f / DM) + EPS);
        GAS f32x4* xo = (GAS f32x4*)(X + (size_t)t * DM) + 2 * lane;
#pragma unroll
        for (int j = 0; j < 2; ++j) { const f32x4 g0 = *((const f32x4*)g + 2 * lane + 128 * j), g1 = *((const f32x4*)g + 2 * lane + 128 * j + 1);
            xo[128 * j] = v[2 * j] * r * g0; xo[128 * j + 1] = v[2 * j + 1] * r * g1; }
    }
}
#ifndef MK_DUP
#define MK_DUP (-1)
#endif
#ifdef MK_REFGEMM
#define GEMM_BODY gemm_phase_ref
#else
#define GEMM_BODY gemm_phase
#endif
#ifndef MK_EN
#define MK_EN 0xfff
#endif
__global__ void __launch_bounds__(NWAVES * 64, 2) mk_fwd(Args args) {
    extern __shared__ __attribute__((aligned(16))) unsigned char lds[];
    Frame F;
    F.lds = (LAS unsigned char*)lds;
    F.MISC = (volatile LAS unsigned*)(F.lds + MISC_OFF);
    F.tid = threadIdx.x; F.lane = F.tid & 63; F.wave = __builtin_amdgcn_readfirstlane(F.tid >> 6);
    F.G = gridDim.x; { const int bx = blockIdx.x; F.vcu = (F.G % 8 == 0) ? (bx % 8) * (F.G / 8) + bx / 8 : bx; }
    F.ws = args.ws; F.out = args.out; F.ctl = (gu32*)(args.ws + WS_CTL);
    for (int u = F.tid; u < (LDS_BYTES - LDSCTL_OFF) / 4; u += NWAVES * 64) ((LAS unsigned*)(F.lds + LDSCTL_OFF))[u] = 0u;
    __syncthreads();
    XcdBarrier bar; bar.bar = (unsigned*)(F.ctl + CW_BAR); bar.x = 0; bar.st = nullptr;
    if (args.use_bar) bar = xcd_barrier_post((unsigned*)(F.ctl + CW_BAR), F.MISC + 8);
    const int cblk = (int)blockIdx.x;
#define PHASE_SEAM(ph_) do { if ((ph_) + 1 < args.ph_hi) { if (args.use_bar) { xcd_barrier(bar); } else { VM_WAIT(); __syncthreads(); } } } while (0)
    int ph0 = args.ph_lo;
    if (ph0 == 0 && (MK_EN & 1)) { p0_prologue(F, args); if (MK_DUP == 0) { xcd_barrier(bar); p0_prologue(F, args); } PHASE_SEAM(0); ph0 = 1; }
    for (int ph = ph0; ph < args.ph_hi; ++ph) {
      for (int rep_ = (ph == MK_DUP ? 2 : 1); rep_ > 0; --rep_) {
        { int t_ = threadIdx.x; asm volatile("" : "+v"(t_)); F.tid = t_; F.lane = t_ & 63; F.wave = __builtin_amdgcn_readfirstlane(t_ >> 6); }
        if (ph == PH_FINAL && (MK_EN & 2)) {
            final_norm_phase(F, args);
        } else {
            const int L = (ph - 1) / PH_PER_LAYER, sub = (ph - 1) % PH_PER_LAYER;
            const char* wl = (const char*)(F.ws + WS_W + (size_t)L * W_LAYER);
            float* SSQ0 = WSP(float, WS_SSQ + (size_t)(3 * L) * MiB);
            if (sub == 0 && (MK_EN & (4 << 0))) {
                SchedGrid S{64, 18, F.G, cblk, (const char*)XCUR(L), wl + WO_WIN, (size_t)256 * 1024 * 2, (size_t)256 * 1024 * 2};
                EpiP1 E{SSQ0, WSP(float, WS_COS), WSP(float, WS_SIN), WSP(bf16, WS_Q), WSP(bf16, WS_K), WSP(bf16, WS_V), WSP(bf16, WS_U), WSP(bf16, WS_SGA), WSP(bf16, WS_SGB)};
                pg8::GEMM_BODY<EpiP1, SchedGrid, true>(F.lds + RING_OFF, pg8::Dims{1024, 1024, 1024}, S, E);
            } else if (sub == 1 && (MK_EN & (4 << 1))) {
#ifdef MK_ATTN_SIMPLE
                attn_simple(F);
#else
                attn_mfma(F); __syncthreads();
#ifdef MK_ATTN_TWICE
                attn_mfma(F); __syncthreads();
#endif
#endif
#ifdef MK_CONV_SIMPLE
                conv_simple(F, args, L);
#else
                conv_v2(F, args, L);
#endif
            } else if (sub == 2 && (MK_EN & (4 << 2))) {
                SchedP3 S{F.G, cblk, (const char*)WSP(bf16, WS_OC), wl + WO_WAO, wl + WO_WCO};
                EpiP3 E{WSP(bf16, WS_SGA), WSP(bf16, WS_SGB), args.in[10] + L * DM, WSP(bf16, WS_MG)};
                pg8::GEMM_BODY<EpiP3, SchedP3, true>(F.lds + RING_OFF, pg8::Dims{512, 1024, 512}, S, E);
            } else if (sub == 3 && (MK_EN & (4 << 3))) {
                SchedGrid S{64, 4, F.G, cblk, (const char*)WSP(bf16, WS_MG), wl + WO_WOUT, (size_t)256 * 1024 * 2, (size_t)256 * 1024 * 2};
                EpiP4 E{XCUR(L), XCUR(L), WSP(float, WS_SSQ + (size_t)(3 * L + 1) * MiB)};
                pg8::GEMM_BODY<EpiP4, SchedGrid, false>(F.lds + RING_OFF, pg8::Dims{1024, 1024, 1024}, S, E);
            } else if (sub == 4 && (MK_EN & (4 << 4))) {
                {
                    SchedGrid S{64, 1, F.G, cblk, (const char*)XCUR(L), (const char*)(WSP(bf16, WS_WR) + (size_t)L * 256 * DM), (size_t)256 * 1024 * 2, (size_t)0};
                    EpiRoute E{WSP(float, WS_SSQ + (size_t)(3 * L + 1) * MiB), WSP(float, WS_RB) + L * 64, WSP(float, WS_LG)};
                    pg8::GEMM_BODY<EpiRoute, SchedGrid, false>(F.lds + RING_OFF, pg8::Dims{1024, 1024, 1024}, S, E);
                    VM_WAIT(); __syncthreads();
                    for (int l_ = cblk; l_ < 64; l_ += F.G) { int pm_, pn_; pg8::tile_of(l_, 64, 1, pm_, pn_); route_decide(F, L, pm_); }
                }
                {
                    const bool split = F.G >= 128;
                    SchedGrid S{64, 4, split ? F.G - 64 : F.G, split ? (cblk >= 64 ? cblk - 64 : 256) : cblk, (const char*)(WSP(bf16, WS_PB) + (size_t)L * M * PLE), wl + WO_WPP, (size_t)256 * 256 * 2, (size_t)256 * 256 * 2};
                    EpiBf16 E{WSP(bf16, WS_PE), DM};
                    pg8::GEMM_BODY<EpiBf16, SchedGrid, false>(F.lds + RING_OFF, pg8::Dims{256, 256, 256}, S, E);
                }
            } else if (sub == 5 && (MK_EN & (4 << 5))) {
                dispatch_phase(F, L);
            } else if (sub == 6 && (MK_EN & (4 << 6))) {
                moe_offsets(F, L);
                SchedMoe S{(const volatile LAS int*)(F.lds + OFFS_OFF), F.G, cblk, 1, (const char*)WSP(bf16, WS_XG), wl + WO_WGU};
                EpiUp E{WSP(float, WS_RSC), WSP(bf16, WS_H)};
                pg8::GEMM_BODY<EpiUp, SchedMoe, true>(F.lds + RING_OFF, pg8::Dims{1024, 1024, 1024}, S, E);
            } else if (sub == 7 && (MK_EN & (4 << 7))) {
                moe_offsets(F, L);
                SchedMoe S{(const volatile LAS int*)(F.lds + OFFS_OFF), F.G, cblk, 0, (const char*)WSP(bf16, WS_H), wl + WO_WD};
                EpiDown E{WSP(float, WS_ROWG), WSP(bf16, WS_Y)};
                pg8::GEMM_BODY<EpiDown, SchedMoe, true>(F.lds + RING_OFF, pg8::Dims{512, 512, 512}, S, E);
            } else if (sub == 8 && (MK_EN & (4 << 8))) {
                combine_phase(F, L);
            } else if (MK_EN & (4 << 9)) {
                SchedGrid S{64, 4, F.G, cblk, (const char*)XCUR(L), wl + WO_WPG, (size_t)256 * 1024 * 2, (size_t)256 * 1024 * 2};
                EpiP8 E{WSP(float, WS_SSQ + (size_t)(3 * L + 2) * MiB), WSP(bf16, WS_PE), XCUR(L), XNXT(L), WSP(float, WS_SSQ + (size_t)(3 * L + 3) * MiB)};
                pg8::GEMM_BODY<EpiP8, SchedGrid, false>(F.lds + RING_OFF, pg8::Dims{1024, 1024, 1024}, S, E);
            }
        }
        if (rep_ > 1) xcd_barrier(bar);
      }
        PHASE_SEAM(ph);
    }
}

#ifndef MK_OPT_PHASES
#define MK_OPT_PHASES 22
#endif
#ifndef MK_REPEAT
#define MK_REPEAT 1
#endif
#ifndef MK_SINGLE
#define MK_SINGLE 0
#endif
#if MK_OPT_PHASES < 22
static void naive_tail(hipStream_t stream, void* const* d_in, float* X, float* out, char* ws, int L0, int st0) {
    using namespace naive;
    const float* p = (const float*)d_in[1]; const float* norm_mix = (const float*)d_in[2]; const float* w_in = (const float*)d_in[3];
    const float* w_dw = (const float*)d_in[4]; const float* b_dw = (const float*)d_in[5]; const float* ln_g = (const float*)d_in[6]; const float* ln_b = (const float*)d_in[7];
    const float* w_ao = (const float*)d_in[8]; const float* w_co = (const float*)d_in[9]; const float* b_co = (const float*)d_in[10]; const float* w_out = (const float*)d_in[11];
    const float* norm_ffn = (const float*)d_in[12]; const float* w_rg = (const float*)d_in[13]; const float* b_rg = (const float*)d_in[14]; const float* w_re = (const float*)d_in[15]; const float* b_re = (const float*)d_in[16];
    const float* w_eg = (const float*)d_in[17]; const float* w_eu = (const float*)d_in[18]; const float* w_ed = (const float*)d_in[19];
    const float* norm_ple = (const float*)d_in[20]; const float* w_pp = (const float*)d_in[21]; const float* w_pg = (const float*)d_in[22]; const float* norm_final = (const float*)d_in[23];
    constexpr size_t MiB_ = 1u << 20;
    float* Hn = (float*)(ws + 0 * MiB_); float* QKV = (float*)(ws + 64 * MiB_); float* CUG = (float*)(ws + 160 * MiB_); float* GAB = (float*)(ws + 224 * MiB_);
    float* AO = (float*)(ws + 352 * MiB_); float* CO = (float*)(ws + 384 * MiB_);
    float* YA = Hn; float* YB = QKV;
    float* LG = CUG; float* LE = CUG + (size_t)M_ * 4; int* EID = (int*)(CUG + (size_t)M_ * 40); float* GT = CUG + (size_t)M_ * 48;
    float* GL = GAB; float* PE = QKV;
    for (int L = L0; L < DEPTH_; ++L) {
        const int s0 = (L == L0) ? st0 : 0;
        if (s0 <= 0) {
            hipLaunchKernelGGL(rmsnorm_k, dim3(M_ / 4), dim3(256), 0, stream, X, norm_mix + L * D_, Hn);
            const float* win = w_in + (size_t)L * D_ * WIN_;
            sgemm(stream, Hn, D_, win, WIN_, QKV, 1536, M_, 1536, D_, nullptr, nullptr);
            sgemm(stream, Hn, D_, win + 1536, WIN_, CUG, 1024, M_, 1024, D_, nullptr, nullptr);
            sgemm(stream, Hn, D_, win + 2560, WIN_, GAB, 2048, M_, 2048, D_, nullptr, nullptr);
            hipLaunchKernelGGL(rope_k, dim3(M_ * 2 * H_ * 32 / 256), dim3(256), 0, stream, QKV);
            hipLaunchKernelGGL(attn_naive_k, dim3(M_ * H_ / 4), dim3(256), 0, stream, QKV, AO);
            hipLaunchKernelGGL(conv_naive_k, dim3(M_), dim3(512), 0, stream, CUG, w_dw + (size_t)L * CK_ * CW_, b_dw + L * CW_, ln_g + L * CW_, ln_b + L * CW_, CO);
            sgemm(stream, AO, 512, w_ao + (size_t)L * 512 * D_, D_, YA, D_, M_, D_, 512, nullptr, nullptr);
            sgemm(stream, CO, 512, w_co + (size_t)L * 512 * D_, D_, YB, D_, M_, D_, 512, b_co + L * D_, nullptr);
            hipLaunchKernelGGL(merge_k, dim3(M_ * D_ / 256), dim3(256), 0, stream, GAB, YA, YB);
            sgemm(stream, GAB, 2048, w_out + (size_t)L * D_ * D_, D_, X, D_, M_, D_, D_, nullptr, X);
        }
        if (s0 <= 1) {
            hipLaunchKernelGGL(rmsnorm_k, dim3(M_ / 4), dim3(256), 0, stream, X, norm_ffn + L * D_, Hn);
            sgemm(stream, Hn, D_, w_rg + (size_t)L * D_ * NG_, NG_, LG, 4, M_, 4, D_, b_rg + L * NG_, nullptr);
            sgemm(stream, Hn, D_, w_re + (size_t)L * D_ * NE_, NE_, LE, 32, M_, 32, D_, b_re + L * NE_, nullptr);
            hipLaunchKernelGGL(route_k, dim3(M_ / 256), dim3(256), 0, stream, LG, LE, EID, GT);
            hipLaunchKernelGGL(moe_naive_k, dim3(M_), dim3(256), 0, stream, Hn, EID, GT, w_eg + (size_t)L * NE_ * D_ * FF_, w_eu + (size_t)L * NE_ * D_ * FF_, w_ed + (size_t)L * NE_ * FF_ * D_, X);
        }
        if (s0 <= 2) {
            hipLaunchKernelGGL(rmsnorm_k, dim3(M_ / 4), dim3(256), 0, stream, X, norm_ple + L * D_, Hn);
            sgemm(stream, Hn, D_, w_pg + (size_t)L * D_ * D_, D_, GL, D_, M_, D_, D_, nullptr, nullptr);
            sgemm(stream, p + (size_t)L * M_ * PLE_, PLE_, w_pp + (size_t)L * PLE_ * D_, D_, PE, D_, M_, D_, PLE_, nullptr, nullptr);
            hipLaunchKernelGGL(ple_k, dim3(M_ * D_ / 256), dim3(256), 0, stream, X, GL, PE);
        }
    }
    hipLaunchKernelGGL(rmsnorm_k, dim3(M_ / 4), dim3(256), 0, stream, X, norm_final, out);
}
#endif


#if MK_OPT_PHASES < 22
namespace dbg {
__device__ __forceinline__ float b2f(unsigned short u) { return __uint_as_float((unsigned)u << 16); }
__global__ void __launch_bounds__(256) cvt_qkv_k(const unsigned short* Q, const unsigned short* K, const unsigned short* V, float* qkv) {
    const size_t idx = (size_t)blockIdx.x * 256 + threadIdx.x;
    const int tok = (int)(idx >> 9), col = (int)(idx & 511), h = col >> 6, d = col & 63, b = tok >> 11, t = tok & 2047;
    const size_t src = ((size_t)(b * 8 + h) * 2048 + t) * 64 + d;
    qkv[(size_t)tok * 1536 + col] = b2f(Q[src]) * (1.0f / (0.125f * 1.4426950408889634f));
    qkv[(size_t)tok * 1536 + 512 + col] = b2f(K[src]);
    qkv[(size_t)tok * 1536 + 1024 + col] = b2f(V[src]);
}
__global__ void __launch_bounds__(512) conv_from_u_k(const unsigned short* __restrict__ U, const float* __restrict__ wdw, const float* __restrict__ bdw,
                                                     const float* __restrict__ lg, const float* __restrict__ lb, float* __restrict__ co) {
    __shared__ float red[16];
    const int tok = blockIdx.x, c = threadIdx.x, t = tok % 2048;
    float y = bdw[c];
    for (int j = 0; j < 31; ++j) { const int tt = t - 30 + j; if (tt >= 0) y += wdw[j * 512 + c] * b2f(U[(size_t)(tok - 30 + j) * 512 + c]); }
    float s = naive::wave_sum(y);
    if ((c & 63) == 0) red[c >> 6] = s;
    __syncthreads();
    float mu = 0.f;
    for (int i = 0; i < 8; ++i) mu += red[i];
    mu *= (1.f / 512.f);
    const float dv = y - mu;
    float s2 = naive::wave_sum(dv * dv);
    if ((c & 63) == 0) red[8 + (c >> 6)] = s2;
    __syncthreads();
    float var = 0.f;
    for (int i = 0; i < 8; ++i) var += red[8 + i];
    var *= (1.f / 512.f);
    const float yn = dv * rsqrtf(var + 1e-6f) * lg[c] + lb[c];
    co[(size_t)tok * 512 + c] = yn / (1.f + expf(-yn));
}
__global__ void __launch_bounds__(256) merge_sig_k(const unsigned short* sga, const unsigned short* sgb, const float* ya, const float* yb, float* mg) {
    const size_t idx = (size_t)blockIdx.x * 256 + threadIdx.x;
    mg[idx] = b2f(sga[idx]) * ya[idx] + b2f(sgb[idx]) * yb[idx];
}
__global__ void __launch_bounds__(256) cvt_oc_k(const unsigned short* oc, float* ao, float* co) {
    const size_t idx = (size_t)blockIdx.x * 256 + threadIdx.x;
    const size_t m = idx >> 10; const int n = (int)(idx & 1023);
    const float v = b2f(oc[idx]);
    if (n < 512) ao[m * 512 + n] = v; else co[m * 512 + n - 512] = v;
}
__global__ void __launch_bounds__(256) cvt_bf_k(const unsigned short* src, float* dst) {
    const size_t idx = (size_t)blockIdx.x * 256 + threadIdx.x; dst[idx] = b2f(src[idx]);
}
}
static void dbg_mixer_tail(hipStream_t stream, void* const* d_in, float* X, char* ws, int nopt) {
    using namespace naive;
    constexpr size_t MiB_ = 1u << 20;
    const float* w_dw = (const float*)d_in[4]; const float* b_dw = (const float*)d_in[5]; const float* ln_g = (const float*)d_in[6]; const float* ln_b = (const float*)d_in[7];
    const float* w_ao = (const float*)d_in[8]; const float* w_co = (const float*)d_in[9]; const float* b_co = (const float*)d_in[10]; const float* w_out = (const float*)d_in[11];
    float* Hn = (float*)(ws + 0 * MiB_); float* QKV = (float*)(ws + 64 * MiB_); float* YBb = (float*)(ws + 160 * MiB_); float* MGf = (float*)(ws + 224 * MiB_);
    float* AO = (float*)(ws + 288 * MiB_); float* CO = (float*)(ws + 320 * MiB_);
    const unsigned short* Qb = (const unsigned short*)(ws + WS_Q); const unsigned short* Kb = (const unsigned short*)(ws + WS_K); const unsigned short* Vb = (const unsigned short*)(ws + WS_V);
    const unsigned short* Ub = (const unsigned short*)(ws + WS_U); const unsigned short* SGAb = (const unsigned short*)(ws + WS_SGA); const unsigned short* SGBb = (const unsigned short*)(ws + WS_SGB);
    const unsigned short* OCb = (const unsigned short*)(ws + WS_OC); const unsigned short* MGb = (const unsigned short*)(ws + WS_MG);
    (void)hipMemcpyAsync(X, d_in[0], (size_t)M_ * D_ * 4, hipMemcpyDeviceToDevice, stream);
    if (nopt == 2) {
        hipLaunchKernelGGL(dbg::cvt_qkv_k, dim3(M_ * 512 / 256), dim3(256), 0, stream, Qb, Kb, Vb, QKV);
        hipLaunchKernelGGL(attn_naive_k, dim3(M_ * H_ / 4), dim3(256), 0, stream, QKV, AO);
        hipLaunchKernelGGL(dbg::conv_from_u_k, dim3(M_), dim3(512), 0, stream, Ub, w_dw, b_dw, ln_g, ln_b, CO);
    } else if (nopt == 3) {
        hipLaunchKernelGGL(dbg::cvt_oc_k, dim3(M_ * D_ / 256), dim3(256), 0, stream, OCb, AO, CO);
    }
    if (nopt <= 3) {
        sgemm(stream, AO, 512, w_ao, D_, Hn, D_, M_, D_, 512, nullptr, nullptr);
        sgemm(stream, CO, 512, w_co, D_, YBb, D_, M_, D_, 512, b_co, nullptr);
        hipLaunchKernelGGL(dbg::merge_sig_k, dim3(M_ * D_ / 256), dim3(256), 0, stream, SGAb, SGBb, Hn, YBb, MGf);
    } else {
        hipLaunchKernelGGL(dbg::cvt_bf_k, dim3(M_ * D_ / 256), dim3(256), 0, stream, MGb, MGf);
    }
    sgemm(stream, MGf, D_, w_out, D_, X, D_, M_, D_, D_, nullptr, X);
}
#endif

#if MK_OPT_PHASES < 22
namespace dbg {
__global__ void __launch_bounds__(256) hash_k(const unsigned* buf, size_t nwords, unsigned* out) {
    unsigned acc = 0u;
    for (size_t i = (size_t)blockIdx.x * 256 + threadIdx.x; i < nwords; i += (size_t)gridDim.x * 256) acc += buf[i] * (2654435761u * (unsigned)(2 * i + 1)) + (unsigned)i;
    for (int o = 1; o < 64; o <<= 1) acc += __shfl_xor(acc, o);
    if ((threadIdx.x & 63) == 0) atomicAdd(out, acc);
}
__global__ void __launch_bounds__(256) perturb_k(float* out, size_t first, size_t count, const unsigned* hash) {
    const size_t i = (size_t)blockIdx.x * 256 + threadIdx.x;
    if (i < count) out[first + i] += (float)(hash[0] >> 8) * (1.0f / 16777216.0f);
}
}
static void dbg_hash(hipStream_t st, const void* buf, size_t bytes, unsigned* cell) { hipLaunchKernelGGL(dbg::hash_k, dim3(1024), dim3(256), 0, st, (const unsigned*)buf, bytes / 4, cell); }
#endif

#if MK_OPT_PHASES < 22
#ifndef DBG_USE
#define DBG_USE 7
#endif
static void dbg_p1_tail(hipStream_t stream, void* const* d_in, float* X, char* ws) {
    using namespace naive;
    constexpr size_t MiB_ = 1u << 20;
    const float* norm_mix = (const float*)d_in[2]; const float* w_in = (const float*)d_in[3];
    const float* w_dw = (const float*)d_in[4]; const float* b_dw = (const float*)d_in[5]; const float* ln_g = (const float*)d_in[6]; const float* ln_b = (const float*)d_in[7];
    const float* w_ao = (const float*)d_in[8]; const float* w_co = (const float*)d_in[9]; const float* b_co = (const float*)d_in[10]; const float* w_out = (const float*)d_in[11];
    float* Hn = (float*)(ws + 0 * MiB_); float* QKV = (float*)(ws + 64 * MiB_); float* CUG = (float*)(ws + 160 * MiB_); float* GAB = (float*)(ws + 224 * MiB_);
    float* AO = (float*)(ws + 480 * MiB_); float* CO = (float*)(ws + 64 * MiB_); float* YA = Hn; float* YB = (float*)(ws + 96 * MiB_); float* MGf = (float*)(ws + 160 * MiB_);
    const unsigned short* Qb = (const unsigned short*)(ws + WS_Q); const unsigned short* Kb = (const unsigned short*)(ws + WS_K); const unsigned short* Vb = (const unsigned short*)(ws + WS_V);
    const unsigned short* Ub = (const unsigned short*)(ws + WS_U); const unsigned short* SGAb = (const unsigned short*)(ws + WS_SGA); const unsigned short* SGBb = (const unsigned short*)(ws + WS_SGB);
    (void)hipMemcpyAsync(X, d_in[0], (size_t)M_ * D_ * 4, hipMemcpyDeviceToDevice, stream);
    hipLaunchKernelGGL(rmsnorm_k, dim3(M_ / 4), dim3(256), 0, stream, X, norm_mix, Hn);
    if (DBG_USE & 1) hipLaunchKernelGGL(dbg::cvt_qkv_k, dim3(M_ * 512 / 256), dim3(256), 0, stream, Qb, Kb, Vb, QKV);
    else { sgemm(stream, Hn, D_, w_in, WIN_, QKV, 1536, M_, 1536, D_, nullptr, nullptr); hipLaunchKernelGGL(rope_k, dim3(M_ * 2 * H_ * 32 / 256), dim3(256), 0, stream, QKV); }
    if (!(DBG_USE & 2)) sgemm(stream, Hn, D_, w_in + 1536, WIN_, CUG, 1024, M_, 1024, D_, nullptr, nullptr);
    if (!(DBG_USE & 4)) sgemm(stream, Hn, D_, w_in + 2560, WIN_, GAB, 2048, M_, 2048, D_, nullptr, nullptr);
    hipLaunchKernelGGL(attn_naive_k, dim3(M_ * H_ / 4), dim3(256), 0, stream, QKV, AO);
    if (DBG_USE & 2) hipLaunchKernelGGL(dbg::conv_from_u_k, dim3(M_), dim3(512), 0, stream, Ub, w_dw, b_dw, ln_g, ln_b, CO);
    else hipLaunchKernelGGL(conv_naive_k, dim3(M_), dim3(512), 0, stream, CUG, w_dw, b_dw, ln_g, ln_b, CO);
    sgemm(stream, AO, 512, w_ao, D_, YA, D_, M_, D_, 512, nullptr, nullptr);
    sgemm(stream, CO, 512, w_co, D_, YB, D_, M_, D_, 512, b_co, nullptr);
    if (DBG_USE & 4) { hipLaunchKernelGGL(dbg::merge_sig_k, dim3(M_ * D_ / 256), dim3(256), 0, stream, SGAb, SGBb, YA, YB, MGf); sgemm(stream, MGf, D_, w_out, D_, X, D_, M_, D_, D_, nullptr, X); }
    else { hipLaunchKernelGGL(merge_k, dim3(M_ * D_ / 256), dim3(256), 0, stream, GAB, YA, YB); sgemm(stream, GAB, 2048, w_out, D_, X, D_, M_, D_, D_, nullptr, X); }
}
#endif

extern "C" void kernel_launch(void* const* d_in, const int* in_sizes, int n_in, void* d_out, int out_size, void* d_ws, size_t ws_size, hipStream_t stream) {
    static int grid = 0;
    if (grid == 0) {
        if (n_in != 24 || in_sizes[0] != M * DM || out_size != M * DM || ws_size < WS_END) { fprintf(stderr, "kernel_launch: unexpected shapes (n_in %d, in0 %d, out %d, ws %zu); nothing launched\n", n_in, n_in > 0 ? in_sizes[0] : -1, out_size, ws_size); grid = -1; return; }
        int dev = 0, cus = 0, per_cu = 0;
        if (hipGetDevice(&dev) != hipSuccess || hipDeviceGetAttribute(&cus, hipDeviceAttributeMultiprocessorCount, dev) != hipSuccess) { fprintf(stderr, "kernel_launch: device query failed\n"); grid = -1; return; }
        if (hipFuncSetAttribute((const void*)mk_fwd, hipFuncAttributeMaxDynamicSharedMemorySize, LDS_BYTES) != hipSuccess) { fprintf(stderr, "kernel_launch: hipFuncSetAttribute failed\n"); grid = -1; return; }
        if (hipOccupancyMaxActiveBlocksPerMultiprocessor(&per_cu, (const void*)mk_fwd, NWAVES * 64, LDS_BYTES) != hipSuccess || per_cu < 1) { fprintf(stderr, "kernel_launch: occupancy query reports %d blocks per CU\n", per_cu); }
        (void)hipGetLastError();
        grid = cus;
    }
    if (grid < 0) return;
    (void)hipMemsetAsync((char*)d_ws + WS_CTL, 0, CTL_ZERO_BYTES, stream);
    Args a{};
    for (int i = 0; i < 24; ++i) a.in[i] = (const float*)d_in[i];
    a.out = (float*)d_out; a.ws = (unsigned char*)d_ws;
    constexpr int NOPT = MK_OPT_PHASES;
#if MK_SINGLE
    a.ph_lo = 0; a.ph_hi = NOPT; a.use_bar = 1;
    hipLaunchKernelGGL(mk_fwd, dim3(grid), dim3(NWAVES * 64), LDS_BYTES, stream, a);
#else
    for (int rep = 0; rep < MK_REPEAT; ++rep)
    for (int ph = 0; ph < NOPT; ++ph) { a.ph_lo = ph; a.ph_hi = ph + 1; a.use_bar = 0; hipLaunchKernelGGL(mk_fwd, dim3(grid), dim3(NWAVES * 64), LDS_BYTES, stream, a); }
#endif
#if defined(MK_PROBE)
    {
        constexpr size_t MiB_ = 1u << 20; char* ws = (char*)d_ws; unsigned* cells = (unsigned*)(ws + 520 * MiB_);
        (void)hipMemsetAsync(cells, 0, 256, stream);
        MK_PROBE
        (void)hipMemcpyAsync(d_out, d_in[0], (size_t)M * DM * 4, hipMemcpyDeviceToDevice, stream);
        naive_tail(stream, d_in, (float*)d_out, (float*)d_out, (char*)d_ws, 0, 0);
        hipLaunchKernelGGL(dbg::perturb_k, dim3((1u << 22) / 256), dim3(256), 0, stream, (float*)d_out, (size_t)0, (size_t)1 << 22, cells);
        hipLaunchKernelGGL(dbg::perturb_k, dim3((1u << 16) / 256), dim3(256), 0, stream, (float*)d_out, (size_t)1 << 23, (size_t)1 << 16, cells + 16);
    }
#elif MK_OPT_PHASES < 22
    {
        int L0 = 0, st0 = 0;
        if (NOPT <= 1) { (void)hipMemcpyAsync(d_out, d_in[0], (size_t)M * DM * 4, hipMemcpyDeviceToDevice, stream); }
        else if (NOPT == 2) { dbg_p1_tail(stream, d_in, (float*)d_out, (char*)d_ws); L0 = 0; st0 = 1; }
        else if (NOPT >= 3 && NOPT <= 4) { dbg_mixer_tail(stream, d_in, (float*)d_out, (char*)d_ws, NOPT); L0 = 0; st0 = 1; }
        else if (NOPT == 5) { L0 = 0; st0 = 1; } else if (NOPT == 10) { L0 = 0; st0 = 2; } else if (NOPT == 11) { L0 = 1; st0 = 0; }
        else if (NOPT == 15) { L0 = 1; st0 = 1; } else if (NOPT == 20) { L0 = 1; st0 = 2; } else if (NOPT == 21) { L0 = 2; st0 = 0; }
        naive_tail(stream, d_in, (float*)d_out, (float*)d_out, (char*)d_ws, L0, st0);
    }
#endif
}
```

```cpp
#define MK_OPT_PHASES 22
#define MK_SINGLE 1
#include <hip/hip_runtime.h>
#include <cstdio>
#include <cstdint>
#include <cmath>
namespace pg8 {
#define PG8_LAS __attribute__((address_space(3)))
typedef unsigned short bf16_t;
typedef short bf16x8 __attribute__((ext_vector_type(8)));
typedef float f32x4 __attribute__((ext_vector_type(4)));
typedef float f32x2 __attribute__((ext_vector_type(2)));
typedef unsigned u32x4 __attribute__((ext_vector_type(4)));
typedef unsigned u32x2 __attribute__((ext_vector_type(2)));
constexpr int BM = 256, BK = 64, HALF = 128, HTB = HALF * BK * 2  , STAGE_BYTES = 8 * HTB, NXCD = 8, WGM = 8;

__host__ __device__ __forceinline__ int lds_byte(int r, int c) { const int st = (r >> 4) * 2 + (c >> 5), rr = r & 15, cc = c & 31, ob = rr * 64 + cc * 2; return st * 1024 + (ob ^ (((ob >> 9) & 1) << 5)); }
__host__ __device__ __forceinline__ void stage_rc(int b, int& R, int& C) { const int st = b / 1024, sb = b % 1024, swz = sb ^ (((sb >> 9) & 1) << 5); R = (st >> 1) * 16 + swz / 64; C = (st & 1) * 32 + (swz % 64) / 2; }
__host__ __device__ __forceinline__ int perm32(int rho) { const int n = rho >> 4, i = rho & 15; return 8 * (i >> 2) + 4 * n + (i & 3); }

struct Unit { int pm, pn, aux; const char* A; const char* B; };
struct Dims { int K, lda, ldb; };

__host__ __device__ __forceinline__ void tile_of(int L, int nM, int nN, int& pm, int& pn) {
    const int nwg = nM * nN; int wgid = L; { const int q = nwg / NXCD, r = nwg % NXCD, xcd = wgid % NXCD, off = wgid / NXCD; wgid = (xcd < r ? xcd * (q + 1) : r * (q + 1) + (xcd - r) * q) + off; }
    const int nig = WGM * nN, gid = wgid / nig, fm = gid * WGM, gsz = (nM - fm) < WGM ? (nM - fm) : WGM;
    pm = fm + ((wgid % nig) % gsz); pn = (wgid % nig) / gsz;
}

typedef __bf16 bf16x2v __attribute__((ext_vector_type(2)));
__device__ __forceinline__ unsigned cvt_pk_bf16(float lo, float hi) { const f32x2 v = {lo, hi}; const bf16x2v b = __builtin_convertvector(v, bf16x2v); return __builtin_bit_cast(unsigned, b); }
__device__ __forceinline__ u32x4 pack8(const f32x4 a, const f32x4 b) { u32x4 w; w.x = cvt_pk_bf16(a[0], a[1]); w.y = cvt_pk_bf16(a[2], a[3]); w.z = cvt_pk_bf16(b[0], b[1]); w.w = cvt_pk_bf16(b[2], b[3]); return w; }
__device__ __forceinline__ float bf_lo(unsigned w) { return __uint_as_float(w << 16); }
__device__ __forceinline__ float bf_hi(unsigned w) { return __uint_as_float(w & 0xffff0000u); }
__device__ __forceinline__ void unpack8(const u32x4 w, f32x4& a, f32x4& b) { a[0] = bf_lo(w.x); a[1] = bf_hi(w.x); a[2] = bf_lo(w.y); a[3] = bf_hi(w.y); b[0] = bf_lo(w.z); b[1] = bf_hi(w.z); b[2] = bf_lo(w.w); b[3] = bf_hi(w.w); }
__device__ __forceinline__ float sigm(float x) { return __builtin_amdgcn_rcpf(1.0f + __builtin_amdgcn_exp2f(-1.4426950408889634f * x)); }
__device__ __forceinline__ f32x4 sigm4(const f32x4 x) { f32x4 r; r[0] = sigm(x[0]); r[1] = sigm(x[1]); r[2] = sigm(x[2]); r[3] = sigm(x[3]); return r; }

template <class Epi, class Sched, bool ALIGN_EPI>
__device__ __forceinline__ void gemm_phase(PG8_LAS unsigned char* lds, const Dims g, const Sched& S, const Epi& E) {
    int tid_ = threadIdx.x; asm volatile("" : "+v"(tid_));
    const int tid = tid_, wid = __builtin_amdgcn_readfirstlane(tid >> 6), lane = tid & 63, wr = wid >> 2, wc = wid & 3, fr = lane & 15, fq = lane >> 4;
    const int K = g.K, nt = K / BK;
    unsigned voffA[2], voffB[2];
#pragma unroll
    for (int i = 0; i < 2; ++i) { int R, C; stage_rc(tid * 16 + i * 8192, R, C); const int Rb = Epi::PERM ? ((R & ~31) + perm32(R & 31)) : R;
        voffA[i] = (unsigned)(R * g.lda + C) * 2u; voffB[i] = (unsigned)(Rb * g.ldb + C) * 2u; }
    const size_t kstep = (size_t)(BK * 2);
    const size_t hA = (size_t)HALF * g.lda * 2, hB = (size_t)HALF * g.ldb * 2;
    const unsigned ldsw = (unsigned)wid * 1024u;
    const int aoff = lds_byte(wr * 64 + fr, fq * 8), boff = lds_byte(wc * 32 + fr, fq * 8);
#define PG8_SA(b, h) (((b) * 2 + (h)) * HTB)
#define PG8_SB(b, h) ((4 + (b) * 2 + (h)) * HTB)
#define PG8_STAGE(bufoff, gbase, voff) do { _Pragma("unroll") for (int _i = 0; _i < 2; ++_i) \
        __builtin_amdgcn_global_load_lds((const unsigned*)((const char*)(gbase) + (voff)[_i]), (PG8_LAS unsigned*)(lds + (bufoff) + ldsw + _i * 8192), 16, 0, 0); } while (0)
#define PG8_LDA(dst, b, h) do { _Pragma("unroll") for (int m = 0; m < 4; ++m) _Pragma("unroll") for (int k = 0; k < 2; ++k) dst[m][k] = *(const PG8_LAS bf16x8*)(lds + PG8_SA(b, h) + aoff + m * 2048 + k * 1024); } while (0)
#define PG8_LDB(dst, b, h) do { _Pragma("unroll") for (int n = 0; n < 2; ++n) _Pragma("unroll") for (int k = 0; k < 2; ++k) dst[n][k] = *(const PG8_LAS bf16x8*)(lds + PG8_SB(b, h) + boff + n * 2048 + k * 1024); } while (0)
#define PG8_MMA(ai, bj, At, Bt) do { __builtin_amdgcn_s_setprio(1); _Pragma("unroll") for (int m = 0; m < 4; ++m) _Pragma("unroll") for (int n = 0; n < 2; ++n) _Pragma("unroll") for (int k = 0; k < 2; ++k) \
        acc[ai][bj][m][n] = __builtin_amdgcn_mfma_f32_16x16x32_bf16(Bt[n][k], At[m][k], acc[ai][bj][m][n], 0, 0, 0); __builtin_amdgcn_s_setprio(0); } while (0)
#define PG8_WAIT_V(n) asm volatile("s_waitcnt vmcnt(" #n ")" ::: "memory")
#define PG8_WAIT_L(n) asm volatile("s_waitcnt lgkmcnt(" #n ")" ::: "memory")
#define PG8_BAR __builtin_amdgcn_s_barrier()
#define PG8_SCHED __builtin_amdgcn_sched_barrier(0)
    Unit cur, nxt; int ui = 0;
    if (!S.next(0, cur)) return;
    f32x4 acc[2][2][4][2];
#pragma unroll
    for (int a = 0; a < 2; ++a)
#pragma unroll
        for (int b = 0; b < 2; ++b)
#pragma unroll
            for (int m = 0; m < 4; ++m)
#pragma unroll
                for (int n = 0; n < 2; ++n) acc[a][b][m][n] = (f32x4){0.f, 0.f, 0.f, 0.f};
    bf16x8 At[4][2], B0[2][2], B1[2][2];
    const char* cA = cur.A; const char* cB = cur.B;
    PG8_STAGE(PG8_SB(0, 0), cB, voffB); PG8_STAGE(PG8_SB(0, 1), cB + hB, voffB); PG8_STAGE(PG8_SA(0, 0), cA, voffA); PG8_STAGE(PG8_SA(0, 1), cA + hA, voffA);
    if (wr == 1) PG8_BAR;
    PG8_WAIT_V(2); PG8_BAR;
    PG8_STAGE(PG8_SB(1, 0), cB + kstep, voffB); PG8_STAGE(PG8_SA(1, 0), cA + kstep, voffA); PG8_STAGE(PG8_SB(1, 1), cB + hB + kstep, voffB);
    PG8_WAIT_V(6); PG8_BAR;
    for (;;) {
        const bool has_next = S.next(ui + 1, nxt);
        const char* nA = has_next ? nxt.A : cA; const char* nB = has_next ? nxt.B : cB;
        for (int hk = 0; hk < (Epi::MIDK ? 2 : 1); ++hk) {
        if constexpr (Epi::MIDK) { if (hk == 1) E.mid(acc, cur, wr, wc, fr, fq); }
        const int tbeg = Epi::MIDK ? hk * (nt / 2) : 0, tend = Epi::MIDK ? (hk + 1) * (nt / 2) : nt;
        for (int t = tbeg; t < tend; t += 2) {
            const bool last = (t == nt - 2);
            const char* a1 = cA + (size_t)(t + 1) * kstep;
            const char* a2 = last ? nA : cA + (size_t)(t + 2) * kstep; const char* b2 = last ? nB : cB + (size_t)(t + 2) * kstep;
            const char* a3 = a2 + kstep; const char* b3 = b2 + kstep;
            PG8_LDB(B0, 0, 0); PG8_LDB(B1, 0, 1); PG8_SCHED; PG8_LDA(At, 0, 0); PG8_STAGE(PG8_SA(1, 1), a1 + hA, voffA);
            PG8_WAIT_V(8); PG8_WAIT_L(0); PG8_BAR; PG8_MMA(0, 0, At, B0); PG8_MMA(0, 1, At, B1); PG8_BAR; PG8_SCHED;
            PG8_LDA(At, 0, 1); PG8_STAGE(PG8_SB(0, 0), b2, voffB); PG8_STAGE(PG8_SB(0, 1), b2 + hB, voffB); PG8_STAGE(PG8_SA(0, 0), a2, voffA);
            PG8_WAIT_V(8); PG8_WAIT_L(0); PG8_BAR; PG8_MMA(1, 0, At, B0); PG8_MMA(1, 1, At, B1); PG8_BAR; PG8_SCHED;
            PG8_LDB(B0, 1, 0); PG8_LDB(B1, 1, 1); PG8_SCHED; PG8_LDA(At, 1, 0); PG8_STAGE(PG8_SA(0, 1), a2 + hA, voffA);
            PG8_WAIT_V(8); PG8_WAIT_L(0); PG8_BAR; PG8_MMA(0, 0, At, B0); PG8_MMA(0, 1, At, B1); PG8_BAR; PG8_SCHED;
            PG8_LDA(At, 1, 1); PG8_STAGE(PG8_SB(1, 0), b3, voffB); PG8_STAGE(PG8_SB(1, 1), b3 + hB, voffB); PG8_STAGE(PG8_SA(1, 0), a3, voffA);
            PG8_WAIT_V(8); PG8_WAIT_L(0); PG8_BAR; PG8_MMA(1, 0, At, B0); PG8_MMA(1, 1, At, B1); PG8_BAR; PG8_SCHED;
        }
        }
        if constexpr (ALIGN_EPI) { if (wr == 0) PG8_BAR; }
        E(acc, cur, wr, wc, fr, fq);
        if (!has_next) break;
#pragma unroll
        for (int a = 0; a < 2; ++a)
#pragma unroll
            for (int b = 0; b < 2; ++b)
#pragma unroll
                for (int m = 0; m < 4; ++m)
#pragma unroll
                    for (int n = 0; n < 2; ++n) acc[a][b][m][n] = (f32x4){0.f, 0.f, 0.f, 0.f};
        cur = nxt; cA = nA; cB = nB; ++ui;
        if constexpr (ALIGN_EPI) { if (wr == 1) PG8_BAR; }
    }
    PG8_WAIT_V(0);
    if constexpr (!ALIGN_EPI) { if (wr == 0) PG8_BAR; }
    PG8_BAR;
#undef PG8_SA
#undef PG8_SB
#undef PG8_STAGE
#undef PG8_LDA
#undef PG8_LDB
#undef PG8_MMA
#undef PG8_WAIT_V
#undef PG8_WAIT_L
#undef PG8_BAR
#undef PG8_SCHED
}

template <class Epi, class Sched, bool ALIGN_EPI>
__device__ __forceinline__ void gemm_phase_ref(PG8_LAS unsigned char* lds, const Dims g, const Sched& S, const Epi& E) {
    int tid_ = threadIdx.x; asm volatile("" : "+v"(tid_));
    const int tid = tid_, wid = __builtin_amdgcn_readfirstlane(tid >> 6), lane = tid & 63, wr = wid >> 2, wc = wid & 3, fr = lane & 15, fq = lane >> 4;
    typedef __bf16 bf2 __attribute__((ext_vector_type(2)));
    Unit cur;
    for (int ui = 0; S.next(ui, cur); ++ui) {
        f32x4 acc[2][2][4][2];
#pragma unroll
        for (int a = 0; a < 2; ++a)
#pragma unroll
            for (int b = 0; b < 2; ++b)
#pragma unroll
                for (int m = 0; m < 4; ++m)
#pragma unroll
                    for (int n = 0; n < 2; ++n) acc[a][b][m][n] = (f32x4){0.f, 0.f, 0.f, 0.f};
        for (int k0 = 0; k0 < g.K; k0 += 8) {
            u32x4 av[2][4];
#pragma unroll
            for (int a = 0; a < 2; ++a)
#pragma unroll
                for (int m = 0; m < 4; ++m) av[a][m] = *(const u32x4*)(cur.A + ((size_t)(128 * a + 64 * wr + 16 * m + fr) * g.lda + k0) * 2);
#pragma unroll
            for (int b = 0; b < 2; ++b)
#pragma unroll
                for (int n = 0; n < 2; ++n)
#pragma unroll
                    for (int i = 0; i < 4; ++i) {
                        const int col = Epi::PERM ? (128 * b + 32 * wc + 8 * fq + 4 * n + i) : (128 * b + 32 * wc + 16 * n + 4 * fq + i);
                        const u32x4 bv = *(const u32x4*)(cur.B + ((size_t)col * g.ldb + k0) * 2);
#pragma unroll
                        for (int a = 0; a < 2; ++a)
#pragma unroll
                            for (int m = 0; m < 4; ++m) { float s = acc[a][b][m][n][i];
                                s = __builtin_amdgcn_fdot2_f32_bf16(__builtin_bit_cast(bf2, av[a][m].x), __builtin_bit_cast(bf2, bv.x), s, false);
                                s = __builtin_amdgcn_fdot2_f32_bf16(__builtin_bit_cast(bf2, av[a][m].y), __builtin_bit_cast(bf2, bv.y), s, false);
                                s = __builtin_amdgcn_fdot2_f32_bf16(__builtin_bit_cast(bf2, av[a][m].z), __builtin_bit_cast(bf2, bv.z), s, false);
                                s = __builtin_amdgcn_fdot2_f32_bf16(__builtin_bit_cast(bf2, av[a][m].w), __builtin_bit_cast(bf2, bv.w), s, false);
                                acc[a][b][m][n][i] = s; }
                    }
        }
        E(acc, cur, wr, wc, fr, fq);
    }
}
}
#define GAS __attribute__((address_space(1)))
#define LAS __attribute__((address_space(3)))
typedef unsigned short bf16;
typedef unsigned v4u __attribute__((ext_vector_type(4)));
typedef unsigned v2u __attribute__((ext_vector_type(2)));
typedef float f32x4 __attribute__((ext_vector_type(4)));
typedef float f32x2 __attribute__((ext_vector_type(2)));
typedef short bf16x8 __attribute__((ext_vector_type(8)));
typedef __bf16 bf16x2_t __attribute__((ext_vector_type(2)));
typedef GAS unsigned gu32;
#define RLX_AGENT __ATOMIC_RELAXED, __HIP_MEMORY_SCOPE_AGENT
#define LDS_WAIT() asm volatile("s_waitcnt lgkmcnt(0)" ::: "memory")
#define VM_WAIT() asm volatile("s_waitcnt vmcnt(0)" ::: "memory")
using pg8::cvt_pk_bf16; using pg8::pack8; using pg8::unpack8; using pg8::bf_lo; using pg8::bf_hi; using pg8::sigm; using pg8::sigm4;

__device__ __forceinline__ float wave_sum(float v) {
#pragma unroll
    for (int o = 1; o < 64; o <<= 1) v += __shfl_xor(v, o);
    return v;
}
__device__ __forceinline__ float dot2bf(unsigned a, unsigned b, float acc) { return __builtin_amdgcn_fdot2_f32_bf16(__builtin_bit_cast(bf16x2_t, a), __builtin_bit_cast(bf16x2_t, b), acc, false); }

#define XB_TMO      128
#define XB_XCNT(j)  (256  + 64 * (j))
#define XB_XSUB(j)  (1280 + 64 * (j))
#define XB_XGEN(j)  (2304 + 64 * (j))
#define XB_TOP      3328
#define XB_TOPGEN   3392
#define XCD_BAR_WORDS 3456
#define XB_SPIN_CAP (1u << 18)

__device__ __forceinline__ unsigned xb_ld(unsigned* p)              { return __hip_atomic_load(p, __ATOMIC_RELAXED, __HIP_MEMORY_SCOPE_AGENT); }
__device__ __forceinline__ unsigned xb_add(unsigned* p, unsigned v) { return __hip_atomic_fetch_add(p, v, __ATOMIC_RELAXED, __HIP_MEMORY_SCOPE_AGENT); }
__device__ __forceinline__ unsigned xb_xcc_id() { return (unsigned)__builtin_amdgcn_s_getreg((3 << 11) | 20) & 0xFu; }
#define XB_SPIN(cond, bar) do { unsigned _sp = 0; while (cond) { __builtin_amdgcn_s_sleep(1); \
    if ((++_sp & 255u) == 0u) { if (xb_ld(&(bar)[XB_TMO])) break; if (_sp > XB_SPIN_CAP) { atomicAdd(&(bar)[XB_TMO], 1u); break; } } } } while (0)

struct XcdBarrier {
    unsigned* bar; unsigned x;
    volatile LAS unsigned* st;
};
__device__ __forceinline__ XcdBarrier xcd_barrier_post(unsigned* bar, volatile LAS unsigned* st) {
    XcdBarrier b; b.bar = bar; b.x = xb_xcc_id(); b.st = st;
    if (threadIdx.x == 0) (void)xb_add(&bar[XB_XCNT(b.x)], 1u);
    return b;
}
__device__ __forceinline__ void xcd_barrier_complete(unsigned* bar, unsigned x, unsigned& nloc, unsigned& nx) {
    const unsigned G = gridDim.x * gridDim.y * gridDim.z;
    unsigned sum, cnt, mine, sp = 0u;
    for (;;) {
        sum = 0u; cnt = 0u; mine = 0u;
#pragma unroll
        for (unsigned j = 0; j < 16; ++j) { const unsigned c = xb_ld(&bar[XB_XCNT(j)]); sum += c; cnt += (c > 0u) ? 1u : 0u; mine = (j == x) ? c : mine; }
        if (sum == G) break;
        __builtin_amdgcn_s_sleep(1);
        if ((++sp & 255u) == 0u) { if (xb_ld(&bar[XB_TMO])) break; if (sp > XB_SPIN_CAP) { atomicAdd(&bar[XB_TMO], 1u); break; } }
    }
    nloc = mine > 0u ? mine : 1u; nx = cnt > 0u ? cnt : 1u;
}
__device__ __forceinline__ void xcd_barrier(const XcdBarrier& b) {
    asm volatile("s_waitcnt vmcnt(0)" ::: "memory");
    __syncthreads();
    if (threadIdx.x == 0) {
        unsigned* bar = b.bar;
        __builtin_amdgcn_s_waitcnt(0);
        unsigned nloc = b.st[0], nx = b.st[1];
        if (nloc == 0u) { xcd_barrier_complete(bar, b.x, nloc, nx); b.st[0] = nloc; b.st[1] = nx; }
        const unsigned old = xb_add(&bar[XB_XSUB(b.x)], 1u);
        const unsigned gen = old / nloc;
        if (old + 1u == (gen + 1u) * nloc) {
            __builtin_amdgcn_fence(__ATOMIC_RELEASE, "agent");
            asm volatile("s_waitcnt vmcnt(0)" ::: "memory");
            const unsigned og = xb_add(&bar[XB_TOP], 1u);
            const unsigned tg = og / nx;
            if (og + 1u == (tg + 1u) * nx) xb_add(&bar[XB_TOPGEN], 1u);
            else XB_SPIN(xb_ld(&bar[XB_TOPGEN]) == tg, bar);
            __builtin_amdgcn_fence(__ATOMIC_ACQUIRE, "agent");
            xb_add(&bar[XB_XGEN(b.x)], 1u);
            asm volatile("s_waitcnt vmcnt(0)" ::: "memory");
        } else {
            XB_SPIN(xb_ld(&bar[XB_XGEN(b.x)]) == gen, bar);
            __builtin_amdgcn_fence(__ATOMIC_ACQUIRE, "agent");
            asm volatile("s_waitcnt vmcnt(0)" ::: "memory");
        }
    }
    __syncthreads();
}
constexpr int NWAVES = 8;
constexpr int BATCH = 8, SEQ = 2048, DM = 1024, M = BATCH * SEQ, DEPTH = 2, NH = 8, HD = 64, AW = 512, CW = 512, CK = 31;
constexpr int NGRP = 4, EPG = 8, NEXP = 32, FF = 512, PLE = 256, WIN = 4608;
constexpr float EPS = 1e-6f;
constexpr float QSCALE = 0.125f * 1.4426950408889634f;
constexpr int MAXROWS = 2 * M + NEXP * 256;
constexpr size_t MiB = 1u << 20;
constexpr size_t WS_CTL = 0, CTL_ZERO_BYTES = 2 * MiB;
constexpr size_t WS_COS = 2 * MiB, WS_SIN = 2 * MiB + 256 * 1024;
constexpr size_t WS_SSQ = 3 * MiB;
constexpr size_t WS_ROUTE = 10 * MiB, WS_POS = 10 * MiB + 512 * 1024, WS_RSC = 11 * MiB, WS_ROWG = 11 * MiB + 256 * 1024;
constexpr size_t WS_WR = 12 * MiB;
constexpr size_t WS_RB = 13 * MiB;
constexpr size_t WS_LG = 352 * MiB;
constexpr size_t WS_W = 16 * MiB, W_LAYER = 112 * MiB;
constexpr size_t WO_WIN = 0, WO_WAO = 9 * MiB, WO_WCO = 10 * MiB, WO_WOUT = 11 * MiB, WO_WPG = 13 * MiB, WO_WPP = 15 * MiB, WO_WGU = 16 * MiB, WO_WD = 80 * MiB;
constexpr size_t WS_XB = 240 * MiB, WS_PB = 272 * MiB, WS_PE = 288 * MiB, WS_MG = 320 * MiB;
constexpr size_t WS_Q = 352 * MiB, WS_K = 368 * MiB, WS_V = 384 * MiB, WS_U = 400 * MiB, WS_SGA = 416 * MiB, WS_SGB = 448 * MiB, WS_OC = 480 * MiB;
constexpr size_t WS_XG = 352 * MiB, WS_H = 432 * MiB, WS_Y = 352 * MiB, WS_END = 512 * MiB;
constexpr int CW_TMO = 0, CW_CODE = 1, CW_BAR = 4096, CW_CNT = 16384;
constexpr int RING_OFF = 0, RING_BYTES = 131072;
constexpr int LDSCTL_OFF = RING_BYTES, MISC_OFF = LDSCTL_OFF + 320, OFFS_OFF = LDSCTL_OFF + 1024;
constexpr int LDS_BYTES = 147456;
constexpr int PH_PER_LAYER = 10, PH_FINAL = 1 + DEPTH * PH_PER_LAYER, N_PHASES = PH_FINAL + 1;

struct Frame {
    LAS unsigned char* lds;
    volatile LAS unsigned* MISC;
    gu32* ctl;
    int tid, lane, wave, vcu, G;
    float* out; unsigned char* ws;
};
#define XCUR(L) ((L) == 0 ? WSP(bf16, WS_XB) : (bf16*)F.out)
#define XNXT(L) ((L) == 0 ? (bf16*)F.out : WSP(bf16, WS_XB))
struct Args { const float* in[24]; float* out; unsigned char* ws; int ph_lo, ph_hi, use_bar, pad; };
#define WSP(T, off) ((T*)(F.ws + (off)))

__device__ __forceinline__ void transpose_item(const float* W, int ld, int colA, int colB, const float* gain, int k0, bf16* WT, int K, int row0, LAS float* scr, int lane, int kd = 0) {
    const int kl = lane >> 4, n4 = lane & 15;
    const float* src = W + (size_t)(k0 + kl) * ld + (n4 < 8 ? colA + 4 * n4 : colB + 4 * (n4 - 8));
    f32x4 v[16];
#pragma unroll
    for (int q = 0; q < 16; ++q) v[q] = *(const GAS f32x4*)(src + (size_t)(4 * q) * ld);
#pragma unroll
    for (int q = 0; q < 16; ++q) { const int k = 4 * q + kl; if (gain) v[q] = v[q] * gain[k0 + k]; *(LAS f32x4*)(scr + k * 64 + ((4 * n4) ^ (((k >> 3) & 7) << 3))) = v[q]; }
    LDS_WAIT(); asm volatile("" ::: "memory");
    const int c = lane & 7;
#pragma unroll
    for (int j = 0; j < 8; ++j) { const int n = (lane >> 3) + 8 * j; const LAS float* s = scr + (8 * c) * 64 + (n ^ (c << 3));
        v4u o; o.x = cvt_pk_bf16(s[0 * 64], s[1 * 64]); o.y = cvt_pk_bf16(s[2 * 64], s[3 * 64]); o.z = cvt_pk_bf16(s[4 * 64], s[5 * 64]); o.w = cvt_pk_bf16(s[6 * 64], s[7 * 64]);
        *(GAS v4u*)(WT + (size_t)(row0 + n) * K + kd + k0 + 8 * c) = o; }
    LDS_WAIT(); asm volatile("" ::: "memory");
}
__device__ __forceinline__ int win_src_col(int g) {
    const int pn = g >> 3, sub = g & 7;
    if (pn < 2) return 64 * (4 * pn + (sub & 3)) + 32 * (sub >> 2);
    if (pn < 4) return 512 + 64 * (4 * (pn - 2) + (sub & 3)) + 32 * (sub >> 2);
    if (pn < 6) return 1024 + 256 * (pn - 4) + 32 * sub;
    if (pn < 10) return (sub < 4 ? 1536 : 2048) + 128 * (pn - 6) + 32 * (sub & 3);
    return 2560 + 256 * (pn - 10) + 32 * sub;
}
constexpr int IT_WIN = 72 * 16, IT_WAO = 16 * 8, IT_WCO = 16 * 8, IT_WOUT = 16 * 16, IT_WPG = 16 * 16, IT_WPP = 16 * 4, IT_WGU = 512 * 16, IT_WD = 512 * 8;
constexpr int IT_LAYER = IT_WIN + IT_WAO + IT_WCO + IT_WOUT + IT_WPG + IT_WPP + IT_WGU + IT_WD;
__device__ __forceinline__ void conv_item(Frame& F, const Args& args, int L, int it, LAS float* scr) {
    unsigned char* wl = F.ws + WS_W + (size_t)L * W_LAYER; const int lane = F.lane;
    int r = it;
    if (r < IT_WIN) { const int gp = r >> 4, kb = r & 15; transpose_item(args.in[3] + (size_t)L * DM * WIN, WIN, win_src_col(2 * gp), win_src_col(2 * gp + 1), args.in[2] + L * DM, 64 * kb, (bf16*)(wl + WO_WIN), 1024, 64 * gp, scr, lane); return; } r -= IT_WIN;
    if (r < IT_WAO) { const int gp = r >> 3, kb = r & 7; transpose_item(args.in[8] + (size_t)L * 512 * DM, DM, 64 * gp, 64 * gp + 32, nullptr, 64 * kb, (bf16*)(wl + WO_WAO), 1024, 64 * gp, scr, lane, 0); return; } r -= IT_WAO;
    if (r < IT_WCO) { const int gp = r >> 3, kb = r & 7; transpose_item(args.in[9] + (size_t)L * 512 * DM, DM, 64 * gp, 64 * gp + 32, nullptr, 64 * kb, (bf16*)(wl + WO_WAO), 1024, 64 * gp, scr, lane, 512); return; } r -= IT_WCO;
    if (r < IT_WOUT) { const int gp = r >> 4, kb = r & 15; transpose_item(args.in[11] + (size_t)L * DM * DM, DM, 64 * gp, 64 * gp + 32, nullptr, 64 * kb, (bf16*)(wl + WO_WOUT), 1024, 64 * gp, scr, lane); return; } r -= IT_WOUT;
    if (r < IT_WPG) { const int gp = r >> 4, kb = r & 15; transpose_item(args.in[22] + (size_t)L * DM * DM, DM, 64 * gp, 64 * gp + 32, args.in[20] + L * DM, 64 * kb, (bf16*)(wl + WO_WPG), 1024, 64 * gp, scr, lane); return; } r -= IT_WPG;
    if (r < IT_WPP) { const int gp = r >> 2, kb = r & 3; transpose_item(args.in[21] + (size_t)L * PLE * DM, DM, 64 * gp, 64 * gp + 32, nullptr, 64 * kb, (bf16*)(wl + WO_WPP), 256, 64 * gp, scr, lane); return; } r -= IT_WPP;
    if (r < IT_WGU) { const int gp = r >> 4, kb = r & 15, e = gp >> 4, gl = gp & 15, tile = gl >> 2, sub = gl & 3;
        const float* src = (sub < 2 ? args.in[17] : args.in[18]) + ((size_t)L * NEXP + e) * DM * FF; const int col = 128 * tile + 64 * (sub & 1);
        transpose_item(src, FF, col, col + 32, args.in[12] + L * DM, 64 * kb, (bf16*)(wl + WO_WGU), 1024, 64 * gp, scr, lane); return; } r -= IT_WGU;
    { const int gp = r >> 3, kb = r & 7, e = gp >> 4, gl = gp & 15;
        transpose_item(args.in[19] + ((size_t)L * NEXP + e) * FF * DM, DM, 64 * gl, 64 * gl + 32, nullptr, 64 * kb, (bf16*)(wl + WO_WD), 512, 64 * gp, scr, lane); }
}
__device__ __forceinline__ void p0_prologue(Frame& F, const Args& args) {
    LAS float* scr = (LAS float*)(F.lds + RING_OFF + F.wave * 16384);
    const int gw = F.vcu * NWAVES + F.wave, NGW = F.G * NWAVES, lane = F.lane;
    const int gt = (F.vcu * NWAVES + F.wave) * 64 + lane, NGT = NGW * 64;
    { bf16* XB = WSP(bf16, WS_XB); float* SSQ = WSP(float, WS_SSQ);
      for (int m = gw; m < M; m += NGW) {
          const GAS f32x4* xr = (const GAS f32x4*)(args.in[0] + (size_t)m * DM) + lane; float s = 0.f; GAS v2u* o8 = (GAS v2u*)(XB + (size_t)m * DM) + lane;
#pragma unroll
          for (int j = 0; j < 4; ++j) { const f32x4 v = xr[64 * j]; s += (v[0] * v[0] + v[1] * v[1]) + (v[2] * v[2] + v[3] * v[3]); v2u w; w.x = cvt_pk_bf16(v[0], v[1]); w.y = cvt_pk_bf16(v[2], v[3]); o8[64 * j] = w; }
          const float tot = wave_sum(s);
          if (lane < 16) SSQ[(size_t)m * 16 + lane] = lane == 0 ? tot : 0.f;
      } }
    { const GAS f32x4* ps = (const GAS f32x4*)args.in[1]; GAS v4u* pb = (GAS v4u*)WSP(bf16, WS_PB);
      for (int i = gt; i < DEPTH * M * PLE / 8; i += NGT) { const f32x4 a = ps[2 * i], b = ps[2 * i + 1]; pb[i] = pack8(a, b); } }
    { float* ct = WSP(float, WS_COS); float* st = WSP(float, WS_SIN);
      for (int i = gt; i < SEQ * 32; i += NGT) { const int pos = i >> 5, k = i & 31; const float inv = powf(10000.0f, -(float)(2 * k) / 64.0f); const float ang = (float)pos * inv; ct[i] = cosf(ang); st[i] = sinf(ang); } }
    { bf16* wr = WSP(bf16, WS_WR);
      for (int i = gt; i < DEPTH * 256 * DM; i += NGT) { const int L = i >> 18, j = (i >> 10) & 255, k = i & 1023; float v = 0.f;
          if (j < 4) v = args.in[13][((size_t)L * DM + k) * NGRP + j]; else if (j < 36) v = args.in[15][((size_t)L * DM + k) * NEXP + (j - 4)];
          if (j < 36) v *= args.in[12][L * DM + k];
          wr[i] = (bf16)(cvt_pk_bf16(v, 0.f) & 0xffffu); }
      float* rb = WSP(float, WS_RB);
      for (int i = gt; i < DEPTH * 64; i += NGT) { const int L = i >> 6, j = i & 63; rb[i] = j < 4 ? args.in[14][L * NGRP + j] : (j < 36 ? args.in[16][L * NEXP + j - 4] : 0.f); } }
    for (int it = gw; it < DEPTH * IT_LAYER; it += NGW) { const int L = it >= IT_LAYER ? 1 : 0; conv_item(F, args, L, it - L * IT_LAYER, scr); }
}

struct SchedGrid {
    int nM, nN, G, c; const char* Ab; const char* Bb; size_t astep, bstep;
    __device__ __forceinline__ bool next(int i, pg8::Unit& u) const {
        const int L = i * G + c; if (L >= nM * nN) return false;
        pg8::tile_of(L, nM, nN, u.pm, u.pn); u.aux = 0; u.A = Ab + (size_t)u.pm * astep; u.B = Bb + (size_t)u.pn * bstep; return true; }
};
struct SchedP3 {
    int G, c; const char* OC; const char* Wa; const char* Wc;
    __device__ __forceinline__ bool next(int i, pg8::Unit& u) const {
        const int T = (i >> 1) * G + c; if (T >= 256) return false;
        pg8::tile_of(T, 64, 4, u.pm, u.pn); u.aux = i & 1;
        u.A = OC + (size_t)u.pm * (256 * 1024 * 2) + (u.aux ? 512 * 2 : 0); u.B = (u.aux ? Wc : Wa) + (size_t)u.pn * (256 * 512 * 2); return true; }
};
struct SchedMoe {
    const volatile LAS int* offs; int G, c, up; const char* Ab; const char* Bb;
    __device__ __forceinline__ bool next(int i, pg8::Unit& u) const {
        const int NB = offs[32] >> 8, L = i * G + c; if (L >= NB * 4) return false;
        const int mb = L >> 2, pn = L & 3; int e = 0;
        while (e < 31 && offs[e + 1] <= mb * 256) ++e;
        u.pm = mb; u.pn = pn; u.aux = e;
        if (up) { u.A = Ab + (size_t)mb * (256 * 1024 * 2); u.B = Bb + ((size_t)e * 1024 + pn * 256) * (1024 * 2); }
        else    { u.A = Ab + (size_t)mb * (256 * 512 * 2);  u.B = Bb + ((size_t)e * 1024 + pn * 256) * (512 * 2); }
        return true; }
};

using pg8::f32x4;
#define EPI_FOR_ROWS _Pragma("unroll") for (int ai = 0; ai < 2; ++ai) _Pragma("unroll") for (int m = 0; m < 4; ++m)
#define EPI_ROW (u.pm * 256 + ai * 128 + wr * 64 + m * 16 + fr)
__device__ __forceinline__ float rscale_of(const float* ssq, int row) {
    const f32x4* sp = (const f32x4*)(ssq + (size_t)row * 16); const f32x4 a = sp[0], b = sp[1], c = sp[2], d = sp[3];
    const float s = ((a[0] + a[1]) + (a[2] + a[3])) + ((b[0] + b[1]) + (b[2] + b[3])) + ((c[0] + c[1]) + (c[2] + c[3])) + ((d[0] + d[1]) + (d[2] + d[3]));
    return rsqrtf(s * (1.0f / DM) + EPS);
}
struct EpiP1 {
    static constexpr bool PERM = true, MIDK = false;
    const float* ssq; const float* cosT; const float* sinT; bf16 *Q, *K, *V, *U, *SGA, *SGB;
    __device__ __forceinline__ void operator()(const f32x4 (&acc)[2][2][4][2], const pg8::Unit& u, int wr, int wc, int fr, int fq) const {
        const int pn = u.pn;
        EPI_FOR_ROWS { const int row = EPI_ROW;
            const float r = rscale_of(ssq, row); const int b = row >> 11, t = row & 2047;
            if (pn < 4) {
                const int head = 4 * (pn & 1) + wc; const float qs = pn < 2 ? QSCALE : 1.0f;
                const f32x4* cp = (const f32x4*)(cosT + t * 32 + 8 * fq); const f32x4* sp = (const f32x4*)(sinT + t * 32 + 8 * fq);
                f32x4 o1[2], o2[2];
#pragma unroll
                for (int n = 0; n < 2; ++n) { const f32x4 c = cp[n], s = sp[n], t1 = acc[ai][0][m][n] * (r * qs), t2 = acc[ai][1][m][n] * (r * qs); o1[n] = t1 * c - t2 * s; o2[n] = t1 * s + t2 * c; }
                bf16* dst = (pn < 2 ? Q : K) + ((size_t)(b * NH + head) * SEQ + t) * HD + 8 * fq;
                *(v4u*)dst = pack8(o1[0], o1[1]); *(v4u*)(dst + 32) = pack8(o2[0], o2[1]);
            } else if (pn < 6) {
#pragma unroll
                for (int bj = 0; bj < 2; ++bj) { const int head = 4 * (pn - 4) + 2 * bj + (wc >> 1), dim = 32 * (wc & 1) + 8 * fq;
                    *(v4u*)(V + ((size_t)(b * NH + head) * SEQ + t) * HD + dim) = pack8(acc[ai][bj][m][0] * r, acc[ai][bj][m][1] * r); }
            } else if (pn < 10) {
                f32x4 o[2];
#pragma unroll
                for (int n = 0; n < 2; ++n) o[n] = (acc[ai][0][m][n] * r) * sigm4(acc[ai][1][m][n] * r);
                *(v4u*)(U + (size_t)row * CW + 128 * (pn - 6) + 32 * wc + 8 * fq) = pack8(o[0], o[1]);
            } else {
                bf16* base = (pn < 14 ? SGA + 256 * (pn - 10) : SGB + 256 * (pn - 14)) + (size_t)row * DM + 32 * wc + 8 * fq;
#pragma unroll
                for (int bj = 0; bj < 2; ++bj) *(v4u*)(base + 128 * bj) = pack8(sigm4(acc[ai][bj][m][0] * r), sigm4(acc[ai][bj][m][1] * r));
            }
        }
    }
};
struct EpiP3 {
    static constexpr bool PERM = true, MIDK = true;
    const bf16* SGA; const bf16* SGB; const float* bco; bf16* MG;
    __device__ __forceinline__ void mid(f32x4 (&acc)[2][2][4][2], const pg8::Unit& u, int wr, int wc, int fr, int fq) const {
        int z_ = 0; asm volatile("" : "+v"(z_));
#pragma unroll
        for (int ai = 0; ai < 2; ++ai)
#pragma unroll
            for (int m = 0; m < 4; ++m) { const int row = EPI_ROW + z_;
                v4u a[2], b[2];
#pragma unroll
                for (int bj = 0; bj < 2; ++bj) { const size_t off = (size_t)row * DM + u.pn * 256 + 128 * bj + 32 * wc + 8 * fq; a[bj] = *(const v4u*)(SGA + off); b[bj] = *(const v4u*)(SGB + off); }
#pragma unroll
                for (int bj = 0; bj < 2; ++bj) {
                    acc[ai][bj][m][0][0] *= bf_lo(a[bj].x) * __builtin_amdgcn_rcpf(bf_lo(b[bj].x)); acc[ai][bj][m][0][1] *= bf_hi(a[bj].x) * __builtin_amdgcn_rcpf(bf_hi(b[bj].x));
                    acc[ai][bj][m][0][2] *= bf_lo(a[bj].y) * __builtin_amdgcn_rcpf(bf_lo(b[bj].y)); acc[ai][bj][m][0][3] *= bf_hi(a[bj].y) * __builtin_amdgcn_rcpf(bf_hi(b[bj].y));
                    acc[ai][bj][m][1][0] *= bf_lo(a[bj].z) * __builtin_amdgcn_rcpf(bf_lo(b[bj].z)); acc[ai][bj][m][1][1] *= bf_hi(a[bj].z) * __builtin_amdgcn_rcpf(bf_hi(b[bj].z));
                    acc[ai][bj][m][1][2] *= bf_lo(a[bj].w) * __builtin_amdgcn_rcpf(bf_lo(b[bj].w)); acc[ai][bj][m][1][3] *= bf_hi(a[bj].w) * __builtin_amdgcn_rcpf(bf_hi(b[bj].w)); }
                if (m & 1) asm volatile("" ::: "memory");
            }
    }
    __device__ __forceinline__ void operator()(const f32x4 (&acc)[2][2][4][2], const pg8::Unit& u, int wr, int wc, int fr, int fq) const {
        EPI_FOR_ROWS { const int row = EPI_ROW;
#pragma unroll
            for (int bj = 0; bj < 2; ++bj) { const int col = u.pn * 256 + 128 * bj + 32 * wc + 8 * fq; const size_t off = (size_t)row * DM + col;
                f32x4 g0, g1; unpack8(*(const v4u*)(SGB + off), g0, g1);
                const f32x4 b0 = *(const f32x4*)(bco + col), b1 = *(const f32x4*)(bco + col + 4);
                *(v4u*)(MG + off) = pack8(g0 * (acc[ai][bj][m][0] + b0), g1 * (acc[ai][bj][m][1] + b1)); }
        }
    }
};
#define RESID_STORE(DELTA0, DELTA1) { f32x4 x0, x1; unpack8(*(const v4u*)(XI + off), x0, x1); const f32x4 v0 = x0 + (DELTA0), v1 = x1 + (DELTA1); \
        *(v4u*)(XO + off) = pack8(v0, v1); \
        ss += ((v0[0] * v0[0] + v0[1] * v0[1]) + (v0[2] * v0[2] + v0[3] * v0[3])) + ((v1[0] * v1[0] + v1[1] * v1[1]) + (v1[2] * v1[2] + v1[3] * v1[3])); }
#define SSQ_STORE() { ss += __shfl_xor(ss, 16); ss += __shfl_xor(ss, 32); if (fq == 0) ssq_out[(size_t)row * 16 + u.pn * 4 + wc] = ss; }
struct EpiP4 {
    static constexpr bool PERM = true, MIDK = false;
    const bf16* XI; bf16* XO; float* ssq_out;
    __device__ __forceinline__ void operator()(const f32x4 (&acc)[2][2][4][2], const pg8::Unit& u, int wr, int wc, int fr, int fq) const {
        EPI_FOR_ROWS { const int row = EPI_ROW;
            float ss = 0.f;
#pragma unroll
            for (int bj = 0; bj < 2; ++bj) { const size_t off = (size_t)row * DM + u.pn * 256 + 128 * bj + 32 * wc + 8 * fq; RESID_STORE(acc[ai][bj][m][0], acc[ai][bj][m][1]) }
            SSQ_STORE()
        }
    }
};
struct EpiP8 {
    static constexpr bool PERM = true, MIDK = false;
    const float* ssq_in; const bf16* PE; const bf16* XI; bf16* XO; float* ssq_out;
    __device__ __forceinline__ void operator()(const f32x4 (&acc)[2][2][4][2], const pg8::Unit& u, int wr, int wc, int fr, int fq) const {
        EPI_FOR_ROWS { const int row = EPI_ROW;
            const float r = rscale_of(ssq_in, row); float ss = 0.f;
#pragma unroll
            for (int bj = 0; bj < 2; ++bj) { const size_t off = (size_t)row * DM + u.pn * 256 + 128 * bj + 32 * wc + 8 * fq;
                f32x4 p0, p1; unpack8(*(const v4u*)(PE + off), p0, p1);
                RESID_STORE(sigm4(acc[ai][bj][m][0] * r) * p0, sigm4(acc[ai][bj][m][1] * r) * p1) }
            SSQ_STORE()
        }
    }
};
struct EpiBf16 {
    static constexpr bool PERM = true, MIDK = false;
    bf16* O; int ldc;
    __device__ __forceinline__ void operator()(const f32x4 (&acc)[2][2][4][2], const pg8::Unit& u, int wr, int wc, int fr, int fq) const {
        EPI_FOR_ROWS { const int row = EPI_ROW;
#pragma unroll
            for (int bj = 0; bj < 2; ++bj) *(v4u*)(O + (size_t)row * ldc + u.pn * 256 + 128 * bj + 32 * wc + 8 * fq) = pack8(acc[ai][bj][m][0], acc[ai][bj][m][1]);
        }
    }
};
struct EpiUp {
    static constexpr bool PERM = true, MIDK = false;
    const float* RSC; bf16* H;
    __device__ __forceinline__ void operator()(const f32x4 (&acc)[2][2][4][2], const pg8::Unit& u, int wr, int wc, int fr, int fq) const {
        EPI_FOR_ROWS { const int row = EPI_ROW;
            const float r = RSC[row]; f32x4 o[2];
#pragma unroll
            for (int n = 0; n < 2; ++n) { const f32x4 g = acc[ai][0][m][n] * r; o[n] = g * sigm4(g) * (acc[ai][1][m][n] * r); }
            *(v4u*)(H + (size_t)row * FF + 128 * u.pn + 32 * wc + 8 * fq) = pack8(o[0], o[1]);
        }
    }
};
struct EpiDown {
    static constexpr bool PERM = true, MIDK = false;
    const float* ROWG; bf16* Y;
    __device__ __forceinline__ void operator()(const f32x4 (&acc)[2][2][4][2], const pg8::Unit& u, int wr, int wc, int fr, int fq) const {
        EPI_FOR_ROWS { const int row = EPI_ROW;
            const float gt = ROWG[row];
#pragma unroll
            for (int bj = 0; bj < 2; ++bj) *(v4u*)(Y + (size_t)row * DM + u.pn * 256 + 128 * bj + 32 * wc + 8 * fq) = pack8(acc[ai][bj][m][0] * gt, acc[ai][bj][m][1] * gt);
        }
    }
};


struct EpiRoute {
    static constexpr bool PERM = true, MIDK = false;
    const float* ssq; const float* bias; float* LG;
    __device__ __forceinline__ void operator()(const f32x4 (&acc)[2][2][4][2], const pg8::Unit& u, int wr, int wc, int fr, int fq) const {
        if (wc < 2) {
            const f32x4 b0 = *(const f32x4*)(bias + 32 * wc + 8 * fq), b1 = *(const f32x4*)(bias + 32 * wc + 8 * fq + 4);
            EPI_FOR_ROWS { const int row = EPI_ROW; const float r = rscale_of(ssq, row);
                float* dst = LG + (size_t)row * 64 + 32 * wc + 8 * fq;
                *(f32x4*)dst = acc[ai][0][m][0] * r + b0; *(f32x4*)(dst + 4) = acc[ai][0][m][1] * r + b1; }
        }
    }
};
__device__ __forceinline__ void route_decide(Frame& F, int L, int pm) {
    if (F.tid < 256) {
        const int t = pm * 256 + F.tid;
        const float* lp = WSP(float, WS_LG) + (size_t)t * 64; const float* SSQ = WSP(float, WS_SSQ + (size_t)(3 * L + 1) * MiB);
        int* ROUTE = WSP(int, WS_ROUTE); unsigned* cnt = (unsigned*)(F.ctl + CW_CNT + 64 * L);
        const f32x4 g4 = *(const f32x4*)lp;
        float mxv = g4[0]; int gs = 0;
#pragma unroll
        for (int i = 1; i < 4; ++i) if (g4[i] > mxv) { mxv = g4[i]; gs = i; }
        float se = 0.f;
#pragma unroll
        for (int i = 0; i < 4; ++i) se += __expf(g4[i] - mxv);
        const float pg = 1.0f / se;
        const f32x4 e0 = *(const f32x4*)(lp + 4 + gs * 8), e1 = *(const f32x4*)(lp + 8 + gs * 8);
        float v1 = -1e30f, v2 = -1e30f; int i1 = 0, i2 = 0;
#pragma unroll
        for (int i = 0; i < 8; ++i) { const float v = i < 4 ? e0[i] : e1[i - 4]; if (v > v1) { v2 = v1; i2 = i1; v1 = v; i1 = i; } else if (v > v2) { v2 = v; i2 = i; } }
        const float e2 = __expf(v2 - v1), s1 = 1.0f / (1.0f + e2);
        const int ea = gs * 8 + i1, eb = gs * 8 + i2;
        const unsigned ia = atomicAdd(cnt + ea, 1u), ib = atomicAdd(cnt + eb, 1u);
        v4u r0, r1; r0.x = (unsigned)ea; r0.y = (unsigned)eb; r0.z = ia; r0.w = ib; r1.x = __float_as_uint(pg * s1); r1.y = __float_as_uint(pg * e2 * s1); r1.z = __float_as_uint(rscale_of(SSQ, t)); r1.w = 0u;
        *(GAS v4u*)(ROUTE + (size_t)t * 8) = r0; *(GAS v4u*)(ROUTE + (size_t)t * 8 + 4) = r1;
    }
}

__device__ __forceinline__ void attn_simple(Frame& F) {
    const bf16* Q = WSP(bf16, WS_Q); const bf16* Kb = WSP(bf16, WS_K); const bf16* Vb = WSP(bf16, WS_V); bf16* OC = WSP(bf16, WS_OC);
    const int lane = F.lane;
    for (int unit = F.vcu * NWAVES + F.wave; unit < BATCH * NH * (SEQ / 64); unit += F.G * NWAVES) {
        const int bh = unit >> 5, t = ((unit & 31) << 6) + lane;
        unsigned qw[32];
        { const GAS v4u* qp = (const GAS v4u*)(Q + ((size_t)bh * SEQ + t) * HD);
#pragma unroll
          for (int i = 0; i < 8; ++i) { const v4u w = qp[i]; qw[4 * i] = w.x; qw[4 * i + 1] = w.y; qw[4 * i + 2] = w.z; qw[4 * i + 3] = w.w; } }
        float o[64];
#pragma unroll
        for (int i = 0; i < 64; ++i) o[i] = 0.f;
        float mx = -1e30f, l = 0.f;
        for (int g = 0; g < 3; ++g) {
            const int d = g == 0 ? 1 : (g == 1 ? 4 : 16);
            for (int j0 = 0; j0 <= 128; j0 += 4) {
                if (!__any(t - j0 * d >= 0)) break;
                float s[4]; int pc[4];
#pragma unroll
                for (int c = 0; c < 4; ++c) { const int j = j0 + c, pos = t - j * d; const bool valid = pos >= 0 && j <= 128; pc[c] = valid ? pos : t;
                    const GAS v4u* kp = (const GAS v4u*)(Kb + ((size_t)bh * SEQ + pc[c]) * HD); float a = 0.f;
#pragma unroll
                    for (int i = 0; i < 8; ++i) { const v4u w = kp[i]; a = dot2bf(qw[4 * i], w.x, a); a = dot2bf(qw[4 * i + 1], w.y, a); a = dot2bf(qw[4 * i + 2], w.z, a); a = dot2bf(qw[4 * i + 3], w.w, a); }
                    s[c] = valid ? a : -1e30f; }
                const float mc = fmaxf(fmaxf(s[0], s[1]), fmaxf(s[2], s[3])), mn = fmaxf(mx, mc), sc = __builtin_amdgcn_exp2f(mx - mn);
                l *= sc;
#pragma unroll
                for (int i = 0; i < 64; ++i) o[i] *= sc;
                mx = mn;
#pragma unroll
                for (int c = 0; c < 4; ++c) { const float p = __builtin_amdgcn_exp2f(s[c] - mn); l += p;
                    const GAS v4u* vp = (const GAS v4u*)(Vb + ((size_t)bh * SEQ + pc[c]) * HD);
#pragma unroll
                    for (int i = 0; i < 8; ++i) { const v4u w = vp[i];
                        o[8 * i + 0] += p * bf_lo(w.x); o[8 * i + 1] += p * bf_hi(w.x); o[8 * i + 2] += p * bf_lo(w.y); o[8 * i + 3] += p * bf_hi(w.y);
                        o[8 * i + 4] += p * bf_lo(w.z); o[8 * i + 5] += p * bf_hi(w.z); o[8 * i + 6] += p * bf_lo(w.w); o[8 * i + 7] += p * bf_hi(w.w); } }
            }
        }
        const float inv = 1.0f / l; const int b = bh >> 3, h = bh & 7;
        GAS v4u* op = (GAS v4u*)(OC + ((size_t)(b * SEQ + t)) * DM + h * HD);
#pragma unroll
        for (int i = 0; i < 8; ++i) { v4u w; w.x = cvt_pk_bf16(o[8 * i] * inv, o[8 * i + 1] * inv); w.y = cvt_pk_bf16(o[8 * i + 2] * inv, o[8 * i + 3] * inv); w.z = cvt_pk_bf16(o[8 * i + 4] * inv, o[8 * i + 5] * inv); w.w = cvt_pk_bf16(o[8 * i + 6] * inv, o[8 * i + 7] * inv); op[i] = w; }
    }
}

typedef float f32x16 __attribute__((ext_vector_type(16)));
typedef short v4i16_t __attribute__((ext_vector_type(4)));
struct AttnStep { int p0, st, mode, T; };
__device__ __forceinline__ void attn_desc(int idx, int qb, int c, int i, int hi, int n1, int n0, int nb2, AttnStep& d) {
    if (idx < n1) { const int kb = qb - idx; d.p0 = 128 * kb + c; d.st = 4; d.mode = (idx == 0) ? 2 : ((idx == 4) ? 1 : 0); d.T = i - 4 * hi; }
    else if (idx < n1 + n0) { const int kb = (qb ? 0 : 4) + (idx - n1); d.st = 1;
        if (kb < 4) { d.p0 = 128 * (qb - 1) + 32 * kb; d.mode = 1; d.T = 4 * i + c - 32 * kb - 4 * hi; }
        else { d.p0 = 128 * qb + 32 * (kb - 4); d.mode = 2; d.T = 4 * i + c - 32 * (kb - 4) - 4 * hi; } }
    else { const int e = idx - n1 - n0, a = e / nb2, kb = e - a * nb2; d.p0 = 512 * kb + 4 * a + c; d.st = 16; d.mode = 2; d.T = ((i & 3) == a) ? (8 * qb + (i >> 2) - 32 * kb - 4 * hi) : -100; }
}
__device__ __forceinline__ void attn_dma(LAS unsigned char* slot, const bf16* Kh, const bf16* Vh, int p0, int st, int lane) {
    const int rl = lane >> 3, pos = lane & 7;
#pragma unroll
    for (int pc = 0; pc < 4; ++pc) {
        const int row = 8 * pc + rl; const size_t rowoff = (size_t)(p0 + st * row) * HD;
        const int chk = pos ^ ((row >> 1) & 7);
        const int chv = (((pos >> 1) ^ (((row >> 1) & 1) << 1)) << 1) | (pos & 1);
        __builtin_amdgcn_global_load_lds((const unsigned*)(Kh + rowoff + chk * 8), (LAS unsigned*)(slot + pc * 1024), 16, 0, 0);
        __builtin_amdgcn_global_load_lds((const unsigned*)(Vh + rowoff + chv * 8), (LAS unsigned*)(slot + 4096 + pc * 1024), 16, 0, 0);
    }
}
__device__ __forceinline__ void attn_mfma(Frame& F) {
    const bf16* Q = WSP(bf16, WS_Q); const bf16* Kb = WSP(bf16, WS_K); const bf16* Vb = WSP(bf16, WS_V); bf16* OC = WSP(bf16, WS_OC);
    const int lane = F.lane, i = lane & 31, hi = lane >> 5;
    LAS unsigned char* ring = F.lds + RING_OFF + F.wave * 16384;
    int koff[4];
#pragma unroll
    for (int s = 0; s < 4; ++s) koff[s] = i * 128 + (((2 * s + hi) ^ ((i >> 1) & 7)) << 4);
    const int g2 = (lane >> 4) & 1, q4 = (lane & 15) >> 2, p4 = lane & 3;
    int voff[2][2];
#pragma unroll
    for (int s = 0; s < 2; ++s)
#pragma unroll
        for (int db = 0; db < 2; ++db) { const int row = 16 * s + 4 * hi + q4; voff[s][db] = 4096 + row * 128 + (((2 * db + g2) ^ (((row >> 1) & 1) << 1)) << 5) + p4 * 8; }
    for (int pass = 0; pass < 2; ++pass) {
        const int gw = F.vcu * NWAVES + F.wave;
        const int T = pass == 0 ? gw : (BATCH * NH * 4 * 16 - 1 - gw);
        if (gw >= BATCH * NH * 4 * 16 / 2) break;
        const int qb = T & 15, c = (T >> 4) & 3, bh = T >> 6;
        const bf16* Kh = Kb + (size_t)bh * SEQ * HD; const bf16* Vh = Vb + (size_t)bh * SEQ * HD;
        const int tq = 128 * qb + 4 * i + c;
        bf16x8 qf[4];
        { const GAS bf16x8* qp = (const GAS bf16x8*)(Q + ((size_t)bh * SEQ + tq) * HD + 8 * hi);
#pragma unroll
          for (int s = 0; s < 4; ++s) qf[s] = qp[2 * s]; }
        const int n1 = (qb < 4 ? qb : 4) + 1, n0 = qb ? 8 : 4, nb2 = (qb >> 2) + 1, nsteps = n1 + n0 + 4 * nb2;
        f32x16 o0, o1;
#pragma unroll
        for (int r = 0; r < 16; ++r) { o0[r] = 0.f; o1[r] = 0.f; }
        float mrun = -1e30f, lrun = 0.f;
        AttnStep cur; attn_desc(0, qb, c, i, hi, n1, n0, nb2, cur);
        attn_dma(ring, Kh, Vh, cur.p0, cur.st, lane);
        for (int idx = 0; idx < nsteps; ++idx) {
            LAS unsigned char* slot = ring + (idx & 1) * 8192;
            AttnStep nxt = cur;
            if (idx + 1 < nsteps) { attn_desc(idx + 1, qb, c, i, hi, n1, n0, nb2, nxt); attn_dma(ring + ((idx + 1) & 1) * 8192, Kh, Vh, nxt.p0, nxt.st, lane); asm volatile("s_waitcnt vmcnt(8)" ::: "memory"); }
            else { asm volatile("s_waitcnt vmcnt(0)" ::: "memory"); }
            f32x16 sacc;
#pragma unroll
            for (int r = 0; r < 16; ++r) sacc[r] = 0.f;
#pragma unroll
            for (int s = 0; s < 4; ++s) { const bf16x8 kf = *(const LAS bf16x8*)(slot + koff[s]); sacc = __builtin_amdgcn_mfma_f32_32x32x16_bf16(kf, qf[s], sacc, 0, 0, 0); }
            if (cur.mode == 1) {
#pragma unroll
                for (int r = 0; r < 16; ++r) sacc[r] = ((r & 3) + 8 * (r >> 2) >= cur.T) ? sacc[r] : -1e30f;
            } else if (cur.mode == 2) {
#pragma unroll
                for (int r = 0; r < 16; ++r) sacc[r] = ((r & 3) + 8 * (r >> 2) <= cur.T) ? sacc[r] : -1e30f;
            }
            float mloc = sacc[0];
#pragma unroll
            for (int r = 1; r < 16; ++r) mloc = fmaxf(mloc, sacc[r]);
            { auto rr = __builtin_amdgcn_permlane32_swap(__float_as_uint(mloc), __float_as_uint(mloc), false, false); mloc = fmaxf(__uint_as_float(rr[0]), __uint_as_float(rr[1])); }
            const float mnew = fmaxf(mrun, mloc), alpha = __builtin_amdgcn_exp2f(mrun - mnew);
            mrun = mnew;
            float psum = 0.f;
#pragma unroll
            for (int r = 0; r < 16; ++r) { sacc[r] = __builtin_amdgcn_exp2f(sacc[r] - mnew); psum += sacc[r]; }
            lrun = lrun * alpha + psum;
#pragma unroll
            for (int r = 0; r < 16; ++r) { o0[r] *= alpha; o1[r] *= alpha; }
            bf16x8 pf[2];
#pragma unroll
            for (int s = 0; s < 2; ++s) { v4u w; w.x = cvt_pk_bf16(sacc[8 * s], sacc[8 * s + 1]); w.y = cvt_pk_bf16(sacc[8 * s + 2], sacc[8 * s + 3]); w.z = cvt_pk_bf16(sacc[8 * s + 4], sacc[8 * s + 5]); w.w = cvt_pk_bf16(sacc[8 * s + 6], sacc[8 * s + 7]); pf[s] = __builtin_bit_cast(bf16x8, w); }
#pragma unroll
            for (int s = 0; s < 2; ++s)
#pragma unroll
                for (int db = 0; db < 2; ++db) {
                    const v4i16_t lo = __builtin_amdgcn_ds_read_tr16_b64_v4i16((LAS v4i16_t*)(slot + voff[s][db]));
                    const v4i16_t hh = __builtin_amdgcn_ds_read_tr16_b64_v4i16((LAS v4i16_t*)(slot + voff[s][db] + 8 * 128));
                    const bf16x8 vf = (bf16x8){lo[0], lo[1], lo[2], lo[3], hh[0], hh[1], hh[2], hh[3]};
                    if (db == 0) o0 = __builtin_amdgcn_mfma_f32_32x32x16_bf16(vf, pf[s], o0, 0, 0, 0); else o1 = __builtin_amdgcn_mfma_f32_32x32x16_bf16(vf, pf[s], o1, 0, 0, 0);
                }
            cur = nxt;
        }
        { auto rr = __builtin_amdgcn_permlane32_swap(__float_as_uint(lrun), __float_as_uint(lrun), false, false); lrun = __uint_as_float(rr[0]) + __uint_as_float(rr[1]); }
        const float inv = 1.0f / lrun; const int b = bh >> 3, h = bh & 7;
        bf16* op = OC + ((size_t)(b * SEQ + tq)) * DM + h * HD + 4 * hi;
#pragma unroll
        for (int g = 0; g < 4; ++g) {
            v2u w0, w1; w0.x = cvt_pk_bf16(o0[4 * g] * inv, o0[4 * g + 1] * inv); w0.y = cvt_pk_bf16(o0[4 * g + 2] * inv, o0[4 * g + 3] * inv);
            w1.x = cvt_pk_bf16(o1[4 * g] * inv, o1[4 * g + 1] * inv); w1.y = cvt_pk_bf16(o1[4 * g + 2] * inv, o1[4 * g + 3] * inv);
            *(GAS v2u*)(op + 8 * g) = w0; *(GAS v2u*)(op + 32 + 8 * g) = w1; }
    }
    asm volatile("s_waitcnt vmcnt(0)" ::: "memory");
}

__device__ __forceinline__ void conv_simple(Frame& F, const Args& args, int L) {
    LAS float* ybuf = (LAS float*)(F.lds + RING_OFF); LAS float* stats = ybuf + 16 * 512;
    const bf16* U = WSP(bf16, WS_U); bf16* OC = WSP(bf16, WS_OC);
    const int c = F.tid, lane = F.lane;
    float w[CK];
#pragma unroll
    for (int j = 0; j < CK; ++j) w[j] = args.in[4][((size_t)L * CK + j) * CW + c];
    const float bias = args.in[5][L * CW + c], lg = args.in[6][L * CW + c], lb = args.in[7][L * CW + c];
    for (int unit = F.vcu; unit < M / 16; unit += F.G) {
        const int row0 = unit * 16, t0 = row0 & (SEQ - 1);
        float uu[46];
#pragma unroll
        for (int i = 0; i < 46; ++i) { const int tt = t0 - 30 + i; uu[i] = tt >= 0 ? __uint_as_float((unsigned)U[(size_t)(row0 - 30 + i) * CW + c] << 16) : 0.f; }
        float y[16];
#pragma unroll
        for (int tt = 0; tt < 16; ++tt) { float a = bias;
#pragma unroll
            for (int j = 0; j < CK; ++j) a += w[j] * uu[tt + j];
            y[tt] = a; ybuf[tt * 512 + c] = a; }
        __syncthreads();
#pragma unroll
        for (int q = 0; q < 2; ++q) { const int tt = 2 * F.wave + q; float v[8]; float s = 0.f;
#pragma unroll
            for (int i = 0; i < 8; ++i) { v[i] = ybuf[tt * 512 + lane + 64 * i]; s += v[i]; }
            const float mu = wave_sum(s) * (1.0f / 512.0f); float s2 = 0.f;
#pragma unroll
            for (int i = 0; i < 8; ++i) { const float dd = v[i] - mu; s2 += dd * dd; }
            const float var = wave_sum(s2) * (1.0f / 512.0f);
            if (lane == 0) { stats[2 * tt] = mu; stats[2 * tt + 1] = rsqrtf(var + EPS); } }
        __syncthreads();
#pragma unroll
        for (int tt = 0; tt < 16; ++tt) { const float yn = (y[tt] - stats[2 * tt]) * stats[2 * tt + 1] * lg + lb; const float ov = yn * sigm(yn);
            OC[(size_t)(row0 + tt) * DM + 512 + c] = (bf16)(cvt_pk_bf16(ov, 0.f) & 0xffffu); }
        __syncthreads();
    }
}

__device__ __forceinline__ void conv_v2(Frame& F, const Args& args, int L) {
    LAS float* ybuf = (LAS float*)(F.lds + RING_OFF);
    LAS float* stats = (LAS float*)(F.lds + OFFS_OFF + 256);
    const bf16* U = WSP(bf16, WS_U); bf16* OC = WSP(bf16, WS_OC);
    const int cp = F.tid & 255, half = F.tid >> 8, lane = F.lane;
    f32x2 w[CK];
#pragma unroll
    for (int j = 0; j < CK; ++j) w[j] = *(const f32x2*)(args.in[4] + ((size_t)L * CK + j) * CW + 2 * cp);
    const f32x2 bias = *(const f32x2*)(args.in[5] + L * CW + 2 * cp), lg = *(const f32x2*)(args.in[6] + L * CW + 2 * cp), lb = *(const f32x2*)(args.in[7] + L * CW + 2 * cp);
    for (int unit = F.vcu; unit < M / 64; unit += F.G) {
        const int row0 = unit * 64 + half * 32, t0 = row0 & (SEQ - 1);
#pragma unroll 1
        for (int sub = 0; sub < 2; ++sub) {
            float wl[46], wh[46];
#pragma unroll
            for (int i = 0; i < 46; ++i) { const int tt = t0 + 16 * sub - 30 + i; const int ri = row0 + 16 * sub - 30 + i; const int rc = tt >= 0 ? ri : row0;
                unsigned u = *(const GAS unsigned*)(U + (size_t)rc * CW + 2 * cp); u = tt >= 0 ? u : 0u; wl[i] = bf_lo(u); wh[i] = bf_hi(u); }
#pragma unroll
            for (int tt = 0; tt < 16; ++tt) { f32x2 a = bias;
#pragma unroll
                for (int j = 0; j < CK; ++j) { a.x += w[j].x * wl[tt + j]; a.y += w[j].y * wh[tt + j]; }
                *(LAS f32x2*)(ybuf + (half * 32 + 16 * sub + tt) * 512 + 2 * cp) = a; }
        }
        __syncthreads();
#pragma unroll
        for (int q = 0; q < 8; ++q) { const int tk = 8 * F.wave + q; float s = 0.f, s2 = 0.f;
#pragma unroll
            for (int i = 0; i < 2; ++i) { const f32x4 v = *(const LAS f32x4*)(ybuf + tk * 512 + 4 * lane + 256 * i); s += (v[0] + v[1]) + (v[2] + v[3]); s2 += (v[0] * v[0] + v[1] * v[1]) + (v[2] * v[2] + v[3] * v[3]); }
            s = wave_sum(s); s2 = wave_sum(s2);
            const float mu = s * (1.0f / 512.0f), var = fmaxf(s2 * (1.0f / 512.0f) - mu * mu, 0.f);
            if (lane == 0) { stats[2 * tk] = mu; stats[2 * tk + 1] = rsqrtf(var + EPS); } }
        __syncthreads();
#pragma unroll
        for (int tt = 0; tt < 32; ++tt) { const f32x2 st = *(const LAS f32x2*)(stats + 2 * (half * 32 + tt));
            const f32x2 yv = *(const LAS f32x2*)(ybuf + (half * 32 + tt) * 512 + 2 * cp);
            const float y0 = (yv.x - st.x) * st.y * lg.x + lb.x, y1 = (yv.y - st.x) * st.y * lg.y + lb.y;
            *(GAS unsigned*)(OC + (size_t)(row0 + tt) * DM + 512 + 2 * cp) = cvt_pk_bf16(y0 * sigm(y0), y1 * sigm(y1)); }
        __syncthreads();
    }
}

__device__ __forceinline__ void route_phase(Frame& F, const Args& args, int L) {
    LAS float* lgs = (LAS float*)(F.lds + RING_OFF) + F.wave * (8 * 40);
    const bf16* XB = WSP(bf16, WS_XB); const float* SSQ = WSP(float, WS_SSQ + (size_t)(3 * L + 1) * MiB); const bf16* WR = WSP(bf16, WS_WR) + (size_t)L * 64 * DM;
    int* ROUTE = WSP(int, WS_ROUTE); unsigned* cnt = (unsigned*)(F.ctl + CW_CNT + 64 * L);
    const int lane = F.lane, gw = F.vcu * NWAVES + F.wave, NGW = F.G * NWAVES;
    int vz = 0; asm volatile("" : "+v"(vz));
    const float bias = lane < 4 ? args.in[14][L * NGRP + lane] : (lane < 36 ? args.in[16][L * NEXP + lane - 4] : 0.f);
    for (int tb = gw; tb < M / 8; tb += NGW) {
        const int t0 = tb * 8;
        const GAS v4u* wp = (const GAS v4u*)(WR + (size_t)lane * DM);
        float a[8];
#pragma unroll
        for (int tt = 0; tt < 8; ++tt) a[tt] = 0.f;
        for (int kc = 0; kc < 128; ++kc) { const v4u w = wp[kc];
#pragma unroll
            for (int tt = 0; tt < 8; ++tt) { const v4u x = *((const GAS v4u*)(XB + (size_t)(t0 + tt) * DM) + kc + vz);
                a[tt] = dot2bf(w.x, x.x, a[tt]); a[tt] = dot2bf(w.y, x.y, a[tt]); a[tt] = dot2bf(w.z, x.z, a[tt]); a[tt] = dot2bf(w.w, x.w, a[tt]); } }
        float rr = 0.f;
#pragma unroll
        for (int tt = 0; tt < 8; ++tt) { const float r = rscale_of(SSQ + vz, t0 + tt); if (lane == tt) rr = r; if (lane < 36) lgs[tt * 40 + lane] = a[tt] * r + bias; }
        LDS_WAIT(); asm volatile("" ::: "memory");
        if (lane < 8) {
            const int t = t0 + lane; const LAS float* lp = lgs + lane * 40;
            float mxv = -1e30f; int gs = 0; float l4[4];
#pragma unroll
            for (int i = 0; i < 4; ++i) { l4[i] = lp[i]; if (l4[i] > mxv) { mxv = l4[i]; gs = i; } }
            float se = 0.f;
#pragma unroll
            for (int i = 0; i < 4; ++i) se += __expf(l4[i] - mxv);
            const float pg = 1.0f / se;
            float v1 = -1e30f, v2 = -1e30f; int i1 = 0, i2 = 0;
#pragma unroll
            for (int i = 0; i < 8; ++i) { const float v = lp[4 + gs * 8 + i]; if (v > v1) { v2 = v1; i2 = i1; v1 = v; i1 = i; } else if (v > v2) { v2 = v; i2 = i; } }
            const float e2 = __expf(v2 - v1), s1 = 1.0f / (1.0f + e2);
            const int ea = gs * 8 + i1, eb = gs * 8 + i2;
            const unsigned ia = atomicAdd(cnt + ea, 1u), ib = atomicAdd(cnt + eb, 1u);
            v4u r0, r1; r0.x = (unsigned)ea; r0.y = (unsigned)eb; r0.z = ia; r0.w = ib; r1.x = __float_as_uint(pg * s1); r1.y = __float_as_uint(pg * e2 * s1); r1.z = __float_as_uint(rr); r1.w = 0u;
            *(GAS v4u*)(ROUTE + (size_t)t * 8) = r0; *(GAS v4u*)(ROUTE + (size_t)t * 8 + 4) = r1;
        }
        LDS_WAIT(); asm volatile("" ::: "memory");
    }
}
__device__ __forceinline__ void moe_offsets(Frame& F, int L) {
    volatile LAS int* offs = (volatile LAS int*)(F.lds + OFFS_OFF);
    __syncthreads();
    if (F.tid == 0) { int acc = 0;
        for (int e = 0; e < NEXP; ++e) { offs[e] = acc; const unsigned c = __hip_atomic_load(F.ctl + CW_CNT + 64 * L + e, RLX_AGENT); acc += (int)((c + 255u) & ~255u); }
        offs[NEXP] = acc; }
    __syncthreads();
}
__device__ __forceinline__ void dispatch_phase(Frame& F, int L) {
    moe_offsets(F, L);
    const volatile LAS int* offs = (const volatile LAS int*)(F.lds + OFFS_OFF);
    const bf16* XB = XCUR(L); bf16* XG = WSP(bf16, WS_XG); const int* ROUTE = WSP(int, WS_ROUTE); int* POS = WSP(int, WS_POS); float* RSC = WSP(float, WS_RSC); float* ROWG = WSP(float, WS_ROWG);
    const int lane = F.lane, gw = F.vcu * NWAVES + F.wave, NGW = F.G * NWAVES;
    int vz = 0; asm volatile("" : "+v"(vz));
    for (int t = gw; t < M; t += NGW) {
        const v4u r0 = *(const GAS v4u*)(ROUTE + (size_t)t * 8 + vz), r1 = *(const GAS v4u*)(ROUTE + (size_t)t * 8 + 4 + vz);
        const int s0 = offs[r0.x] + (int)r0.z, s1 = offs[r0.y] + (int)r0.w;
        const GAS v4u* src = (const GAS v4u*)(XB + (size_t)t * DM) + lane; const v4u a = src[0], b = src[64];
        GAS v4u* d0 = (GAS v4u*)(XG + (size_t)s0 * DM) + lane; GAS v4u* d1 = (GAS v4u*)(XG + (size_t)s1 * DM) + lane;
        d0[0] = a; d0[64] = b; d1[0] = a; d1[64] = b;
        if (lane == 0) { POS[2 * t] = s0; POS[2 * t + 1] = s1; RSC[s0] = __uint_as_float(r1.z); RSC[s1] = __uint_as_float(r1.z); ROWG[s0] = __uint_as_float(r1.x); ROWG[s1] = __uint_as_float(r1.y); }
    }
}
__device__ __forceinline__ void combine_phase(Frame& F, int L) {
    bf16* XB = XCUR(L); const bf16* Y = WSP(bf16, WS_Y); const int* POS = WSP(int, WS_POS); float* SSQ = WSP(float, WS_SSQ + (size_t)(3 * L + 2) * MiB);
    const int lane = F.lane, gw = F.vcu * NWAVES + F.wave, NGW = F.G * NWAVES;
    int vz = 0; asm volatile("" : "+v"(vz));
    for (int t = gw; t < M; t += NGW) {
        const int s0 = POS[2 * t + vz], s1 = POS[2 * t + 1 + vz];
        GAS v4u* xb = (GAS v4u*)(XB + (size_t)t * DM) + lane; const GAS v4u* y0 = (const GAS v4u*)(Y + (size_t)s0 * DM) + lane; const GAS v4u* y1 = (const GAS v4u*)(Y + (size_t)s1 * DM) + lane;
        float s = 0.f;
#pragma unroll
        for (int j = 0; j < 2; ++j) { f32x4 xa, xc, aa, ac, ba, bc; unpack8(xb[64 * j], xa, xc); unpack8(y0[64 * j], aa, ac); unpack8(y1[64 * j], ba, bc);
            const f32x4 v0 = xa + aa + ba, v1 = xc + ac + bc; xb[64 * j] = pack8(v0, v1);
            s += ((v0[0] * v0[0] + v0[1] * v0[1]) + (v0[2] * v0[2] + v0[3] * v0[3])) + ((v1[0] * v1[0] + v1[1] * v1[1]) + (v1[2] * v1[2] + v1[3] * v1[3])); }
        const float tot = wave_sum(s);
        if (lane < 16) SSQ[(size_t)t * 16 + lane] = lane == 0 ? tot : 0.f;
    }
}
__device__ __forceinline__ void final_norm_phase(Frame& F, const Args& args) {
    float* X = F.out; const bf16* XB = WSP(bf16, WS_XB); const float* g = args.in[23];
    const int lane = F.lane, gw = F.vcu * NWAVES + F.wave, NGW = F.G * NWAVES;
    for (int t = gw; t < M; t += NGW) {
        const GAS v4u* xb = (const GAS v4u*)(XB + (size_t)t * DM) + lane; f32x4 v[4]; float s = 0.f;
#pragma unroll
        for (int j = 0; j < 2; ++j) { unpack8(xb[64 * j], v[2 * j], v[2 * j + 1]); }
#pragma unroll
        for (int j = 0; j < 4; ++j) s += (v[j][0] * v[j][0] + v[j][1] * v[j][1]) + (v[j][2] * v[j][2] + v[j][3] * v[j][3]);
        const float r = rsqrtf(wave_sum(s) * (1.0f / DM) + EPS);
        GAS f32x4* xo = (GAS f32x4*)(X + (size_t)t * DM) + 2 * lane;
#pragma unroll
        for (int j = 0; j < 2; ++j) { const f32x4 g0 = *((const f32x4*)g + 2 * lane + 128 * j), g1 = *((const f32x4*)g + 2 * lane + 128 * j + 1);
            xo[128 * j] = v[2 * j] * r * g0; xo[128 * j + 1] = v[2 * j + 1] * r * g1; }
    }
}
#ifndef MK_EXTRA_BAR
#define MK_EXTRA_BAR
#endif
#ifndef MK_DUP
#define MK_DUP (-1)
#endif
#ifdef MK_REFGEMM
#define GEMM_BODY gemm_phase_ref
#else
#define GEMM_BODY gemm_phase
#endif
#ifndef MK_EN
#define MK_EN 0xfff
#endif
__global__ void __launch_bounds__(NWAVES * 64, 2) mk_fwd(Args args) {
    extern __shared__ __attribute__((aligned(16))) unsigned char lds[];
    Frame F;
    F.lds = (LAS unsigned char*)lds;
    F.MISC = (volatile LAS unsigned*)(F.lds + MISC_OFF);
    F.tid = threadIdx.x; F.lane = F.tid & 63; F.wave = __builtin_amdgcn_readfirstlane(F.tid >> 6);
    F.G = gridDim.x; { const int bx = blockIdx.x; F.vcu = (F.G % 8 == 0) ? (bx % 8) * (F.G / 8) + bx / 8 : bx; }
    F.ws = args.ws; F.out = args.out; F.ctl = (gu32*)(args.ws + WS_CTL);
    for (int u = F.tid; u < (LDS_BYTES - LDSCTL_OFF) / 4; u += NWAVES * 64) ((LAS unsigned*)(F.lds + LDSCTL_OFF))[u] = 0u;
    __syncthreads();
    XcdBarrier bar; bar.bar = (unsigned*)(F.ctl + CW_BAR); bar.x = 0; bar.st = nullptr;
    if (args.use_bar) bar = xcd_barrier_post((unsigned*)(F.ctl + CW_BAR), F.MISC + 8);
    const int cblk = (int)blockIdx.x;
#define PHASE_SEAM(ph_) do { if ((ph_) + 1 < args.ph_hi) { if (args.use_bar) { xcd_barrier(bar); MK_EXTRA_BAR } else { VM_WAIT(); __syncthreads(); } } } while (0)
    int ph0 = args.ph_lo;
    if (ph0 == 0 && (MK_EN & 1)) { p0_prologue(F, args); if (MK_DUP == 0) { xcd_barrier(bar); p0_prologue(F, args); } PHASE_SEAM(0); ph0 = 1; }
    for (int ph = ph0; ph < args.ph_hi; ++ph) {
      for (int rep_ = (ph == MK_DUP ? 2 : 1); rep_ > 0; --rep_) {
        { int t_ = threadIdx.x; asm volatile("" : "+v"(t_)); F.tid = t_; F.lane = t_ & 63; F.wave = __builtin_amdgcn_readfirstlane(t_ >> 6); }
        if (ph == PH_FINAL && (MK_EN & 2)) {
            final_norm_phase(F, args);
        } else {
            const int L = (ph - 1) / PH_PER_LAYER, sub = (ph - 1) % PH_PER_LAYER;
            const char* wl = (const char*)(F.ws + WS_W + (size_t)L * W_LAYER);
            float* SSQ0 = WSP(float, WS_SSQ + (size_t)(3 * L) * MiB);
            if (sub == 0 && (MK_EN & (4 << 0))) {
                SchedGrid S{64, 18, F.G, cblk, (const char*)XCUR(L), wl + WO_WIN, (size_t)256 * 1024 * 2, (size_t)256 * 1024 * 2};
                EpiP1 E{SSQ0, WSP(float, WS_COS), WSP(float, WS_SIN), WSP(bf16, WS_Q), WSP(bf16, WS_K), WSP(bf16, WS_V), WSP(bf16, WS_U), WSP(bf16, WS_SGA), WSP(bf16, WS_SGB)};
                pg8::GEMM_BODY<EpiP1, SchedGrid, true>(F.lds + RING_OFF, pg8::Dims{1024, 1024, 1024}, S, E);
            } else if (sub == 1 && (MK_EN & (4 << 1))) {
#ifdef MK_ATTN_SIMPLE
                attn_simple(F);
#else
                attn_mfma(F); __syncthreads();
#ifdef MK_ATTN_TWICE
                attn_mfma(F); __syncthreads();
#endif
#endif
#ifdef MK_CONV_SIMPLE
                conv_simple(F, args, L);
#else
                conv_v2(F, args, L);
#endif
            } else if (sub == 2 && (MK_EN & (4 << 2))) {
                SchedGrid S{64, 4, F.G, cblk, (const char*)WSP(bf16, WS_OC), wl + WO_WAO, (size_t)256 * 1024 * 2, (size_t)256 * 1024 * 2};
                EpiP3 E{WSP(bf16, WS_SGA), WSP(bf16, WS_SGB), args.in[10] + L * DM, WSP(bf16, WS_MG)};
                pg8::GEMM_BODY<EpiP3, SchedGrid, true>(F.lds + RING_OFF, pg8::Dims{1024, 1024, 1024}, S, E);
            } else if (sub == 3 && (MK_EN & (4 << 3))) {
                SchedGrid S{64, 4, F.G, cblk, (const char*)WSP(bf16, WS_MG), wl + WO_WOUT, (size_t)256 * 1024 * 2, (size_t)256 * 1024 * 2};
                EpiP4 E{XCUR(L), XCUR(L), WSP(float, WS_SSQ + (size_t)(3 * L + 1) * MiB)};
                pg8::GEMM_BODY<EpiP4, SchedGrid, true>(F.lds + RING_OFF, pg8::Dims{1024, 1024, 1024}, S, E);
            } else if (sub == 4 && (MK_EN & (4 << 4))) {
                {
                    SchedGrid S{64, 1, F.G, cblk, (const char*)XCUR(L), (const char*)(WSP(bf16, WS_WR) + (size_t)L * 256 * DM), (size_t)256 * 1024 * 2, (size_t)0};
                    EpiRoute E{WSP(float, WS_SSQ + (size_t)(3 * L + 1) * MiB), WSP(float, WS_RB) + L * 64, WSP(float, WS_LG)};
                    pg8::GEMM_BODY<EpiRoute, SchedGrid, false>(F.lds + RING_OFF, pg8::Dims{1024, 1024, 1024}, S, E);
                    VM_WAIT(); __syncthreads();
                    for (int l_ = cblk; l_ < 64; l_ += F.G) { int pm_, pn_; pg8::tile_of(l_, 64, 1, pm_, pn_); route_decide(F, L, pm_); }
                }
                {
                    const bool split = F.G >= 128;
                    SchedGrid S{64, 4, split ? F.G - 64 : F.G, split ? (cblk >= 64 ? cblk - 64 : 256) : cblk, (const char*)(WSP(bf16, WS_PB) + (size_t)L * M * PLE), wl + WO_WPP, (size_t)256 * 256 * 2, (size_t)256 * 256 * 2};
                    EpiBf16 E{WSP(bf16, WS_PE), DM};
                    pg8::GEMM_BODY<EpiBf16, SchedGrid, false>(F.lds + RING_OFF, pg8::Dims{256, 256, 256}, S, E);
                }
            } else if (sub == 5 && (MK_EN & (4 << 5))) {
                dispatch_phase(F, L);
            } else if (sub == 6 && (MK_EN & (4 << 6))) {
                moe_offsets(F, L);
                SchedMoe S{(const volatile LAS int*)(F.lds + OFFS_OFF), F.G, cblk, 1, (const char*)WSP(bf16, WS_XG), wl + WO_WGU};
                EpiUp E{WSP(float, WS_RSC), WSP(bf16, WS_H)};
                pg8::GEMM_BODY<EpiUp, SchedMoe, true>(F.lds + RING_OFF, pg8::Dims{1024, 1024, 1024}, S, E);
            } else if (sub == 7 && (MK_EN & (4 << 7))) {
                moe_offsets(F, L);
                SchedMoe S{(const volatile LAS int*)(F.lds + OFFS_OFF), F.G, cblk, 0, (const char*)WSP(bf16, WS_H), wl + WO_WD};
                EpiDown E{WSP(float, WS_ROWG), WSP(bf16, WS_Y)};
                pg8::GEMM_BODY<EpiDown, SchedMoe, true>(F.lds + RING_OFF, pg8::Dims{512, 512, 512}, S, E);
            } else if (sub == 8 && (MK_EN & (4 << 8))) {
                combine_phase(F, L);
            } else if (MK_EN & (4 << 9)) {
                SchedGrid S{64, 4, F.G, cblk, (const char*)XCUR(L), wl + WO_WPG, (size_t)256 * 1024 * 2, (size_t)256 * 1024 * 2};
                EpiP8 E{WSP(float, WS_SSQ + (size_t)(3 * L + 2) * MiB), WSP(bf16, WS_PE), XCUR(L), XNXT(L), WSP(float, WS_SSQ + (size_t)(3 * L + 3) * MiB)};
                pg8::GEMM_BODY<EpiP8, SchedGrid, true>(F.lds + RING_OFF, pg8::Dims{1024, 1024, 1024}, S, E);
            }
        }
        if (rep_ > 1) xcd_barrier(bar);
      }
        PHASE_SEAM(ph);
    }
}

#ifndef MK_OPT_PHASES
#define MK_OPT_PHASES 22
#endif
#ifndef MK_REPEAT
#define MK_REPEAT 1
#endif
#ifndef MK_SINGLE
#define MK_SINGLE 0
#endif
#if MK_OPT_PHASES < 22
static void naive_tail(hipStream_t stream, void* const* d_in, float* X, float* out, char* ws, int L0, int st0) {
    using namespace naive;
    const float* p = (const float*)d_in[1]; const float* norm_mix = (const float*)d_in[2]; const float* w_in = (const float*)d_in[3];
    const float* w_dw = (const float*)d_in[4]; const float* b_dw = (const float*)d_in[5]; const float* ln_g = (const float*)d_in[6]; const float* ln_b = (const float*)d_in[7];
    const float* w_ao = (const float*)d_in[8]; const float* w_co = (const float*)d_in[9]; const float* b_co = (const float*)d_in[10]; const float* w_out = (const float*)d_in[11];
    const float* norm_ffn = (const float*)d_in[12]; const float* w_rg = (const float*)d_in[13]; const float* b_rg = (const float*)d_in[14]; const float* w_re = (const float*)d_in[15]; const float* b_re = (const float*)d_in[16];
    const float* w_eg = (const float*)d_in[17]; const float* w_eu = (const float*)d_in[18]; const float* w_ed = (const float*)d_in[19];
    const float* norm_ple = (const float*)d_in[20]; const float* w_pp = (const float*)d_in[21]; const float* w_pg = (const float*)d_in[22]; const float* norm_final = (const float*)d_in[23];
    constexpr size_t MiB_ = 1u << 20;
    float* Hn = (float*)(ws + 0 * MiB_); float* QKV = (float*)(ws + 64 * MiB_); float* CUG = (float*)(ws + 160 * MiB_); float* GAB = (float*)(ws + 224 * MiB_);
    float* AO = (float*)(ws + 352 * MiB_); float* CO = (float*)(ws + 384 * MiB_);
    float* YA = Hn; float* YB = QKV;
    float* LG = CUG; float* LE = CUG + (size_t)M_ * 4; int* EID = (int*)(CUG + (size_t)M_ * 40); float* GT = CUG + (size_t)M_ * 48;
    float* GL = GAB; float* PE = QKV;
    for (int L = L0; L < DEPTH_; ++L) {
        const int s0 = (L == L0) ? st0 : 0;
        if (s0 <= 0) {
            hipLaunchKernelGGL(rmsnorm_k, dim3(M_ / 4), dim3(256), 0, stream, X, norm_mix + L * D_, Hn);
            const float* win = w_in + (size_t)L * D_ * WIN_;
            sgemm(stream, Hn, D_, win, WIN_, QKV, 1536, M_, 1536, D_, nullptr, nullptr);
            sgemm(stream, Hn, D_, win + 1536, WIN_, CUG, 1024, M_, 1024, D_, nullptr, nullptr);
            sgemm(stream, Hn, D_, win + 2560, WIN_, GAB, 2048, M_, 2048, D_, nullptr, nullptr);
            hipLaunchKernelGGL(rope_k, dim3(M_ * 2 * H_ * 32 / 256), dim3(256), 0, stream, QKV);
            hipLaunchKernelGGL(attn_naive_k, dim3(M_ * H_ / 4), dim3(256), 0, stream, QKV, AO);
            hipLaunchKernelGGL(conv_naive_k, dim3(M_), dim3(512), 0, stream, CUG, w_dw + (size_t)L * CK_ * CW_, b_dw + L * CW_, ln_g + L * CW_, ln_b + L * CW_, CO);
            sgemm(stream, AO, 512, w_ao + (size_t)L * 512 * D_, D_, YA, D_, M_, D_, 512, nullptr, nullptr);
            sgemm(stream, CO, 512, w_co + (size_t)L * 512 * D_, D_, YB, D_, M_, D_, 512, b_co + L * D_, nullptr);
            hipLaunchKernelGGL(merge_k, dim3(M_ * D_ / 256), dim3(256), 0, stream, GAB, YA, YB);
            sgemm(stream, GAB, 2048, w_out + (size_t)L * D_ * D_, D_, X, D_, M_, D_, D_, nullptr, X);
        }
        if (s0 <= 1) {
            hipLaunchKernelGGL(rmsnorm_k, dim3(M_ / 4), dim3(256), 0, stream, X, norm_ffn + L * D_, Hn);
            sgemm(stream, Hn, D_, w_rg + (size_t)L * D_ * NG_, NG_, LG, 4, M_, 4, D_, b_rg + L * NG_, nullptr);
            sgemm(stream, Hn, D_, w_re + (size_t)L * D_ * NE_, NE_, LE, 32, M_, 32, D_, b_re + L * NE_, nullptr);
            hipLaunchKernelGGL(route_k, dim3(M_ / 256), dim3(256), 0, stream, LG, LE, EID, GT);
            hipLaunchKernelGGL(moe_naive_k, dim3(M_), dim3(256), 0, stream, Hn, EID, GT, w_eg + (size_t)L * NE_ * D_ * FF_, w_eu + (size_t)L * NE_ * D_ * FF_, w_ed + (size_t)L * NE_ * FF_ * D_, X);
        }
        if (s0 <= 2) {
            hipLaunchKernelGGL(rmsnorm_k, dim3(M_ / 4), dim3(256), 0, stream, X, norm_ple + L * D_, Hn);
            sgemm(stream, Hn, D_, w_pg + (size_t)L * D_ * D_, D_, GL, D_, M_, D_, D_, nullptr, nullptr);
            sgemm(stream, p + (size_t)L * M_ * PLE_, PLE_, w_pp + (size_t)L * PLE_ * D_, D_, PE, D_, M_, D_, PLE_, nullptr, nullptr);
            hipLaunchKernelGGL(ple_k, dim3(M_ * D_ / 256), dim3(256), 0, stream, X, GL, PE);
        }
    }
    hipLaunchKernelGGL(rmsnorm_k, dim3(M_ / 4), dim3(256), 0, stream, X, norm_final, out);
}
#endif


#if MK_OPT_PHASES < 22
namespace dbg {
__device__ __forceinline__ float b2f(unsigned short u) { return __uint_as_float((unsigned)u << 16); }
__global__ void __launch_bounds__(256) cvt_qkv_k(const unsigned short* Q, const unsigned short* K, const unsigned short* V, float* qkv) {
    const size_t idx = (size_t)blockIdx.x * 256 + threadIdx.x;
    const int tok = (int)(idx >> 9), col = (int)(idx & 511), h = col >> 6, d = col & 63, b = tok >> 11, t = tok & 2047;
    const size_t src = ((size_t)(b * 8 + h) * 2048 + t) * 64 + d;
    qkv[(size_t)tok * 1536 + col] = b2f(Q[src]) * (1.0f / (0.125f * 1.4426950408889634f));
    qkv[(size_t)tok * 1536 + 512 + col] = b2f(K[src]);
    qkv[(size_t)tok * 1536 + 1024 + col] = b2f(V[src]);
}
__global__ void __launch_bounds__(512) conv_from_u_k(const unsigned short* __restrict__ U, const float* __restrict__ wdw, const float* __restrict__ bdw,
                                                     const float* __restrict__ lg, const float* __restrict__ lb, float* __restrict__ co) {
    __shared__ float red[16];
    const int tok = blockIdx.x, c = threadIdx.x, t = tok % 2048;
    float y = bdw[c];
    for (int j = 0; j < 31; ++j) { const int tt = t - 30 + j; if (tt >= 0) y += wdw[j * 512 + c] * b2f(U[(size_t)(tok - 30 + j) * 512 + c]); }
    float s = naive::wave_sum(y);
    if ((c & 63) == 0) red[c >> 6] = s;
    __syncthreads();
    float mu = 0.f;
    for (int i = 0; i < 8; ++i) mu += red[i];
    mu *= (1.f / 512.f);
    const float dv = y - mu;
    float s2 = naive::wave_sum(dv * dv);
    if ((c & 63) == 0) red[8 + (c >> 6)] = s2;
    __syncthreads();
    float var = 0.f;
    for (int i = 0; i < 8; ++i) var += red[8 + i];
    var *= (1.f / 512.f);
    const float yn = dv * rsqrtf(var + 1e-6f) * lg[c] + lb[c];
    co[(size_t)tok * 512 + c] = yn / (1.f + expf(-yn));
}
__global__ void __launch_bounds__(256) merge_sig_k(const unsigned short* sga, const unsigned short* sgb, const float* ya, const float* yb, float* mg) {
    const size_t idx = (size_t)blockIdx.x * 256 + threadIdx.x;
    mg[idx] = b2f(sga[idx]) * ya[idx] + b2f(sgb[idx]) * yb[idx];
}
__global__ void __launch_bounds__(256) cvt_oc_k(const unsigned short* oc, float* ao, float* co) {
    const size_t idx = (size_t)blockIdx.x * 256 + threadIdx.x;
    const size_t m = idx >> 10; const int n = (int)(idx & 1023);
    const float v = b2f(oc[idx]);
    if (n < 512) ao[m * 512 + n] = v; else co[m * 512 + n - 512] = v;
}
__global__ void __launch_bounds__(256) cvt_bf_k(const unsigned short* src, float* dst) {
    const size_t idx = (size_t)blockIdx.x * 256 + threadIdx.x; dst[idx] = b2f(src[idx]);
}
}
static void dbg_mixer_tail(hipStream_t stream, void* const* d_in, float* X, char* ws, int nopt) {
    using namespace naive;
    constexpr size_t MiB_ = 1u << 20;
    const float* w_dw = (const float*)d_in[4]; const float* b_dw = (const float*)d_in[5]; const float* ln_g = (const float*)d_in[6]; const float* ln_b = (const float*)d_in[7];
    const float* w_ao = (const float*)d_in[8]; const float* w_co = (const float*)d_in[9]; const float* b_co = (const float*)d_in[10]; const float* w_out = (const float*)d_in[11];
    float* Hn = (float*)(ws + 0 * MiB_); float* QKV = (float*)(ws + 64 * MiB_); float* YBb = (float*)(ws + 160 * MiB_); float* MGf = (float*)(ws + 224 * MiB_);
    float* AO = (float*)(ws + 288 * MiB_); float* CO = (float*)(ws + 320 * MiB_);
    const unsigned short* Qb = (const unsigned short*)(ws + WS_Q); const unsigned short* Kb = (const unsigned short*)(ws + WS_K); const unsigned short* Vb = (const unsigned short*)(ws + WS_V);
    const unsigned short* Ub = (const unsigned short*)(ws + WS_U); const unsigned short* SGAb = (const unsigned short*)(ws + WS_SGA); const unsigned short* SGBb = (const unsigned short*)(ws + WS_SGB);
    const unsigned short* OCb = (const unsigned short*)(ws + WS_OC); const unsigned short* MGb = (const unsigned short*)(ws + WS_MG);
    (void)hipMemcpyAsync(X, d_in[0], (size_t)M_ * D_ * 4, hipMemcpyDeviceToDevice, stream);
    if (nopt == 2) {
        hipLaunchKernelGGL(dbg::cvt_qkv_k, dim3(M_ * 512 / 256), dim3(256), 0, stream, Qb, Kb, Vb, QKV);
        hipLaunchKernelGGL(attn_naive_k, dim3(M_ * H_ / 4), dim3(256), 0, stream, QKV, AO);
        hipLaunchKernelGGL(dbg::conv_from_u_k, dim3(M_), dim3(512), 0, stream, Ub, w_dw, b_dw, ln_g, ln_b, CO);
    } else if (nopt == 3) {
        hipLaunchKernelGGL(dbg::cvt_oc_k, dim3(M_ * D_ / 256), dim3(256), 0, stream, OCb, AO, CO);
    }
    if (nopt <= 3) {
        sgemm(stream, AO, 512, w_ao, D_, Hn, D_, M_, D_, 512, nullptr, nullptr);
        sgemm(stream, CO, 512, w_co, D_, YBb, D_, M_, D_, 512, b_co, nullptr);
        hipLaunchKernelGGL(dbg::merge_sig_k, dim3(M_ * D_ / 256), dim3(256), 0, stream, SGAb, SGBb, Hn, YBb, MGf);
    } else {
        hipLaunchKernelGGL(dbg::cvt_bf_k, dim3(M_ * D_ / 256), dim3(256), 0, stream, MGb, MGf);
    }
    sgemm(stream, MGf, D_, w_out, D_, X, D_, M_, D_, D_, nullptr, X);
}
#endif

#if MK_OPT_PHASES < 22
namespace dbg {
__global__ void __launch_bounds__(256) hash_k(const unsigned* buf, size_t nwords, unsigned* out) {
    unsigned acc = 0u;
    for (size_t i = (size_t)blockIdx.x * 256 + threadIdx.x; i < nwords; i += (size_t)gridDim.x * 256) acc += buf[i] * (2654435761u * (unsigned)(2 * i + 1)) + (unsigned)i;
    for (int o = 1; o < 64; o <<= 1) acc += __shfl_xor(acc, o);
    if ((threadIdx.x & 63) == 0) atomicAdd(out, acc);
}
__global__ void __launch_bounds__(256) perturb_k(float* out, size_t first, size_t count, const unsigned* hash) {
    const size_t i = (size_t)blockIdx.x * 256 + threadIdx.x;
    if (i < count) out[first + i] += (float)(hash[0] >> 8) * (1.0f / 16777216.0f);
}
}
static void dbg_hash(hipStream_t st, const void* buf, size_t bytes, unsigned* cell) { hipLaunchKernelGGL(dbg::hash_k, dim3(1024), dim3(256), 0, st, (const unsigned*)buf, bytes / 4, cell); }
#endif

#if MK_OPT_PHASES < 22
#ifndef DBG_USE
#define DBG_USE 7
#endif
static void dbg_p1_tail(hipStream_t stream, void* const* d_in, float* X, char* ws) {
    using namespace naive;
    constexpr size_t MiB_ = 1u << 20;
    const float* norm_mix = (const float*)d_in[2]; const float* w_in = (const float*)d_in[3];
    const float* w_dw = (const float*)d_in[4]; const float* b_dw = (const float*)d_in[5]; const float* ln_g = (const float*)d_in[6]; const float* ln_b = (const float*)d_in[7];
    const float* w_ao = (const float*)d_in[8]; const float* w_co = (const float*)d_in[9]; const float* b_co = (const float*)d_in[10]; const float* w_out = (const float*)d_in[11];
    float* Hn = (float*)(ws + 0 * MiB_); float* QKV = (float*)(ws + 64 * MiB_); float* CUG = (float*)(ws + 160 * MiB_); float* GAB = (float*)(ws + 224 * MiB_);
    float* AO = (float*)(ws + 480 * MiB_); float* CO = (float*)(ws + 64 * MiB_); float* YA = Hn; float* YB = (float*)(ws + 96 * MiB_); float* MGf = (float*)(ws + 160 * MiB_);
    const unsigned short* Qb = (const unsigned short*)(ws + WS_Q); const unsigned short* Kb = (const unsigned short*)(ws + WS_K); const unsigned short* Vb = (const unsigned short*)(ws + WS_V);
    const unsigned short* Ub = (const unsigned short*)(ws + WS_U); const unsigned short* SGAb = (const unsigned short*)(ws + WS_SGA); const unsigned short* SGBb = (const unsigned short*)(ws + WS_SGB);
    (void)hipMemcpyAsync(X, d_in[0], (size_t)M_ * D_ * 4, hipMemcpyDeviceToDevice, stream);
    hipLaunchKernelGGL(rmsnorm_k, dim3(M_ / 4), dim3(256), 0, stream, X, norm_mix, Hn);
    if (DBG_USE & 1) hipLaunchKernelGGL(dbg::cvt_qkv_k, dim3(M_ * 512 / 256), dim3(256), 0, stream, Qb, Kb, Vb, QKV);
    else { sgemm(stream, Hn, D_, w_in, WIN_, QKV, 1536, M_, 1536, D_, nullptr, nullptr); hipLaunchKernelGGL(rope_k, dim3(M_ * 2 * H_ * 32 / 256), dim3(256), 0, stream, QKV); }
    if (!(DBG_USE & 2)) sgemm(stream, Hn, D_, w_in + 1536, WIN_, CUG, 1024, M_, 1024, D_, nullptr, nullptr);
    if (!(DBG_USE & 4)) sgemm(stream, Hn, D_, w_in + 2560, WIN_, GAB, 2048, M_, 2048, D_, nullptr, nullptr);
    hipLaunchKernelGGL(attn_naive_k, dim3(M_ * H_ / 4), dim3(256), 0, stream, QKV, AO);
    if (DBG_USE & 2) hipLaunchKernelGGL(dbg::conv_from_u_k, dim3(M_), dim3(512), 0, stream, Ub, w_dw, b_dw, ln_g, ln_b, CO);
    else hipLaunchKernelGGL(conv_naive_k, dim3(M_), dim3(512), 0, stream, CUG, w_dw, b_dw, ln_g, ln_b, CO);
    sgemm(stream, AO, 512, w_ao, D_, YA, D_, M_, D_, 512, nullptr, nullptr);
    sgemm(stream, CO, 512, w_co, D_, YB, D_, M_, D_, 512, b_co, nullptr);
    if (DBG_USE & 4) { hipLaunchKernelGGL(dbg::merge_sig_k, dim3(M_ * D_ / 256), dim3(256), 0, stream, SGAb, SGBb, YA, YB, MGf); sgemm(stream, MGf, D_, w_out, D_, X, D_, M_, D_, D_, nullptr, X); }
    else { hipLaunchKernelGGL(merge_k, dim3(M_ * D_ / 256), dim3(256), 0, stream, GAB, YA, YB); sgemm(stream, GAB, 2048, w_out, D_, X, D_, M_, D_, D_, nullptr, X); }
}
#endif

extern "C" void kernel_launch(void* const* d_in, const int* in_sizes, int n_in, void* d_out, int out_size, void* d_ws, size_t ws_size, hipStream_t stream) {
    static int grid = 0;
    if (grid == 0) {
        if (n_in != 24 || in_sizes[0] != M * DM || out_size != M * DM || ws_size < WS_END) { fprintf(stderr, "kernel_launch: unexpected shapes (n_in %d, in0 %d, out %d, ws %zu); nothing launched\n", n_in, n_in > 0 ? in_sizes[0] : -1, out_size, ws_size); grid = -1; return; }
        int dev = 0, cus = 0, per_cu = 0;
        if (hipGetDevice(&dev) != hipSuccess || hipDeviceGetAttribute(&cus, hipDeviceAttributeMultiprocessorCount, dev) != hipSuccess) { fprintf(stderr, "kernel_launch: device query failed\n"); grid = -1; return; }
        if (hipFuncSetAttribute((const void*)mk_fwd, hipFuncAttributeMaxDynamicSharedMemorySize, LDS_BYTES) != hipSuccess) { fprintf(stderr, "kernel_launch: hipFuncSetAttribute failed\n"); grid = -1; return; }
        if (hipOccupancyMaxActiveBlocksPerMultiprocessor(&per_cu, (const void*)mk_fwd, NWAVES * 64, LDS_BYTES) != hipSuccess || per_cu < 1) { fprintf(stderr, "kernel_launch: occupancy query reports %d blocks per CU\n", per_cu); }
        (void)hipGetLastError();
        grid = cus;
    }
    if (grid < 0) return;
    (void)hipMemsetAsync((char*)d_ws + WS_CTL, 0, CTL_ZERO_BYTES, stream);
    Args a{};
    for (int i = 0; i < 24; ++i) a.in[i] = (const float*)d_in[i];
    a.out = (float*)d_out; a.ws = (unsigned char*)d_ws;
    constexpr int NOPT = MK_OPT_PHASES;
#if MK_SINGLE
    a.ph_lo = 0; a.ph_hi = NOPT; a.use_bar = 1;
    hipLaunchKernelGGL(mk_fwd, dim3(grid), dim3(NWAVES * 64), LDS_BYTES, stream, a);
#else
    for (int rep = 0; rep < MK_REPEAT; ++rep)
    for (int ph = 0; ph < NOPT; ++ph) { a.ph_lo = ph; a.ph_hi = ph + 1; a.use_bar = 0; hipLaunchKernelGGL(mk_fwd, dim3(grid), dim3(NWAVES * 64), LDS_BYTES, stream, a); }
#endif
#if defined(MK_PROBE)
    {
        constexpr size_t MiB_ = 1u << 20; char* ws = (char*)d_ws; unsigned* cells = (unsigned*)(ws + 520 * MiB_);
        (void)hipMemsetAsync(cells, 0, 256, stream);
        MK_PROBE
        (void)hipMemcpyAsync(d_out, d_in[0], (size_t)M * DM * 4, hipMemcpyDeviceToDevice, stream);
        naive_tail(stream, d_in, (float*)d_out, (float*)d_out, (char*)d_ws, 0, 0);
        hipLaunchKernelGGL(dbg::perturb_k, dim3((1u << 22) / 256), dim3(256), 0, stream, (float*)d_out, (size_t)0, (size_t)1 << 22, cells);
        hipLaunchKernelGGL(dbg::perturb_k, dim3((1u << 16) / 256), dim3(256), 0, stream, (float*)d_out, (size_t)1 << 23, (size_t)1 << 16, cells + 16);
    }
#elif MK_OPT_PHASES < 22
    {
        int L0 = 0, st0 = 0;
        if (NOPT <= 1) { (void)hipMemcpyAsync(d_out, d_in[0], (size_t)M * DM * 4, hipMemcpyDeviceToDevice, stream); }
        else if (NOPT == 2) { dbg_p1_tail(stream, d_in, (float*)d_out, (char*)d_ws); L0 = 0; st0 = 1; }
        else if (NOPT >= 3 && NOPT <= 4) { dbg_mixer_tail(stream, d_in, (float*)d_out, (char*)d_ws, NOPT); L0 = 0; st0 = 1; }
        else if (NOPT == 5) { L0 = 0; st0 = 1; } else if (NOPT == 10) { L0 = 0; st0 = 2; } else if (NOPT == 11) { L0 = 1; st0 = 0; }
        else if (NOPT == 15) { L0 = 1; st0 = 1; } else if (NOPT == 20) { L0 = 1; st0 = 2; } else if (NOPT == 21) { L0 = 2; st0 = 0; }
        naive_tail(stream, d_in, (float*)d_out, (float*)d_out, (char*)d_ws, L0, st0);
    }
#endif
}
```

```cpp
#define MK_OPT_PHASES 22
#define MK_SINGLE 1
#include <hip/hip_runtime.h>
#include <cstdio>
#include <cstdint>
#include <cmath>
namespace pg8 {
#define PG8_LAS __attribute__((address_space(3)))
typedef unsigned short bf16_t;
typedef short bf16x8 __attribute__((ext_vector_type(8)));
typedef float f32x4 __attribute__((ext_vector_type(4)));
typedef float f32x2 __attribute__((ext_vector_type(2)));
typedef unsigned u32x4 __attribute__((ext_vector_type(4)));
typedef unsigned u32x2 __attribute__((ext_vector_type(2)));
constexpr int BM = 256, BK = 64, HALF = 128, HTB = HALF * BK * 2  , STAGE_BYTES = 8 * HTB, NXCD = 8, WGM = 8;

__host__ __device__ __forceinline__ int lds_byte(int r, int c) { const int st = (r >> 4) * 2 + (c >> 5), rr = r & 15, cc = c & 31, ob = rr * 64 + cc * 2; return st * 1024 + (ob ^ (((ob >> 9) & 1) << 5)); }
__host__ __device__ __forceinline__ void stage_rc(int b, int& R, int& C) { const int st = b / 1024, sb = b % 1024, swz = sb ^ (((sb >> 9) & 1) << 5); R = (st >> 1) * 16 + swz / 64; C = (st & 1) * 32 + (swz % 64) / 2; }
__host__ __device__ __forceinline__ int perm32(int rho) { const int n = rho >> 4, i = rho & 15; return 8 * (i >> 2) + 4 * n + (i & 3); }

struct Unit { int pm, pn, aux; const char* A; const char* B; };
struct Dims { int K, lda, ldb; };

__host__ __device__ __forceinline__ void tile_of(int L, int nM, int nN, int& pm, int& pn) {
    const int nwg = nM * nN; int wgid = L; { const int q = nwg / NXCD, r = nwg % NXCD, xcd = wgid % NXCD, off = wgid / NXCD; wgid = (xcd < r ? xcd * (q + 1) : r * (q + 1) + (xcd - r) * q) + off; }
    const int nig = WGM * nN, gid = wgid / nig, fm = gid * WGM, gsz = (nM - fm) < WGM ? (nM - fm) : WGM;
    pm = fm + ((wgid % nig) % gsz); pn = (wgid % nig) / gsz;
}

typedef __bf16 bf16x2v __attribute__((ext_vector_type(2)));
__device__ __forceinline__ unsigned cvt_pk_bf16(float lo, float hi) { const f32x2 v = {lo, hi}; const bf16x2v b = __builtin_convertvector(v, bf16x2v); return __builtin_bit_cast(unsigned, b); }
__device__ __forceinline__ u32x4 pack8(const f32x4 a, const f32x4 b) { u32x4 w; w.x = cvt_pk_bf16(a[0], a[1]); w.y = cvt_pk_bf16(a[2], a[3]); w.z = cvt_pk_bf16(b[0], b[1]); w.w = cvt_pk_bf16(b[2], b[3]); return w; }
__device__ __forceinline__ float bf_lo(unsigned w) { return __uint_as_float(w << 16); }
__device__ __forceinline__ float bf_hi(unsigned w) { return __uint_as_float(w & 0xffff0000u); }
__device__ __forceinline__ void unpack8(const u32x4 w, f32x4& a, f32x4& b) { a[0] = bf_lo(w.x); a[1] = bf_hi(w.x); a[2] = bf_lo(w.y); a[3] = bf_hi(w.y); b[0] = bf_lo(w.z); b[1] = bf_hi(w.z); b[2] = bf_lo(w.w); b[3] = bf_hi(w.w); }
__device__ __forceinline__ float sigm(float x) { return __builtin_amdgcn_rcpf(1.0f + __builtin_amdgcn_exp2f(-1.4426950408889634f * x)); }
__device__ __forceinline__ f32x4 sigm4(const f32x4 x) { f32x4 r; r[0] = sigm(x[0]); r[1] = sigm(x[1]); r[2] = sigm(x[2]); r[3] = sigm(x[3]); return r; }

template <class Epi, class Sched, bool ALIGN_EPI>
__device__ __forceinline__ void gemm_phase(PG8_LAS unsigned char* lds, const Dims g, const Sched& S, const Epi& E) {
    int tid_ = threadIdx.x; asm volatile("" : "+v"(tid_));
    const int tid = tid_, wid = __builtin_amdgcn_readfirstlane(tid >> 6), lane = tid & 63, wr = wid >> 2, wc = wid & 3, fr = lane & 15, fq = lane >> 4;
    const int K = g.K, nt = K / BK;
    unsigned voffA[2], voffB[2];
#pragma unroll
    for (int i = 0; i < 2; ++i) { int R, C; stage_rc(tid * 16 + i * 8192, R, C); const int Rb = Epi::PERM ? ((R & ~31) + perm32(R & 31)) : R;
        voffA[i] = (unsigned)(R * g.lda + C) * 2u; voffB[i] = (unsigned)(Rb * g.ldb + C) * 2u; }
    const size_t kstep = (size_t)(BK * 2);
    const size_t hA = (size_t)HALF * g.lda * 2, hB = (size_t)HALF * g.ldb * 2;
    const unsigned ldsw = (unsigned)wid * 1024u;
    const int aoff = lds_byte(wr * 64 + fr, fq * 8), boff = lds_byte(wc * 32 + fr, fq * 8);
#define PG8_SA(b, h) (((b) * 2 + (h)) * HTB)
#define PG8_SB(b, h) ((4 + (b) * 2 + (h)) * HTB)
#define PG8_STAGE(bufoff, gbase, voff) do { _Pragma("unroll") for (int _i = 0; _i < 2; ++_i) \
        __builtin_amdgcn_global_load_lds((const unsigned*)((const char*)(gbase) + (voff)[_i]), (PG8_LAS unsigned*)(lds + (bufoff) + ldsw + _i * 8192), 16, 0, 0); } while (0)
#define PG8_LDA(dst, b, h) do { _Pragma("unroll") for (int m = 0; m < 4; ++m) _Pragma("unroll") for (int k = 0; k < 2; ++k) dst[m][k] = *(const PG8_LAS bf16x8*)(lds + PG8_SA(b, h) + aoff + m * 2048 + k * 1024); } while (0)
#define PG8_LDB(dst, b, h) do { _Pragma("unroll") for (int n = 0; n < 2; ++n) _Pragma("unroll") for (int k = 0; k < 2; ++k) dst[n][k] = *(const PG8_LAS bf16x8*)(lds + PG8_SB(b, h) + boff + n * 2048 + k * 1024); } while (0)
#define PG8_MMA(ai, bj, At, Bt) do { __builtin_amdgcn_s_setprio(1); _Pragma("unroll") for (int m = 0; m < 4; ++m) _Pragma("unroll") for (int n = 0; n < 2; ++n) _Pragma("unroll") for (int k = 0; k < 2; ++k) \
        acc[ai][bj][m][n] = __builtin_amdgcn_mfma_f32_16x16x32_bf16(Bt[n][k], At[m][k], acc[ai][bj][m][n], 0, 0, 0); __builtin_amdgcn_s_setprio(0); } while (0)
#define PG8_WAIT_V(n) asm volatile("s_waitcnt vmcnt(" #n ")" ::: "memory")
#define PG8_WAIT_L(n) asm volatile("s_waitcnt lgkmcnt(" #n ")" ::: "memory")
#define PG8_BAR __builtin_amdgcn_s_barrier()
#define PG8_SCHED __builtin_amdgcn_sched_barrier(0)
    Unit cur, nxt; int ui = 0;
    if (!S.next(0, cur)) return;
    f32x4 acc[2][2][4][2];
#pragma unroll
    for (int a = 0; a < 2; ++a)
#pragma unroll
        for (int b = 0; b < 2; ++b)
#pragma unroll
            for (int m = 0; m < 4; ++m)
#pragma unroll
                for (int n = 0; n < 2; ++n) acc[a][b][m][n] = (f32x4){0.f, 0.f, 0.f, 0.f};
    bf16x8 At[4][2], B0[2][2], B1[2][2];
    const char* cA = cur.A; const char* cB = cur.B;
    PG8_STAGE(PG8_SB(0, 0), cB, voffB); PG8_STAGE(PG8_SB(0, 1), cB + hB, voffB); PG8_STAGE(PG8_SA(0, 0), cA, voffA); PG8_STAGE(PG8_SA(0, 1), cA + hA, voffA);
    if (wr == 1) PG8_BAR;
    PG8_WAIT_V(2); PG8_BAR;
    PG8_STAGE(PG8_SB(1, 0), cB + kstep, voffB); PG8_STAGE(PG8_SA(1, 0), cA + kstep, voffA); PG8_STAGE(PG8_SB(1, 1), cB + hB + kstep, voffB);
    PG8_WAIT_V(6); PG8_BAR;
    for (;;) {
        const bool has_next = S.next(ui + 1, nxt);
        const char* nA = has_next ? nxt.A : cA; const char* nB = has_next ? nxt.B : cB;
        for (int hk = 0; hk < (Epi::MIDK ? 2 : 1); ++hk) {
        if constexpr (Epi::MIDK) { if (hk == 1) E.mid(acc, cur, wr, wc, fr, fq); }
        const int tbeg = Epi::MIDK ? hk * (nt / 2) : 0, tend = Epi::MIDK ? (hk + 1) * (nt / 2) : nt;
        for (int t = tbeg; t < tend; t += 2) {
            const bool last = (t == nt - 2);
            const char* a1 = cA + (size_t)(t + 1) * kstep;
            const char* a2 = last ? nA : cA + (size_t)(t + 2) * kstep; const char* b2 = last ? nB : cB + (size_t)(t + 2) * kstep;
            const char* a3 = a2 + kstep; const char* b3 = b2 + kstep;
            PG8_LDB(B0, 0, 0); PG8_LDB(B1, 0, 1); PG8_SCHED; PG8_LDA(At, 0, 0); PG8_STAGE(PG8_SA(1, 1), a1 + hA, voffA);
            PG8_WAIT_V(8); PG8_WAIT_L(0); PG8_BAR; PG8_MMA(0, 0, At, B0); PG8_MMA(0, 1, At, B1); PG8_BAR; PG8_SCHED;
            PG8_LDA(At, 0, 1); PG8_STAGE(PG8_SB(0, 0), b2, voffB); PG8_STAGE(PG8_SB(0, 1), b2 + hB, voffB); PG8_STAGE(PG8_SA(0, 0), a2, voffA);
            PG8_WAIT_V(8); PG8_WAIT_L(0); PG8_BAR; PG8_MMA(1, 0, At, B0); PG8_MMA(1, 1, At, B1); PG8_BAR; PG8_SCHED;
            PG8_LDB(B0, 1, 0); PG8_LDB(B1, 1, 1); PG8_SCHED; PG8_LDA(At, 1, 0); PG8_STAGE(PG8_SA(0, 1), a2 + hA, voffA);
            PG8_WAIT_V(8); PG8_WAIT_L(0); PG8_BAR; PG8_MMA(0, 0, At, B0); PG8_MMA(0, 1, At, B1); PG8_BAR; PG8_SCHED;
            PG8_LDA(At, 1, 1); PG8_STAGE(PG8_SB(1, 0), b3, voffB); PG8_STAGE(PG8_SB(1, 1), b3 + hB, voffB); PG8_STAGE(PG8_SA(1, 0), a3, voffA);
            PG8_WAIT_V(8); PG8_WAIT_L(0); PG8_BAR; PG8_MMA(1, 0, At, B0); PG8_MMA(1, 1, At, B1); PG8_BAR; PG8_SCHED;
        }
        }
        if constexpr (ALIGN_EPI) { if (wr == 0) PG8_BAR; }
        E(acc, cur, wr, wc, fr, fq);
        if (!has_next) break;
#pragma unroll
        for (int a = 0; a < 2; ++a)
#pragma unroll
            for (int b = 0; b < 2; ++b)
#pragma unroll
                for (int m = 0; m < 4; ++m)
#pragma unroll
                    for (int n = 0; n < 2; ++n) acc[a][b][m][n] = (f32x4){0.f, 0.f, 0.f, 0.f};
        cur = nxt; cA = nA; cB = nB; ++ui;
        if constexpr (ALIGN_EPI) { if (wr == 1) PG8_BAR; }
    }
    PG8_WAIT_V(0);
    if constexpr (!ALIGN_EPI) { if (wr == 0) PG8_BAR; }
    PG8_BAR;
#undef PG8_SA
#undef PG8_SB
#undef PG8_STAGE
#undef PG8_LDA
#undef PG8_LDB
#undef PG8_MMA
#undef PG8_WAIT_V
#undef PG8_WAIT_L
#undef PG8_BAR
#undef PG8_SCHED
}

template <class Epi, class Sched, bool ALIGN_EPI>
__device__ __forceinline__ void gemm_phase_ref(PG8_LAS unsigned char* lds, const Dims g, const Sched& S, const Epi& E) {
    int tid_ = threadIdx.x; asm volatile("" : "+v"(tid_));
    const int tid = tid_, wid = __builtin_amdgcn_readfirstlane(tid >> 6), lane = tid & 63, wr = wid >> 2, wc = wid & 3, fr = lane & 15, fq = lane >> 4;
    typedef __bf16 bf2 __attribute__((ext_vector_type(2)));
    Unit cur;
    for (int ui = 0; S.next(ui, cur); ++ui) {
        f32x4 acc[2][2][4][2];
#pragma unroll
        for (int a = 0; a < 2; ++a)
#pragma unroll
            for (int b = 0; b < 2; ++b)
#pragma unroll
                for (int m = 0; m < 4; ++m)
#pragma unroll
                    for (int n = 0; n < 2; ++n) acc[a][b][m][n] = (f32x4){0.f, 0.f, 0.f, 0.f};
        for (int k0 = 0; k0 < g.K; k0 += 8) {
            u32x4 av[2][4];
#pragma unroll
            for (int a = 0; a < 2; ++a)
#pragma unroll
                for (int m = 0; m < 4; ++m) av[a][m] = *(const u32x4*)(cur.A + ((size_t)(128 * a + 64 * wr + 16 * m + fr) * g.lda + k0) * 2);
#pragma unroll
            for (int b = 0; b < 2; ++b)
#pragma unroll
                for (int n = 0; n < 2; ++n)
#pragma unroll
                    for (int i = 0; i < 4; ++i) {
                        const int col = Epi::PERM ? (128 * b + 32 * wc + 8 * fq + 4 * n + i) : (128 * b + 32 * wc + 16 * n + 4 * fq + i);
                        const u32x4 bv = *(const u32x4*)(cur.B + ((size_t)col * g.ldb + k0) * 2);
#pragma unroll
                        for (int a = 0; a < 2; ++a)
#pragma unroll
                            for (int m = 0; m < 4; ++m) { float s = acc[a][b][m][n][i];
                                s = __builtin_amdgcn_fdot2_f32_bf16(__builtin_bit_cast(bf2, av[a][m].x), __builtin_bit_cast(bf2, bv.x), s, false);
                                s = __builtin_amdgcn_fdot2_f32_bf16(__builtin_bit_cast(bf2, av[a][m].y), __builtin_bit_cast(bf2, bv.y), s, false);
                                s = __builtin_amdgcn_fdot2_f32_bf16(__builtin_bit_cast(bf2, av[a][m].z), __builtin_bit_cast(bf2, bv.z), s, false);
                                s = __builtin_amdgcn_fdot2_f32_bf16(__builtin_bit_cast(bf2, av[a][m].w), __builtin_bit_cast(bf2, bv.w), s, false);
                                acc[a][b][m][n][i] = s; }
                    }
        }
        E(acc, cur, wr, wc, fr, fq);
    }
}
}
#define GAS __attribute__((address_space(1)))
#define LAS __attribute__((address_space(3)))
typedef unsigned short bf16;
typedef unsigned v4u __attribute__((ext_vector_type(4)));
typedef unsigned v2u __attribute__((ext_vector_type(2)));
typedef float f32x4 __attribute__((ext_vector_type(4)));
typedef float f32x2 __attribute__((ext_vector_type(2)));
typedef short bf16x8 __attribute__((ext_vector_type(8)));
typedef __bf16 bf16x2_t __attribute__((ext_vector_type(2)));
typedef GAS unsigned gu32;
#define RLX_AGENT __ATOMIC_RELAXED, __HIP_MEMORY_SCOPE_AGENT
#define LDS_WAIT() asm volatile("s_waitcnt lgkmcnt(0)" ::: "memory")
#define VM_WAIT() asm volatile("s_waitcnt vmcnt(0)" ::: "memory")
using pg8::cvt_pk_bf16; using pg8::pack8; using pg8::unpack8; using pg8::bf_lo; using pg8::bf_hi; using pg8::sigm; using pg8::sigm4;

__device__ __forceinline__ float wave_sum(float v) {
#pragma unroll
    for (int o = 1; o < 64; o <<= 1) v += __shfl_xor(v, o);
    return v;
}
__device__ __forceinline__ float dot2bf(unsigned a, unsigned b, float acc) { return __builtin_amdgcn_fdot2_f32_bf16(__builtin_bit_cast(bf16x2_t, a), __builtin_bit_cast(bf16x2_t, b), acc, false); }

#define XB_TMO      128
#define XB_XCNT(j)  (256  + 64 * (j))
#define XB_XSUB(j)  (1280 + 64 * (j))
#define XB_XGEN(j)  (2304 + 64 * (j))
#define XB_TOP      3328
#define XB_TOPGEN   3392
#define XCD_BAR_WORDS 3456
#define XB_SPIN_CAP (1u << 18)

__device__ __forceinline__ unsigned xb_ld(unsigned* p)              { return __hip_atomic_load(p, __ATOMIC_RELAXED, __HIP_MEMORY_SCOPE_AGENT); }
__device__ __forceinline__ unsigned xb_add(unsigned* p, unsigned v) { return __hip_atomic_fetch_add(p, v, __ATOMIC_RELAXED, __HIP_MEMORY_SCOPE_AGENT); }
__device__ __forceinline__ unsigned xb_xcc_id() { return (unsigned)__builtin_amdgcn_s_getreg((3 << 11) | 20) & 0xFu; }
#define XB_SPIN(cond, bar) do { unsigned _sp = 0; while (cond) { __builtin_amdgcn_s_sleep(1); \
    if ((++_sp & 255u) == 0u) { if (xb_ld(&(bar)[XB_TMO])) break; if (_sp > XB_SPIN_CAP) { atomicAdd(&(bar)[XB_TMO], 1u); break; } } } } while (0)

struct XcdBarrier {
    unsigned* bar; unsigned x;
    volatile LAS unsigned* st;
};
__device__ __forceinline__ XcdBarrier xcd_barrier_post(unsigned* bar, volatile LAS unsigned* st) {
    XcdBarrier b; b.bar = bar; b.x = xb_xcc_id(); b.st = st;
    if (threadIdx.x == 0) (void)xb_add(&bar[XB_XCNT(b.x)], 1u);
    return b;
}
__device__ __forceinline__ void xcd_barrier_complete(unsigned* bar, unsigned x, unsigned& nloc, unsigned& nx) {
    const unsigned G = gridDim.x * gridDim.y * gridDim.z;
    unsigned sum, cnt, mine, sp = 0u;
    for (;;) {
        sum = 0u; cnt = 0u; mine = 0u;
#pragma unroll
        for (unsigned j = 0; j < 16; ++j) { const unsigned c = xb_ld(&bar[XB_XCNT(j)]); sum += c; cnt += (c > 0u) ? 1u : 0u; mine = (j == x) ? c : mine; }
        if (sum == G) break;
        __builtin_amdgcn_s_sleep(1);
        if ((++sp & 255u) == 0u) { if (xb_ld(&bar[XB_TMO])) break; if (sp > XB_SPIN_CAP) { atomicAdd(&bar[XB_TMO], 1u); break; } }
    }
    nloc = mine > 0u ? mine : 1u; nx = cnt > 0u ? cnt : 1u;
}
__device__ __forceinline__ void xcd_barrier(const XcdBarrier& b) {
    asm volatile("s_waitcnt vmcnt(0)" ::: "memory");
    __syncthreads();
    if (threadIdx.x == 0) {
        unsigned* bar = b.bar;
        __builtin_amdgcn_s_waitcnt(0);
        unsigned nloc = b.st[0], nx = b.st[1];
        if (nloc == 0u) { xcd_barrier_complete(bar, b.x, nloc, nx); b.st[0] = nloc; b.st[1] = nx; }
        const unsigned old = xb_add(&bar[XB_XSUB(b.x)], 1u);
        const unsigned gen = old / nloc;
        if (old + 1u == (gen + 1u) * nloc) {
            __builtin_amdgcn_fence(__ATOMIC_RELEASE, "agent");
            asm volatile("s_waitcnt vmcnt(0)" ::: "memory");
            const unsigned og = xb_add(&bar[XB_TOP], 1u);
            const unsigned tg = og / nx;
            if (og + 1u == (tg + 1u) * nx) xb_add(&bar[XB_TOPGEN], 1u);
            else XB_SPIN(xb_ld(&bar[XB_TOPGEN]) == tg, bar);
            __builtin_amdgcn_fence(__ATOMIC_ACQUIRE, "agent");
            xb_add(&bar[XB_XGEN(b.x)], 1u);
            asm volatile("s_waitcnt vmcnt(0)" ::: "memory");
        } else {
            XB_SPIN(xb_ld(&bar[XB_XGEN(b.x)]) == gen, bar);
            __builtin_amdgcn_fence(__ATOMIC_ACQUIRE, "agent");
            asm volatile("s_waitcnt vmcnt(0)" ::: "memory");
        }
    }
    __syncthreads();
}
constexpr int NWAVES = 8;
constexpr int BATCH = 8, SEQ = 2048, DM = 1024, M = BATCH * SEQ, DEPTH = 2, NH = 8, HD = 64, AW = 512, CW = 512, CK = 31;
constexpr int NGRP = 4, EPG = 8, NEXP = 32, FF = 512, PLE = 256, WIN = 4608;
constexpr float EPS = 1e-6f;
constexpr float QSCALE = 0.125f * 1.4426950408889634f;
constexpr int MAXROWS = 2 * M + NEXP * 256;
constexpr size_t MiB = 1u << 20;
constexpr size_t WS_CTL = 0, CTL_ZERO_BYTES = 2 * MiB;
constexpr size_t WS_COS = 2 * MiB, WS_SIN = 2 * MiB + 256 * 1024;
constexpr size_t WS_SSQ = 3 * MiB;
constexpr size_t WS_ROUTE = 10 * MiB, WS_POS = 10 * MiB + 512 * 1024, WS_RSC = 11 * MiB, WS_ROWG = 11 * MiB + 256 * 1024;
constexpr size_t WS_WR = 12 * MiB;
constexpr size_t WS_RB = 13 * MiB;
constexpr size_t WS_LG = 352 * MiB;
constexpr size_t WS_W = 16 * MiB, W_LAYER = 112 * MiB;
constexpr size_t WO_WIN = 0, WO_WAO = 9 * MiB, WO_WCO = 10 * MiB, WO_WOUT = 11 * MiB, WO_WPG = 13 * MiB, WO_WPP = 15 * MiB, WO_WGU = 16 * MiB, WO_WD = 80 * MiB;
constexpr size_t WS_XB = 240 * MiB, WS_PB = 272 * MiB, WS_PE = 288 * MiB, WS_MG = 320 * MiB;
constexpr size_t WS_Q = 352 * MiB, WS_K = 368 * MiB, WS_V = 384 * MiB, WS_U = 400 * MiB, WS_SGA = 416 * MiB, WS_SGB = 448 * MiB, WS_OC = 480 * MiB;
constexpr size_t WS_XG = 352 * MiB, WS_H = 432 * MiB, WS_Y = 352 * MiB, WS_END = 512 * MiB;
constexpr int CW_TMO = 0, CW_CODE = 1, CW_BAR = 4096, CW_CNT = 16384;
constexpr int RING_OFF = 0, RING_BYTES = 131072;
constexpr int LDSCTL_OFF = RING_BYTES, MISC_OFF = LDSCTL_OFF + 320, OFFS_OFF = LDSCTL_OFF + 1024;
constexpr int LDS_BYTES = 147456;
constexpr int PH_PER_LAYER = 10, PH_FINAL = 1 + DEPTH * PH_PER_LAYER, N_PHASES = PH_FINAL + 1;

struct Frame {
    LAS unsigned char* lds;
    volatile LAS unsigned* MISC;
    gu32* ctl;
    int tid, lane, wave, vcu, G;
    float* out; unsigned char* ws;
};
#define XCUR(L) ((L) == 0 ? WSP(bf16, WS_XB) : (bf16*)F.out)
#define XNXT(L) ((L) == 0 ? (bf16*)F.out : WSP(bf16, WS_XB))
struct Args { const float* in[24]; float* out; unsigned char* ws; int ph_lo, ph_hi, use_bar, pad; };
#define WSP(T, off) ((T*)(F.ws + (off)))

__device__ __forceinline__ void transpose_item(const float* W, int ld, int colA, int colB, const float* gain, int k0, bf16* WT, int K, int row0, LAS float* scr, int lane, int kd = 0) {
    const int kl = lane >> 4, n4 = lane & 15;
    const float* src = W + (size_t)(k0 + kl) * ld + (n4 < 8 ? colA + 4 * n4 : colB + 4 * (n4 - 8));
    f32x4 v[16];
#pragma unroll
    for (int q = 0; q < 16; ++q) v[q] = *(const GAS f32x4*)(src + (size_t)(4 * q) * ld);
#pragma unroll
    for (int q = 0; q < 16; ++q) { const int k = 4 * q + kl; if (gain) v[q] = v[q] * gain[k0 + k]; *(LAS f32x4*)(scr + k * 64 + ((4 * n4) ^ (((k >> 3) & 7) << 3))) = v[q]; }
    LDS_WAIT(); asm volatile("" ::: "memory");
    const int c = lane & 7;
#pragma unroll
    for (int j = 0; j < 8; ++j) { const int n = (lane >> 3) + 8 * j; const LAS float* s = scr + (8 * c) * 64 + (n ^ (c << 3));
        v4u o; o.x = cvt_pk_bf16(s[0 * 64], s[1 * 64]); o.y = cvt_pk_bf16(s[2 * 64], s[3 * 64]); o.z = cvt_pk_bf16(s[4 * 64], s[5 * 64]); o.w = cvt_pk_bf16(s[6 * 64], s[7 * 64]);
        *(GAS v4u*)(WT + (size_t)(row0 + n) * K + kd + k0 + 8 * c) = o; }
    LDS_WAIT(); asm volatile("" ::: "memory");
}
__device__ __forceinline__ int win_src_col(int g) {
    const int pn = g >> 3, sub = g & 7;
    if (pn < 2) return 64 * (4 * pn + (sub & 3)) + 32 * (sub >> 2);
    if (pn < 4) return 512 + 64 * (4 * (pn - 2) + (sub & 3)) + 32 * (sub >> 2);
    if (pn < 6) return 1024 + 256 * (pn - 4) + 32 * sub;
    if (pn < 10) return (sub < 4 ? 1536 : 2048) + 128 * (pn - 6) + 32 * (sub & 3);
    return 2560 + 256 * (pn - 10) + 32 * sub;
}
constexpr int IT_WIN = 72 * 16, IT_WAO = 16 * 8, IT_WCO = 16 * 8, IT_WOUT = 16 * 16, IT_WPG = 16 * 16, IT_WPP = 16 * 4, IT_WGU = 512 * 16, IT_WD = 512 * 8;
constexpr int IT_LAYER = IT_WIN + IT_WAO + IT_WCO + IT_WOUT + IT_WPG + IT_WPP + IT_WGU + IT_WD;
__device__ __forceinline__ void conv_item(Frame& F, const Args& args, int L, int it, LAS float* scr) {
    unsigned char* wl = F.ws + WS_W + (size_t)L * W_LAYER; const int lane = F.lane;
    int r = it;
    if (r < IT_WIN) { const int gp = r >> 4, kb = r & 15; transpose_item(args.in[3] + (size_t)L * DM * WIN, WIN, win_src_col(2 * gp), win_src_col(2 * gp + 1), args.in[2] + L * DM, 64 * kb, (bf16*)(wl + WO_WIN), 1024, 64 * gp, scr, lane); return; } r -= IT_WIN;
    if (r < IT_WAO) { const int gp = r >> 3, kb = r & 7; transpose_item(args.in[8] + (size_t)L * 512 * DM, DM, 64 * gp, 64 * gp + 32, nullptr, 64 * kb, (bf16*)(wl + WO_WAO), 1024, 64 * gp, scr, lane, 0); return; } r -= IT_WAO;
    if (r < IT_WCO) { const int gp = r >> 3, kb = r & 7; transpose_item(args.in[9] + (size_t)L * 512 * DM, DM, 64 * gp, 64 * gp + 32, nullptr, 64 * kb, (bf16*)(wl + WO_WAO), 1024, 64 * gp, scr, lane, 512); return; } r -= IT_WCO;
    if (r < IT_WOUT) { const int gp = r >> 4, kb = r & 15; transpose_item(args.in[11] + (size_t)L * DM * DM, DM, 64 * gp, 64 * gp + 32, nullptr, 64 * kb, (bf16*)(wl + WO_WOUT), 1024, 64 * gp, scr, lane); return; } r -= IT_WOUT;
    if (r < IT_WPG) { const int gp = r >> 4, kb = r & 15; transpose_item(args.in[22] + (size_t)L * DM * DM, DM, 64 * gp, 64 * gp + 32, args.in[20] + L * DM, 64 * kb, (bf16*)(wl + WO_WPG), 1024, 64 * gp, scr, lane); return; } r -= IT_WPG;
    if (r < IT_WPP) { const int gp = r >> 2, kb = r & 3; transpose_item(args.in[21] + (size_t)L * PLE * DM, DM, 64 * gp, 64 * gp + 32, nullptr, 64 * kb, (bf16*)(wl + WO_WPP), 256, 64 * gp, scr, lane); return; } r -= IT_WPP;
    if (r < IT_WGU) { const int gp = r >> 4, kb = r & 15, e = gp >> 4, gl = gp & 15, tile = gl >> 2, sub = gl & 3;
        const float* src = (sub < 2 ? args.in[17] : args.in[18]) + ((size_t)L * NEXP + e) * DM * FF; const int col = 128 * tile + 64 * (sub & 1);
        transpose_item(src, FF, col, col + 32, args.in[12] + L * DM, 64 * kb, (bf16*)(wl + WO_WGU), 1024, 64 * gp, scr, lane); return; } r -= IT_WGU;
    { const int gp = r >> 3, kb = r & 7, e = gp >> 4, gl = gp & 15;
        transpose_item(args.in[19] + ((size_t)L * NEXP + e) * FF * DM, DM, 64 * gl, 64 * gl + 32, nullptr, 64 * kb, (bf16*)(wl + WO_WD), 512, 64 * gp, scr, lane); }
}
__device__ __forceinline__ void p0_prologue(Frame& F, const Args& args) {
    LAS float* scr = (LAS float*)(F.lds + RING_OFF + F.wave * 16384);
    const int gw = F.vcu * NWAVES + F.wave, NGW = F.G * NWAVES, lane = F.lane;
    const int gt = (F.vcu * NWAVES + F.wave) * 64 + lane, NGT = NGW * 64;
    { bf16* XB = WSP(bf16, WS_XB); float* SSQ = WSP(float, WS_SSQ);
      for (int m = gw; m < M; m += NGW) {
          const GAS f32x4* xr = (const GAS f32x4*)(args.in[0] + (size_t)m * DM) + lane; float s = 0.f; GAS v2u* o8 = (GAS v2u*)(XB + (size_t)m * DM) + lane;
#pragma unroll
          for (int j = 0; j < 4; ++j) { const f32x4 v = xr[64 * j]; s += (v[0] * v[0] + v[1] * v[1]) + (v[2] * v[2] + v[3] * v[3]); v2u w; w.x = cvt_pk_bf16(v[0], v[1]); w.y = cvt_pk_bf16(v[2], v[3]); o8[64 * j] = w; }
          const float tot = wave_sum(s);
          if (lane < 16) SSQ[(size_t)m * 16 + lane] = lane == 0 ? tot : 0.f;
      } }
    { const GAS f32x4* ps = (const GAS f32x4*)args.in[1]; GAS v4u* pb = (GAS v4u*)WSP(bf16, WS_PB);
      for (int i = gt; i < DEPTH * M * PLE / 8; i += NGT) { const f32x4 a = ps[2 * i], b = ps[2 * i + 1]; pb[i] = pack8(a, b); } }
    { float* ct = WSP(float, WS_COS); float* st = WSP(float, WS_SIN);
      for (int i = gt; i < SEQ * 32; i += NGT) { const int pos = i >> 5, k = i & 31; const float inv = powf(10000.0f, -(float)(2 * k) / 64.0f); const float ang = (float)pos * inv; ct[i] = cosf(ang); st[i] = sinf(ang); } }
    { bf16* wr = WSP(bf16, WS_WR);
      for (int i = gt; i < DEPTH * 256 * DM; i += NGT) { const int L = i >> 18, j = (i >> 10) & 255, k = i & 1023; float v = 0.f;
          if (j < 4) v = args.in[13][((size_t)L * DM + k) * NGRP + j]; else if (j < 36) v = args.in[15][((size_t)L * DM + k) * NEXP + (j - 4)];
          if (j < 36) v *= args.in[12][L * DM + k];
          wr[i] = (bf16)(cvt_pk_bf16(v, 0.f) & 0xffffu); }
      float* rb = WSP(float, WS_RB);
      for (int i = gt; i < DEPTH * 64; i += NGT) { const int L = i >> 6, j = i & 63; rb[i] = j < 4 ? args.in[14][L * NGRP + j] : (j < 36 ? args.in[16][L * NEXP + j - 4] : 0.f); } }
    for (int it = gw; it < DEPTH * IT_LAYER; it += NGW) { const int L = it >= IT_LAYER ? 1 : 0; conv_item(F, args, L, it - L * IT_LAYER, scr); }
}

struct SchedGrid {
    int nM, nN, G, c; const char* Ab; const char* Bb; size_t astep, bstep;
    __device__ __forceinline__ bool next(int i, pg8::Unit& u) const {
        const int L = i * G + c; if (L >= nM * nN) return false;
        pg8::tile_of(L, nM, nN, u.pm, u.pn); u.aux = 0; u.A = Ab + (size_t)u.pm * astep; u.B = Bb + (size_t)u.pn * bstep; return true; }
};
struct SchedP3 {
    int G, c; const char* OC; const char* Wa; const char* Wc;
    __device__ __forceinline__ bool next(int i, pg8::Unit& u) const {
        const int T = (i >> 1) * G + c; if (T >= 256) return false;
        pg8::tile_of(T, 64, 4, u.pm, u.pn); u.aux = i & 1;
        u.A = OC + (size_t)u.pm * (256 * 1024 * 2) + (u.aux ? 512 * 2 : 0); u.B = (u.aux ? Wc : Wa) + (size_t)u.pn * (256 * 512 * 2); return true; }
};
struct SchedMoe {
    const volatile LAS int* offs; int G, c, up; const char* Ab; const char* Bb;
    __device__ __forceinline__ bool next(int i, pg8::Unit& u) const {
        const int NB = offs[32] >> 8, L = i * G + c; if (L >= NB * 4) return false;
        const int mb = L >> 2, pn = L & 3; int e = 0;
        while (e < 31 && offs[e + 1] <= mb * 256) ++e;
        u.pm = mb; u.pn = pn; u.aux = e;
        if (up) { u.A = Ab + (size_t)mb * (256 * 1024 * 2); u.B = Bb + ((size_t)e * 1024 + pn * 256) * (1024 * 2); }
        else    { u.A = Ab + (size_t)mb * (256 * 512 * 2);  u.B = Bb + ((size_t)e * 1024 + pn * 256) * (512 * 2); }
        return true; }
};

using pg8::f32x4;
#define EPI_FOR_ROWS _Pragma("unroll") for (int ai = 0; ai < 2; ++ai) _Pragma("unroll") for (int m = 0; m < 4; ++m)
#define EPI_ROW (u.pm * 256 + ai * 128 + wr * 64 + m * 16 + fr)
__device__ __forceinline__ float rscale_of(const float* ssq, int row) {
    const f32x4* sp = (const f32x4*)(ssq + (size_t)row * 16); const f32x4 a = sp[0], b = sp[1], c = sp[2], d = sp[3];
    const float s = ((a[0] + a[1]) + (a[2] + a[3])) + ((b[0] + b[1]) + (b[2] + b[3])) + ((c[0] + c[1]) + (c[2] + c[3])) + ((d[0] + d[1]) + (d[2] + d[3]));
    return rsqrtf(s * (1.0f / DM) + EPS);
}
struct EpiP1 {
    static constexpr bool PERM = true, MIDK = false;
    const float* ssq; const float* cosT; const float* sinT; bf16 *Q, *K, *V, *U, *SGA, *SGB;
    __device__ __forceinline__ void operator()(const f32x4 (&acc)[2][2][4][2], const pg8::Unit& u, int wr, int wc, int fr, int fq) const {
        const int pn = u.pn;
        EPI_FOR_ROWS { const int row = EPI_ROW;
            const float r = rscale_of(ssq, row); const int b = row >> 11, t = row & 2047;
            if (pn < 4) {
                const int head = 4 * (pn & 1) + wc; const float qs = pn < 2 ? QSCALE : 1.0f;
                const f32x4* cp = (const f32x4*)(cosT + t * 32 + 8 * fq); const f32x4* sp = (const f32x4*)(sinT + t * 32 + 8 * fq);
                f32x4 o1[2], o2[2];
#pragma unroll
                for (int n = 0; n < 2; ++n) { const f32x4 c = cp[n], s = sp[n], t1 = acc[ai][0][m][n] * (r * qs), t2 = acc[ai][1][m][n] * (r * qs); o1[n] = t1 * c - t2 * s; o2[n] = t1 * s + t2 * c; }
                bf16* dst = (pn < 2 ? Q : K) + ((size_t)(b * NH + head) * SEQ + t) * HD + 8 * fq;
                *(v4u*)dst = pack8(o1[0], o1[1]); *(v4u*)(dst + 32) = pack8(o2[0], o2[1]);
            } else if (pn < 6) {
#pragma unroll
                for (int bj = 0; bj < 2; ++bj) { const int head = 4 * (pn - 4) + 2 * bj + (wc >> 1), dim = 32 * (wc & 1) + 8 * fq;
                    *(v4u*)(V + ((size_t)(b * NH + head) * SEQ + t) * HD + dim) = pack8(acc[ai][bj][m][0] * r, acc[ai][bj][m][1] * r); }
            } else if (pn < 10) {
                f32x4 o[2];
#pragma unroll
                for (int n = 0; n < 2; ++n) o[n] = (acc[ai][0][m][n] * r) * sigm4(acc[ai][1][m][n] * r);
                *(v4u*)(U + (size_t)row * CW + 128 * (pn - 6) + 32 * wc + 8 * fq) = pack8(o[0], o[1]);
            } else {
                bf16* base = (pn < 14 ? SGA + 256 * (pn - 10) : SGB + 256 * (pn - 14)) + (size_t)row * DM + 32 * wc + 8 * fq;
#pragma unroll
                for (int bj = 0; bj < 2; ++bj) *(v4u*)(base + 128 * bj) = pack8(sigm4(acc[ai][bj][m][0] * r), sigm4(acc[ai][bj][m][1] * r));
            }
        }
    }
};
struct EpiP3 {
    static constexpr bool PERM = true, MIDK = true;
    const bf16* SGA; const bf16* SGB; const float* bco; bf16* MG;
    __device__ __forceinline__ void mid(f32x4 (&acc)[2][2][4][2], const pg8::Unit& u, int wr, int wc, int fr, int fq) const {
        int z_ = 0; asm volatile("" : "+v"(z_));
#pragma unroll
        for (int ai = 0; ai < 2; ++ai)
#pragma unroll
            for (int m = 0; m < 4; ++m) { const int row = EPI_ROW + z_;
                v4u a[2], b[2];
#pragma unroll
                for (int bj = 0; bj < 2; ++bj) { const size_t off = (size_t)row * DM + u.pn * 256 + 128 * bj + 32 * wc + 8 * fq; a[bj] = *(const v4u*)(SGA + off); b[bj] = *(const v4u*)(SGB + off); }
#pragma unroll
                for (int bj = 0; bj < 2; ++bj) {
                    acc[ai][bj][m][0][0] *= bf_lo(a[bj].x) * __builtin_amdgcn_rcpf(bf_lo(b[bj].x)); acc[ai][bj][m][0][1] *= bf_hi(a[bj].x) * __builtin_amdgcn_rcpf(bf_hi(b[bj].x));
                    acc[ai][bj][m][0][2] *= bf_lo(a[bj].y) * __builtin_amdgcn_rcpf(bf_lo(b[bj].y)); acc[ai][bj][m][0][3] *= bf_hi(a[bj].y) * __builtin_amdgcn_rcpf(bf_hi(b[bj].y));
                    acc[ai][bj][m][1][0] *= bf_lo(a[bj].z) * __builtin_amdgcn_rcpf(bf_lo(b[bj].z)); acc[ai][bj][m][1][1] *= bf_hi(a[bj].z) * __builtin_amdgcn_rcpf(bf_hi(b[bj].z));
                    acc[ai][bj][m][1][2] *= bf_lo(a[bj].w) * __builtin_amdgcn_rcpf(bf_lo(b[bj].w)); acc[ai][bj][m][1][3] *= bf_hi(a[bj].w) * __builtin_amdgcn_rcpf(bf_hi(b[bj].w)); }
                if (m & 1) asm volatile("" ::: "memory");
            }
    }
    __device__ __forceinline__ void operator()(const f32x4 (&acc)[2][2][4][2], const pg8::Unit& u, int wr, int wc, int fr, int fq) const {
        EPI_FOR_ROWS { const int row = EPI_ROW;
#pragma unroll
            for (int bj = 0; bj < 2; ++bj) { const int col = u.pn * 256 + 128 * bj + 32 * wc + 8 * fq; const size_t off = (size_t)row * DM + col;
                f32x4 g0, g1; unpack8(*(const v4u*)(SGB + off), g0, g1);
                const f32x4 b0 = *(const f32x4*)(bco + col), b1 = *(const f32x4*)(bco + col + 4);
                *(v4u*)(MG + off) = pack8(g0 * (acc[ai][bj][m][0] + b0), g1 * (acc[ai][bj][m][1] + b1)); }
        }
    }
};
#define RESID_STORE(DELTA0, DELTA1) { f32x4 x0, x1; unpack8(*(const v4u*)(XI + off), x0, x1); const f32x4 v0 = x0 + (DELTA0), v1 = x1 + (DELTA1); \
        *(v4u*)(XO + off) = pack8(v0, v1); \
        ss += ((v0[0] * v0[0] + v0[1] * v0[1]) + (v0[2] * v0[2] + v0[3] * v0[3])) + ((v1[0] * v1[0] + v1[1] * v1[1]) + (v1[2] * v1[2] + v1[3] * v1[3])); }
#define SSQ_STORE() { ss += __shfl_xor(ss, 16); ss += __shfl_xor(ss, 32); if (fq == 0) ssq_out[(size_t)row * 16 + u.pn * 4 + wc] = ss; }
struct EpiP4 {
    static constexpr bool PERM = true, MIDK = false;
    const bf16* XI; bf16* XO; float* ssq_out;
    __device__ __forceinline__ void operator()(const f32x4 (&acc)[2][2][4][2], const pg8::Unit& u, int wr, int wc, int fr, int fq) const {
        EPI_FOR_ROWS { const int row = EPI_ROW;
            float ss = 0.f;
#pragma unroll
            for (int bj = 0; bj < 2; ++bj) { const size_t off = (size_t)row * DM + u.pn * 256 + 128 * bj + 32 * wc + 8 * fq; RESID_STORE(acc[ai][bj][m][0], acc[ai][bj][m][1]) }
            SSQ_STORE()
        }
    }
};
struct EpiP8 {
    static constexpr bool PERM = true, MIDK = false;
    const float* ssq_in; const bf16* PE; const bf16* XI; bf16* XO; float* ssq_out;
    __device__ __forceinline__ void operator()(const f32x4 (&acc)[2][2][4][2], const pg8::Unit& u, int wr, int wc, int fr, int fq) const {
        EPI_FOR_ROWS { const int row = EPI_ROW;
            const float r = rscale_of(ssq_in, row); float ss = 0.f;
#pragma unroll
            for (int bj = 0; bj < 2; ++bj) { const size_t off = (size_t)row * DM + u.pn * 256 + 128 * bj + 32 * wc + 8 * fq;
                f32x4 p0, p1; unpack8(*(const v4u*)(PE + off), p0, p1);
                RESID_STORE(sigm4(acc[ai][bj][m][0] * r) * p0, sigm4(acc[ai][bj][m][1] * r) * p1) }
            SSQ_STORE()
        }
    }
};
struct EpiBf16 {
    static constexpr bool PERM = true, MIDK = false;
    bf16* O; int ldc;
    __device__ __forceinline__ void operator()(const f32x4 (&acc)[2][2][4][2], const pg8::Unit& u, int wr, int wc, int fr, int fq) const {
        EPI_FOR_ROWS { const int row = EPI_ROW;
#pragma unroll
            for (int bj = 0; bj < 2; ++bj) *(v4u*)(O + (size_t)row * ldc + u.pn * 256 + 128 * bj + 32 * wc + 8 * fq) = pack8(acc[ai][bj][m][0], acc[ai][bj][m][1]);
        }
    }
};
struct EpiUp {
    static constexpr bool PERM = true, MIDK = false;
    const float* RSC; bf16* H;
    __device__ __forceinline__ void operator()(const f32x4 (&acc)[2][2][4][2], const pg8::Unit& u, int wr, int wc, int fr, int fq) const {
        EPI_FOR_ROWS { const int row = EPI_ROW;
            const float r = RSC[row]; f32x4 o[2];
#pragma unroll
            for (int n = 0; n < 2; ++n) { const f32x4 g = acc[ai][0][m][n] * r; o[n] = g * sigm4(g) * (acc[ai][1][m][n] * r); }
            *(v4u*)(H + (size_t)row * FF + 128 * u.pn + 32 * wc + 8 * fq) = pack8(o[0], o[1]);
        }
    }
};
struct EpiDown {
    static constexpr bool PERM = true, MIDK = false;
    const float* ROWG; bf16* Y;
    __device__ __forceinline__ void operator()(const f32x4 (&acc)[2][2][4][2], const pg8::Unit& u, int wr, int wc, int fr, int fq) const {
        EPI_FOR_ROWS { const int row = EPI_ROW;
            const float gt = ROWG[row];
#pragma unroll
            for (int bj = 0; bj < 2; ++bj) *(v4u*)(Y + (size_t)row * DM + u.pn * 256 + 128 * bj + 32 * wc + 8 * fq) = pack8(acc[ai][bj][m][0] * gt, acc[ai][bj][m][1] * gt);
        }
    }
};


struct EpiRoute {
    static constexpr bool PERM = true, MIDK = false;
    const float* ssq; const float* bias; float* LG;
    __device__ __forceinline__ void operator()(const f32x4 (&acc)[2][2][4][2], const pg8::Unit& u, int wr, int wc, int fr, int fq) const {
        if (wc < 2) {
            const f32x4 b0 = *(const f32x4*)(bias + 32 * wc + 8 * fq), b1 = *(const f32x4*)(bias + 32 * wc + 8 * fq + 4);
            EPI_FOR_ROWS { const int row = EPI_ROW; const float r = rscale_of(ssq, row);
                float* dst = LG + (size_t)row * 64 + 32 * wc + 8 * fq;
                *(f32x4*)dst = acc[ai][0][m][0] * r + b0; *(f32x4*)(dst + 4) = acc[ai][0][m][1] * r + b1; }
        }
    }
};
__device__ __forceinline__ void route_decide(Frame& F, int L, int pm) {
    if (F.tid < 256) {
        const int t = pm * 256 + F.tid;
        const float* lp = WSP(float, WS_LG) + (size_t)t * 64; const float* SSQ = WSP(float, WS_SSQ + (size_t)(3 * L + 1) * MiB);
        int* ROUTE = WSP(int, WS_ROUTE); unsigned* cnt = (unsigned*)(F.ctl + CW_CNT + 64 * L);
        const f32x4 g4 = *(const f32x4*)lp;
        float mxv = g4[0]; int gs = 0;
#pragma unroll
        for (int i = 1; i < 4; ++i) if (g4[i] > mxv) { mxv = g4[i]; gs = i; }
        float se = 0.f;
#pragma unroll
        for (int i = 0; i < 4; ++i) se += __expf(g4[i] - mxv);
        const float pg = 1.0f / se;
        const f32x4 e0 = *(const f32x4*)(lp + 4 + gs * 8), e1 = *(const f32x4*)(lp + 8 + gs * 8);
        float v1 = -1e30f, v2 = -1e30f; int i1 = 0, i2 = 0;
#pragma unroll
        for (int i = 0; i < 8; ++i) { const float v = i < 4 ? e0[i] : e1[i - 4]; if (v > v1) { v2 = v1; i2 = i1; v1 = v; i1 = i; } else if (v > v2) { v2 = v; i2 = i; } }
        const float e2 = __expf(v2 - v1), s1 = 1.0f / (1.0f + e2);
        const int ea = gs * 8 + i1, eb = gs * 8 + i2;
        const unsigned ia = atomicAdd(cnt + ea, 1u), ib = atomicAdd(cnt + eb, 1u);
        v4u r0, r1; r0.x = (unsigned)ea; r0.y = (unsigned)eb; r0.z = ia; r0.w = ib; r1.x = __float_as_uint(pg * s1); r1.y = __float_as_uint(pg * e2 * s1); r1.z = __float_as_uint(rscale_of(SSQ, t)); r1.w = 0u;
        *(GAS v4u*)(ROUTE + (size_t)t * 8) = r0; *(GAS v4u*)(ROUTE + (size_t)t * 8 + 4) = r1;
    }
}


struct SchedRouteP {
    int G, c; const char* Xb; const char* Wb;
    __device__ __forceinline__ bool next(int i, pg8::Unit& u) const {
        const int L = i * G + c; if (L >= 256) return false;
        pg8::tile_of(L, 64, 4, u.pm, u.pn); u.aux = 0; u.A = Xb + (size_t)u.pm * (256 * 1024 * 2) + u.pn * 512; u.B = Wb + u.pn * 512; return true; }
};
struct EpiRouteP {
    static constexpr bool PERM = true, MIDK = false;
    float* LGP;
    __device__ __forceinline__ void operator()(const f32x4 (&acc)[2][2][4][2], const pg8::Unit& u, int wr, int wc, int fr, int fq) const {
        if (wc < 2) {
            EPI_FOR_ROWS { const int row = EPI_ROW; float* dst = LGP + ((size_t)u.pn * M + row) * 64 + 32 * wc + 8 * fq;
                *(f32x4*)dst = acc[ai][0][m][0]; *(f32x4*)(dst + 4) = acc[ai][0][m][1]; }
        }
    }
};
__device__ __forceinline__ void decide_phase(Frame& F, int L) {
    volatile LAS unsigned* lcnt = (volatile LAS unsigned*)(F.lds + RING_OFF);
    const float* LGP = WSP(float, WS_LG); const float* SSQ = WSP(float, WS_SSQ + (size_t)(3 * L + 1) * MiB); const float* rb = WSP(float, WS_RB) + L * 64;
    int* ROUTE = WSP(int, WS_ROUTE); unsigned* cnt = (unsigned*)(F.ctl + CW_CNT + 64 * L);
    for (int blk = F.vcu; blk < M / 64; blk += F.G) {
        if (F.tid < 64) lcnt[F.tid] = 0u;
        __syncthreads();
        int ea = 0, eb = 0; unsigned ra = 0, rbk = 0; float g1 = 0.f, g2 = 0.f, rr = 0.f; const int t = blk * 64 + F.tid;
        if (F.tid < 64) {
            rr = rscale_of(SSQ, t);
            float lg[36];
#pragma unroll
            for (int q = 0; q < 9; ++q) { f32x4 a = *(const f32x4*)(LGP + (size_t)t * 64 + 4 * q);
#pragma unroll
                for (int p = 1; p < 4; ++p) a = a + *(const f32x4*)(LGP + ((size_t)p * M + t) * 64 + 4 * q);
                const f32x4 b = *(const f32x4*)(rb + 4 * q); a = a * rr + b; lg[4 * q] = a[0]; lg[4 * q + 1] = a[1]; lg[4 * q + 2] = a[2]; lg[4 * q + 3] = a[3]; }
            float mxv = lg[0]; int gs = 0;
#pragma unroll
            for (int i = 1; i < 4; ++i) if (lg[i] > mxv) { mxv = lg[i]; gs = i; }
            float se = 0.f;
#pragma unroll
            for (int i = 0; i < 4; ++i) se += __expf(lg[i] - mxv);
            const float pg = 1.0f / se;
            float v1 = -1e30f, v2 = -1e30f; int i1 = 0, i2 = 0;
#pragma unroll
            for (int g = 0; g < 4; ++g) if (g == gs) {
#pragma unroll
                for (int i = 0; i < 8; ++i) { const float v = lg[4 + 8 * g + i]; if (v > v1) { v2 = v1; i2 = i1; v1 = v; i1 = i; } else if (v > v2) { v2 = v; i2 = i; } } }
            const float e2 = __expf(v2 - v1), s1 = 1.0f / (1.0f + e2);
            ea = gs * 8 + i1; eb = gs * 8 + i2; g1 = pg * s1; g2 = pg * e2 * s1;
            ra = __hip_atomic_fetch_add((LAS unsigned*)lcnt + ea, 1u, __ATOMIC_RELAXED, __HIP_MEMORY_SCOPE_WORKGROUP); rbk = __hip_atomic_fetch_add((LAS unsigned*)lcnt + eb, 1u, __ATOMIC_RELAXED, __HIP_MEMORY_SCOPE_WORKGROUP);
        }
        __syncthreads();
        if (F.tid < 32) { const unsigned n = lcnt[F.tid]; lcnt[32 + F.tid] = n ? atomicAdd(cnt + F.tid, n) : 0u; }
        __syncthreads();
        if (F.tid < 64) {
            v4u r0, r1; r0.x = (unsigned)ea; r0.y = (unsigned)eb; r0.z = lcnt[32 + ea] + ra; r0.w = lcnt[32 + eb] + rbk; r1.x = __float_as_uint(g1); r1.y = __float_as_uint(g2); r1.z = __float_as_uint(rr); r1.w = 0u;
            *(GAS v4u*)(ROUTE + (size_t)t * 8) = r0; *(GAS v4u*)(ROUTE + (size_t)t * 8 + 4) = r1;
        }
        __syncthreads();
    }
}

__device__ __forceinline__ void attn_simple(Frame& F) {
    const bf16* Q = WSP(bf16, WS_Q); const bf16* Kb = WSP(bf16, WS_K); const bf16* Vb = WSP(bf16, WS_V); bf16* OC = WSP(bf16, WS_OC);
    const int lane = F.lane;
    for (int unit = F.vcu * NWAVES + F.wave; unit < BATCH * NH * (SEQ / 64); unit += F.G * NWAVES) {
        const int bh = unit >> 5, t = ((unit & 31) << 6) + lane;
        unsigned qw[32];
        { const GAS v4u* qp = (const GAS v4u*)(Q + ((size_t)bh * SEQ + t) * HD);
#pragma unroll
          for (int i = 0; i < 8; ++i) { const v4u w = qp[i]; qw[4 * i] = w.x; qw[4 * i + 1] = w.y; qw[4 * i + 2] = w.z; qw[4 * i + 3] = w.w; } }
        float o[64];
#pragma unroll
        for (int i = 0; i < 64; ++i) o[i] = 0.f;
        float mx = -1e30f, l = 0.f;
        for (int g = 0; g < 3; ++g) {
            const int d = g == 0 ? 1 : (g == 1 ? 4 : 16);
            for (int j0 = 0; j0 <= 128; j0 += 4) {
                if (!__any(t - j0 * d >= 0)) break;
                float s[4]; int pc[4];
#pragma unroll
                for (int c = 0; c < 4; ++c) { const int j = j0 + c, pos = t - j * d; const bool valid = pos >= 0 && j <= 128; pc[c] = valid ? pos : t;
                    const GAS v4u* kp = (const GAS v4u*)(Kb + ((size_t)bh * SEQ + pc[c]) * HD); float a = 0.f;
#pragma unroll
                    for (int i = 0; i < 8; ++i) { const v4u w = kp[i]; a = dot2bf(qw[4 * i], w.x, a); a = dot2bf(qw[4 * i + 1], w.y, a); a = dot2bf(qw[4 * i + 2], w.z, a); a = dot2bf(qw[4 * i + 3], w.w, a); }
                    s[c] = valid ? a : -1e30f; }
                const float mc = fmaxf(fmaxf(s[0], s[1]), fmaxf(s[2], s[3])), mn = fmaxf(mx, mc), sc = __builtin_amdgcn_exp2f(mx - mn);
                l *= sc;
#pragma unroll
                for (int i = 0; i < 64; ++i) o[i] *= sc;
                mx = mn;
#pragma unroll
                for (int c = 0; c < 4; ++c) { const float p = __builtin_amdgcn_exp2f(s[c] - mn); l += p;
                    const GAS v4u* vp = (const GAS v4u*)(Vb + ((size_t)bh * SEQ + pc[c]) * HD);
#pragma unroll
                    for (int i = 0; i < 8; ++i) { const v4u w = vp[i];
                        o[8 * i + 0] += p * bf_lo(w.x); o[8 * i + 1] += p * bf_hi(w.x); o[8 * i + 2] += p * bf_lo(w.y); o[8 * i + 3] += p * bf_hi(w.y);
                        o[8 * i + 4] += p * bf_lo(w.z); o[8 * i + 5] += p * bf_hi(w.z); o[8 * i + 6] += p * bf_lo(w.w); o[8 * i + 7] += p * bf_hi(w.w); } }
            }
        }
        const float inv = 1.0f / l; const int b = bh >> 3, h = bh & 7;
        GAS v4u* op = (GAS v4u*)(OC + ((size_t)(b * SEQ + t)) * DM + h * HD);
#pragma unroll
        for (int i = 0; i < 8; ++i) { v4u w; w.x = cvt_pk_bf16(o[8 * i] * inv, o[8 * i + 1] * inv); w.y = cvt_pk_bf16(o[8 * i + 2] * inv, o[8 * i + 3] * inv); w.z = cvt_pk_bf16(o[8 * i + 4] * inv, o[8 * i + 5] * inv); w.w = cvt_pk_bf16(o[8 * i + 6] * inv, o[8 * i + 7] * inv); op[i] = w; }
    }
}

typedef float f32x16 __attribute__((ext_vector_type(16)));
typedef short v4i16_t __attribute__((ext_vector_type(4)));
struct AttnStep { int p0, st, mode, T; };
__device__ __forceinline__ void attn_desc(int idx, int qb, int c, int i, int hi, int n1, int n0, int nb2, AttnStep& d) {
    if (idx < n1) { const int kb = qb - idx; d.p0 = 128 * kb + c; d.st = 4; d.mode = (idx == 0) ? 2 : ((idx == 4) ? 1 : 0); d.T = i - 4 * hi; }
    else if (idx < n1 + n0) { const int kb = (qb ? 0 : 4) + (idx - n1); d.st = 1;
        if (kb < 4) { d.p0 = 128 * (qb - 1) + 32 * kb; d.mode = 1; d.T = 4 * i + c - 32 * kb - 4 * hi; }
        else { d.p0 = 128 * qb + 32 * (kb - 4); d.mode = 2; d.T = 4 * i + c - 32 * (kb - 4) - 4 * hi; } }
    else { const int e = idx - n1 - n0, a = e / nb2, kb = e - a * nb2; d.p0 = 512 * kb + 4 * a + c; d.st = 16; d.mode = 2; d.T = ((i & 3) == a) ? (8 * qb + (i >> 2) - 32 * kb - 4 * hi) : -100; }
}
__device__ __forceinline__ void attn_dma(LAS unsigned char* slot, const bf16* Kh, const bf16* Vh, int p0, int st, int lane) {
    const int rl = lane >> 3, pos = lane & 7;
#pragma unroll
    for (int pc = 0; pc < 4; ++pc) {
        const int row = 8 * pc + rl; const size_t rowoff = (size_t)(p0 + st * row) * HD;
        const int chk = pos ^ ((row >> 1) & 7);
        const int chv = (((pos >> 1) ^ (((row >> 1) & 1) << 1)) << 1) | (pos & 1);
        __builtin_amdgcn_global_load_lds((const unsigned*)(Kh + rowoff + chk * 8), (LAS unsigned*)(slot + pc * 1024), 16, 0, 0);
        __builtin_amdgcn_global_load_lds((const unsigned*)(Vh + rowoff + chv * 8), (LAS unsigned*)(slot + 4096 + pc * 1024), 16, 0, 0);
    }
}
__device__ __forceinline__ void attn_mfma(Frame& F) {
    const bf16* Q = WSP(bf16, WS_Q); const bf16* Kb = WSP(bf16, WS_K); const bf16* Vb = WSP(bf16, WS_V); bf16* OC = WSP(bf16, WS_OC);
    const int lane = F.lane, i = lane & 31, hi = lane >> 5;
    LAS unsigned char* ring = F.lds + RING_OFF + F.wave * 16384;
    int koff[4];
#pragma unroll
    for (int s = 0; s < 4; ++s) koff[s] = i * 128 + (((2 * s + hi) ^ ((i >> 1) & 7)) << 4);
    const int g2 = (lane >> 4) & 1, q4 = (lane & 15) >> 2, p4 = lane & 3;
    int voff[2][2];
#pragma unroll
    for (int s = 0; s < 2; ++s)
#pragma unroll
        for (int db = 0; db < 2; ++db) { const int row = 16 * s + 4 * hi + q4; voff[s][db] = 4096 + row * 128 + (((2 * db + g2) ^ (((row >> 1) & 1) << 1)) << 5) + p4 * 8; }
    for (int pass = 0; pass < 2; ++pass) {
        const int gw = F.vcu * NWAVES + F.wave;
        const int T = pass == 0 ? gw : (BATCH * NH * 4 * 16 - 1 - gw);
        if (gw >= BATCH * NH * 4 * 16 / 2) break;
        const int qb = T & 15, c = (T >> 4) & 3, bh = T >> 6;
        const bf16* Kh = Kb + (size_t)bh * SEQ * HD; const bf16* Vh = Vb + (size_t)bh * SEQ * HD;
        const int tq = 128 * qb + 4 * i + c;
        bf16x8 qf[4];
        { const GAS bf16x8* qp = (const GAS bf16x8*)(Q + ((size_t)bh * SEQ + tq) * HD + 8 * hi);
#pragma unroll
          for (int s = 0; s < 4; ++s) qf[s] = qp[2 * s]; }
        const int n1 = (qb < 4 ? qb : 4) + 1, n0 = qb ? 8 : 4, nb2 = (qb >> 2) + 1, nsteps = n1 + n0 + 4 * nb2;
        f32x16 o0, o1;
#pragma unroll
        for (int r = 0; r < 16; ++r) { o0[r] = 0.f; o1[r] = 0.f; }
        float mrun = -1e30f, lrun = 0.f;
        AttnStep cur; attn_desc(0, qb, c, i, hi, n1, n0, nb2, cur);
        attn_dma(ring, Kh, Vh, cur.p0, cur.st, lane);
        for (int idx = 0; idx < nsteps; ++idx) {
            LAS unsigned char* slot = ring + (idx & 1) * 8192;
            AttnStep nxt = cur;
            if (idx + 1 < nsteps) { attn_desc(idx + 1, qb, c, i, hi, n1, n0, nb2, nxt); attn_dma(ring + ((idx + 1) & 1) * 8192, Kh, Vh, nxt.p0, nxt.st, lane); asm volatile("s_waitcnt vmcnt(8)" ::: "memory"); }
            else { asm volatile("s_waitcnt vmcnt(0)" ::: "memory"); }
            f32x16 sacc;
#pragma unroll
            for (int r = 0; r < 16; ++r) sacc[r] = 0.f;
#pragma unroll
            for (int s = 0; s < 4; ++s) { const bf16x8 kf = *(const LAS bf16x8*)(slot + koff[s]); sacc = __builtin_amdgcn_mfma_f32_32x32x16_bf16(kf, qf[s], sacc, 0, 0, 0); }
            if (cur.mode == 1) {
#pragma unroll
                for (int r = 0; r < 16; ++r) sacc[r] = ((r & 3) + 8 * (r >> 2) >= cur.T) ? sacc[r] : -1e30f;
            } else if (cur.mode == 2) {
#pragma unroll
                for (int r = 0; r < 16; ++r) sacc[r] = ((r & 3) + 8 * (r >> 2) <= cur.T) ? sacc[r] : -1e30f;
            }
            float mloc = sacc[0];
#pragma unroll
            for (int r = 1; r < 16; ++r) mloc = fmaxf(mloc, sacc[r]);
            { auto rr = __builtin_amdgcn_permlane32_swap(__float_as_uint(mloc), __float_as_uint(mloc), false, false); mloc = fmaxf(__uint_as_float(rr[0]), __uint_as_float(rr[1])); }
            const float mnew = fmaxf(mrun, mloc), alpha = __builtin_amdgcn_exp2f(mrun - mnew);
            mrun = mnew;
            float psum = 0.f;
#pragma unroll
            for (int r = 0; r < 16; ++r) { sacc[r] = __builtin_amdgcn_exp2f(sacc[r] - mnew); psum += sacc[r]; }
            lrun = lrun * alpha + psum;
#pragma unroll
            for (int r = 0; r < 16; ++r) { o0[r] *= alpha; o1[r] *= alpha; }
            bf16x8 pf[2];
#pragma unroll
            for (int s = 0; s < 2; ++s) { v4u w; w.x = cvt_pk_bf16(sacc[8 * s], sacc[8 * s + 1]); w.y = cvt_pk_bf16(sacc[8 * s + 2], sacc[8 * s + 3]); w.z = cvt_pk_bf16(sacc[8 * s + 4], sacc[8 * s + 5]); w.w = cvt_pk_bf16(sacc[8 * s + 6], sacc[8 * s + 7]); pf[s] = __builtin_bit_cast(bf16x8, w); }
#pragma unroll
            for (int s = 0; s < 2; ++s)
#pragma unroll
                for (int db = 0; db < 2; ++db) {
                    const v4i16_t lo = __builtin_amdgcn_ds_read_tr16_b64_v4i16((LAS v4i16_t*)(slot + voff[s][db]));
                    const v4i16_t hh = __builtin_amdgcn_ds_read_tr16_b64_v4i16((LAS v4i16_t*)(slot + voff[s][db] + 8 * 128));
                    const bf16x8 vf = (bf16x8){lo[0], lo[1], lo[2], lo[3], hh[0], hh[1], hh[2], hh[3]};
                    if (db == 0) o0 = __builtin_amdgcn_mfma_f32_32x32x16_bf16(vf, pf[s], o0, 0, 0, 0); else o1 = __builtin_amdgcn_mfma_f32_32x32x16_bf16(vf, pf[s], o1, 0, 0, 0);
                }
            cur = nxt;
        }
        { auto rr = __builtin_amdgcn_permlane32_swap(__float_as_uint(lrun), __float_as_uint(lrun), false, false); lrun = __uint_as_float(rr[0]) + __uint_as_float(rr[1]); }
        const float inv = 1.0f / lrun; const int b = bh >> 3, h = bh & 7;
        bf16* op = OC + ((size_t)(b * SEQ + tq)) * DM + h * HD + 4 * hi;
#pragma unroll
        for (int g = 0; g < 4; ++g) {
            v2u w0, w1; w0.x = cvt_pk_bf16(o0[4 * g] * inv, o0[4 * g + 1] * inv); w0.y = cvt_pk_bf16(o0[4 * g + 2] * inv, o0[4 * g + 3] * inv);
            w1.x = cvt_pk_bf16(o1[4 * g] * inv, o1[4 * g + 1] * inv); w1.y = cvt_pk_bf16(o1[4 * g + 2] * inv, o1[4 * g + 3] * inv);
            *(GAS v2u*)(op + 8 * g) = w0; *(GAS v2u*)(op + 32 + 8 * g) = w1; }
    }
    asm volatile("s_waitcnt vmcnt(0)" ::: "memory");
}

__device__ __forceinline__ void conv_simple(Frame& F, const Args& args, int L) {
    LAS float* ybuf = (LAS float*)(F.lds + RING_OFF); LAS float* stats = ybuf + 16 * 512;
    const bf16* U = WSP(bf16, WS_U); bf16* OC = WSP(bf16, WS_OC);
    const int c = F.tid, lane = F.lane;
    float w[CK];
#pragma unroll
    for (int j = 0; j < CK; ++j) w[j] = args.in[4][((size_t)L * CK + j) * CW + c];
    const float bias = args.in[5][L * CW + c], lg = args.in[6][L * CW + c], lb = args.in[7][L * CW + c];
    for (int unit = F.vcu; unit < M / 16; unit += F.G) {
        const int row0 = unit * 16, t0 = row0 & (SEQ - 1);
        float uu[46];
#pragma unroll
        for (int i = 0; i < 46; ++i) { const int tt = t0 - 30 + i; uu[i] = tt >= 0 ? __uint_as_float((unsigned)U[(size_t)(row0 - 30 + i) * CW + c] << 16) : 0.f; }
        float y[16];
#pragma unroll
        for (int tt = 0; tt < 16; ++tt) { float a = bias;
#pragma unroll
            for (int j = 0; j < CK; ++j) a += w[j] * uu[tt + j];
            y[tt] = a; ybuf[tt * 512 + c] = a; }
        __syncthreads();
#pragma unroll
        for (int q = 0; q < 2; ++q) { const int tt = 2 * F.wave + q; float v[8]; float s = 0.f;
#pragma unroll
            for (int i = 0; i < 8; ++i) { v[i] = ybuf[tt * 512 + lane + 64 * i]; s += v[i]; }
            const float mu = wave_sum(s) * (1.0f / 512.0f); float s2 = 0.f;
#pragma unroll
            for (int i = 0; i < 8; ++i) { const float dd = v[i] - mu; s2 += dd * dd; }
            const float var = wave_sum(s2) * (1.0f / 512.0f);
            if (lane == 0) { stats[2 * tt] = mu; stats[2 * tt + 1] = rsqrtf(var + EPS); } }
        __syncthreads();
#pragma unroll
        for (int tt = 0; tt < 16; ++tt) { const float yn = (y[tt] - stats[2 * tt]) * stats[2 * tt + 1] * lg + lb; const float ov = yn * sigm(yn);
            OC[(size_t)(row0 + tt) * DM + 512 + c] = (bf16)(cvt_pk_bf16(ov, 0.f) & 0xffffu); }
        __syncthreads();
    }
}

__device__ __forceinline__ void conv_v2(Frame& F, const Args& args, int L) {
    LAS float* ybuf = (LAS float*)(F.lds + RING_OFF);
    LAS float* stats = (LAS float*)(F.lds + OFFS_OFF + 256);
    const bf16* U = WSP(bf16, WS_U); bf16* OC = WSP(bf16, WS_OC);
    const int cp = F.tid & 255, half = F.tid >> 8, lane = F.lane;
    f32x2 w[CK];
#pragma unroll
    for (int j = 0; j < CK; ++j) w[j] = *(const f32x2*)(args.in[4] + ((size_t)L * CK + j) * CW + 2 * cp);
    const f32x2 bias = *(const f32x2*)(args.in[5] + L * CW + 2 * cp), lg = *(const f32x2*)(args.in[6] + L * CW + 2 * cp), lb = *(const f32x2*)(args.in[7] + L * CW + 2 * cp);
    for (int unit = F.vcu; unit < M / 64; unit += F.G) {
        const int row0 = unit * 64 + half * 32, t0 = row0 & (SEQ - 1);
#pragma unroll 1
        for (int sub = 0; sub < 2; ++sub) {
            float wl[46], wh[46];
#pragma unroll
            for (int i = 0; i < 46; ++i) { const int tt = t0 + 16 * sub - 30 + i; const int ri = row0 + 16 * sub - 30 + i; const int rc = tt >= 0 ? ri : row0;
                unsigned u = *(const GAS unsigned*)(U + (size_t)rc * CW + 2 * cp); u = tt >= 0 ? u : 0u; wl[i] = bf_lo(u); wh[i] = bf_hi(u); }
#pragma unroll
            for (int tt = 0; tt < 16; ++tt) { f32x2 a = bias;
#pragma unroll
                for (int j = 0; j < CK; ++j) { a.x += w[j].x * wl[tt + j]; a.y += w[j].y * wh[tt + j]; }
                *(LAS f32x2*)(ybuf + (half * 32 + 16 * sub + tt) * 512 + 2 * cp) = a; }
        }
        __syncthreads();
#pragma unroll
        for (int q = 0; q < 8; ++q) { const int tk = 8 * F.wave + q; float s = 0.f, s2 = 0.f;
#pragma unroll
            for (int i = 0; i < 2; ++i) { const f32x4 v = *(const LAS f32x4*)(ybuf + tk * 512 + 4 * lane + 256 * i); s += (v[0] + v[1]) + (v[2] + v[3]); s2 += (v[0] * v[0] + v[1] * v[1]) + (v[2] * v[2] + v[3] * v[3]); }
            s = wave_sum(s); s2 = wave_sum(s2);
            const float mu = s * (1.0f / 512.0f), var = fmaxf(s2 * (1.0f / 512.0f) - mu * mu, 0.f);
            if (lane == 0) { stats[2 * tk] = mu; stats[2 * tk + 1] = rsqrtf(var + EPS); } }
        __syncthreads();
#pragma unroll
        for (int tt = 0; tt < 32; ++tt) { const f32x2 st = *(const LAS f32x2*)(stats + 2 * (half * 32 + tt));
            const f32x2 yv = *(const LAS f32x2*)(ybuf + (half * 32 + tt) * 512 + 2 * cp);
            const float y0 = (yv.x - st.x) * st.y * lg.x + lb.x, y1 = (yv.y - st.x) * st.y * lg.y + lb.y;
            *(GAS unsigned*)(OC + (size_t)(row0 + tt) * DM + 512 + 2 * cp) = cvt_pk_bf16(y0 * sigm(y0), y1 * sigm(y1)); }
        __syncthreads();
    }
}

__device__ __forceinline__ void route_phase(Frame& F, const Args& args, int L) {
    LAS float* lgs = (LAS float*)(F.lds + RING_OFF) + F.wave * (8 * 40);
    const bf16* XB = WSP(bf16, WS_XB); const float* SSQ = WSP(float, WS_SSQ + (size_t)(3 * L + 1) * MiB); const bf16* WR = WSP(bf16, WS_WR) + (size_t)L * 64 * DM;
    int* ROUTE = WSP(int, WS_ROUTE); unsigned* cnt = (unsigned*)(F.ctl + CW_CNT + 64 * L);
    const int lane = F.lane, gw = F.vcu * NWAVES + F.wave, NGW = F.G * NWAVES;
    int vz = 0; asm volatile("" : "+v"(vz));
    const float bias = lane < 4 ? args.in[14][L * NGRP + lane] : (lane < 36 ? args.in[16][L * NEXP + lane - 4] : 0.f);
    for (int tb = gw; tb < M / 8; tb += NGW) {
        const int t0 = tb * 8;
        const GAS v4u* wp = (const GAS v4u*)(WR + (size_t)lane * DM);
        float a[8];
#pragma unroll
        for (int tt = 0; tt < 8; ++tt) a[tt] = 0.f;
        for (int kc = 0; kc < 128; ++kc) { const v4u w = wp[kc];
#pragma unroll
            for (int tt = 0; tt < 8; ++tt) { const v4u x = *((const GAS v4u*)(XB + (size_t)(t0 + tt) * DM) + kc + vz);
                a[tt] = dot2bf(w.x, x.x, a[tt]); a[tt] = dot2bf(w.y, x.y, a[tt]); a[tt] = dot2bf(w.z, x.z, a[tt]); a[tt] = dot2bf(w.w, x.w, a[tt]); } }
        float rr = 0.f;
#pragma unroll
        for (int tt = 0; tt < 8; ++tt) { const float r = rscale_of(SSQ + vz, t0 + tt); if (lane == tt) rr = r; if (lane < 36) lgs[tt * 40 + lane] = a[tt] * r + bias; }
        LDS_WAIT(); asm volatile("" ::: "memory");
        if (lane < 8) {
            const int t = t0 + lane; const LAS float* lp = lgs + lane * 40;
            float mxv = -1e30f; int gs = 0; float l4[4];
#pragma unroll
            for (int i = 0; i < 4; ++i) { l4[i] = lp[i]; if (l4[i] > mxv) { mxv = l4[i]; gs = i; } }
            float se = 0.f;
#pragma unroll
            for (int i = 0; i < 4; ++i) se += __expf(l4[i] - mxv);
            const float pg = 1.0f / se;
            float v1 = -1e30f, v2 = -1e30f; int i1 = 0, i2 = 0;
#pragma unroll
            for (int i = 0; i < 8; ++i) { const float v = lp[4 + gs * 8 + i]; if (v > v1) { v2 = v1; i2 = i1; v1 = v; i1 = i; } else if (v > v2) { v2 = v; i2 = i; } }
            const float e2 = __expf(v2 - v1), s1 = 1.0f / (1.0f + e2);
            const int ea = gs * 8 + i1, eb = gs * 8 + i2;
            const unsigned ia = atomicAdd(cnt + ea, 1u), ib = atomicAdd(cnt + eb, 1u);
            v4u r0, r1; r0.x = (unsigned)ea; r0.y = (unsigned)eb; r0.z = ia; r0.w = ib; r1.x = __float_as_uint(pg * s1); r1.y = __float_as_uint(pg * e2 * s1); r1.z = __float_as_uint(rr); r1.w = 0u;
            *(GAS v4u*)(ROUTE + (size_t)t * 8) = r0; *(GAS v4u*)(ROUTE + (size_t)t * 8 + 4) = r1;
        }
        LDS_WAIT(); asm volatile("" ::: "memory");
    }
}
__device__ __forceinline__ void moe_offsets(Frame& F, int L) {
    volatile LAS int* offs = (volatile LAS int*)(F.lds + OFFS_OFF);
    __syncthreads();
    if (F.tid == 0) { int acc = 0;
        for (int e = 0; e < NEXP; ++e) { offs[e] = acc; const unsigned c = __hip_atomic_load(F.ctl + CW_CNT + 64 * L + e, RLX_AGENT); acc += (int)((c + 255u) & ~255u); }
        offs[NEXP] = acc; }
    __syncthreads();
}
__device__ __forceinline__ void dispatch_phase(Frame& F, int L) {
    moe_offsets(F, L);
    const volatile LAS int* offs = (const volatile LAS int*)(F.lds + OFFS_OFF);
    const bf16* XB = XCUR(L); bf16* XG = WSP(bf16, WS_XG); const int* ROUTE = WSP(int, WS_ROUTE); int* POS = WSP(int, WS_POS); float* RSC = WSP(float, WS_RSC); float* ROWG = WSP(float, WS_ROWG);
    const int lane = F.lane, gw = F.vcu * NWAVES + F.wave, NGW = F.G * NWAVES;
    int vz = 0; asm volatile("" : "+v"(vz));
    for (int t = gw; t < M; t += NGW) {
        const v4u r0 = *(const GAS v4u*)(ROUTE + (size_t)t * 8 + vz), r1 = *(const GAS v4u*)(ROUTE + (size_t)t * 8 + 4 + vz);
        const int s0 = offs[r0.x] + (int)r0.z, s1 = offs[r0.y] + (int)r0.w;
        const GAS v4u* src = (const GAS v4u*)(XB + (size_t)t * DM) + lane; const v4u a = src[0], b = src[64];
        GAS v4u* d0 = (GAS v4u*)(XG + (size_t)s0 * DM) + lane; GAS v4u* d1 = (GAS v4u*)(XG + (size_t)s1 * DM) + lane;
        d0[0] = a; d0[64] = b; d1[0] = a; d1[64] = b;
        if (lane == 0) { POS[2 * t] = s0; POS[2 * t + 1] = s1; RSC[s0] = __uint_as_float(r1.z); RSC[s1] = __uint_as_float(r1.z); ROWG[s0] = __uint_as_float(r1.x); ROWG[s1] = __uint_as_float(r1.y); }
    }
}
__device__ __forceinline__ void combine_phase(Frame& F, int L) {
    bf16* XB = XCUR(L); const bf16* Y = WSP(bf16, WS_Y); const int* POS = WSP(int, WS_POS); float* SSQ = WSP(float, WS_SSQ + (size_t)(3 * L + 2) * MiB);
    const int lane = F.lane, gw = F.vcu * NWAVES + F.wave, NGW = F.G * NWAVES;
    int vz = 0; asm volatile("" : "+v"(vz));
    for (int t = gw; t < M; t += NGW) {
        const int s0 = POS[2 * t + vz], s1 = POS[2 * t + 1 + vz];
        GAS v4u* xb = (GAS v4u*)(XB + (size_t)t * DM) + lane; const GAS v4u* y0 = (const GAS v4u*)(Y + (size_t)s0 * DM) + lane; const GAS v4u* y1 = (const GAS v4u*)(Y + (size_t)s1 * DM) + lane;
        float s = 0.f;
#pragma unroll
        for (int j = 0; j < 2; ++j) { f32x4 xa, xc, aa, ac, ba, bc; unpack8(xb[64 * j], xa, xc); unpack8(y0[64 * j], aa, ac); unpack8(y1[64 * j], ba, bc);
            const f32x4 v0 = xa + aa + ba, v1 = xc + ac + bc; xb[64 * j] = pack8(v0, v1);
            s += ((v0[0] * v0[0] + v0[1] * v0[1]) + (v0[2] * v0[2] + v0[3] * v0[3])) + ((v1[0] * v1[0] + v1[1] * v1[1]) + (v1[2] * v1[2] + v1[3] * v1[3])); }
        const float tot = wave_sum(s);
        if (lane < 16) SSQ[(size_t)t * 16 + lane] = lane == 0 ? tot : 0.f;
    }
}
__device__ __forceinline__ void final_norm_phase(Frame& F, const Args& args) {
    float* X = F.out; const bf16* XB = WSP(bf16, WS_XB); const float* g = args.in[23];
    const int lane = F.lane, gw = F.vcu * NWAVES + F.wave, NGW = F.G * NWAVES;
    for (int t = gw; t < M; t += NGW) {
        const GAS v4u* xb = (const GAS v4u*)(XB + (size_t)t * DM) + lane; f32x4 v[4]; float s = 0.f;
#pragma unroll
        for (int j = 0; j < 2; ++j) { unpack8(xb[64 * j], v[2 * j], v[2 * j + 1]); }
#pragma unroll
        for (int j = 0; j < 4; ++j) s += (v[j][0] * v[j][0] + v[j][1] * v[j][1]) + (v[j][2] * v[j][2] + v[j][3] * v[j][3]);
        const float r = rsqrtf(wave_sum(s) * (1.0f / DM) + EPS);
        GAS f32x4* xo = (GAS f32x4*)(X + (size_t)t * DM) + 2 * lane;
#pragma unroll
        for (int j = 0; j < 2; ++j) { const f32x4 g0 = *((const f32x4*)g + 2 * lane + 128 * j), g1 = *((const f32x4*)g + 2 * lane + 128 * j + 1);
            xo[128 * j] = v[2 * j] * r * g0; xo[128 * j + 1] = v[2 * j + 1] * r * g1; }
    }
}
#ifndef MK_EXTRA_BAR
#define MK_EXTRA_BAR
#endif
#ifndef MK_TIME_PHASE
#define MK_TIME_PHASE (-1)
#endif
#ifndef MK_TIME_MUL
#define MK_TIME_MUL 4
#endif
#ifndef MK_DUP
#define MK_DUP (-1)
#endif
#ifdef MK_REFGEMM
#define GEMM_BODY gemm_phase_ref
#else
#define GEMM_BODY gemm_phase
#endif
#ifndef MK_EN
#define MK_EN 0xfff
#endif
__global__ void __launch_bounds__(NWAVES * 64, 2) mk_fwd(Args args) {
    extern __shared__ __attribute__((aligned(16))) unsigned char lds[];
    Frame F;
    F.lds = (LAS unsigned char*)lds;
    F.MISC = (volatile LAS unsigned*)(F.lds + MISC_OFF);
    F.tid = threadIdx.x; F.lane = F.tid & 63; F.wave = __builtin_amdgcn_readfirstlane(F.tid >> 6);
    F.G = gridDim.x; { const int bx = blockIdx.x; F.vcu = (F.G % 8 == 0) ? (bx % 8) * (F.G / 8) + bx / 8 : bx; }
    F.ws = args.ws; F.out = args.out; F.ctl = (gu32*)(args.ws + WS_CTL);
    for (int u = F.tid; u < (LDS_BYTES - LDSCTL_OFF) / 4; u += NWAVES * 64) ((LAS unsigned*)(F.lds + LDSCTL_OFF))[u] = 0u;
    __syncthreads();
    XcdBarrier bar; bar.bar = (unsigned*)(F.ctl + CW_BAR); bar.x = 0; bar.st = nullptr;
    if (args.use_bar) bar = xcd_barrier_post((unsigned*)(F.ctl + CW_BAR), F.MISC + 8);
    const int cblk = (int)blockIdx.x;
#define PHASE_SEAM(ph_) do { if ((ph_) + 1 < args.ph_hi) { if (args.use_bar) { xcd_barrier(bar); MK_EXTRA_BAR } else { VM_WAIT(); __syncthreads(); } } } while (0)
    volatile LAS unsigned long long* tsl = (volatile LAS unsigned long long*)(F.lds + LDSCTL_OFF + 2048);
    const bool stamper = MK_TIME_PHASE >= 0 && blockIdx.x == 0 && threadIdx.x == 0;
    if (stamper) tsl[0] = __builtin_amdgcn_s_memrealtime();
    int ph0 = args.ph_lo;
    if (ph0 == 0 && (MK_EN & 1)) { p0_prologue(F, args); if (MK_DUP == 0) { xcd_barrier(bar); p0_prologue(F, args); } PHASE_SEAM(0); ph0 = 1; if (stamper) tsl[1] = __builtin_amdgcn_s_memrealtime(); }
    for (int ph = ph0; ph < args.ph_hi; ++ph) {
      for (int rep_ = (ph == MK_DUP ? 2 : 1); rep_ > 0; --rep_) {
        { int t_ = threadIdx.x; asm volatile("" : "+v"(t_)); F.tid = t_; F.lane = t_ & 63; F.wave = __builtin_amdgcn_readfirstlane(t_ >> 6); }
        if (ph == PH_FINAL && (MK_EN & 2)) {
            final_norm_phase(F, args);
        } else {
            const int L = (ph - 1) / PH_PER_LAYER, sub = (ph - 1) % PH_PER_LAYER;
            const char* wl = (const char*)(F.ws + WS_W + (size_t)L * W_LAYER);
            float* SSQ0 = WSP(float, WS_SSQ + (size_t)(3 * L) * MiB);
            if (sub == 0 && (MK_EN & (4 << 0))) {
                SchedGrid S{64, 18, F.G, cblk, (const char*)XCUR(L), wl + WO_WIN, (size_t)256 * 1024 * 2, (size_t)256 * 1024 * 2};
                EpiP1 E{SSQ0, WSP(float, WS_COS), WSP(float, WS_SIN), WSP(bf16, WS_Q), WSP(bf16, WS_K), WSP(bf16, WS_V), WSP(bf16, WS_U), WSP(bf16, WS_SGA), WSP(bf16, WS_SGB)};
                pg8::GEMM_BODY<EpiP1, SchedGrid, true>(F.lds + RING_OFF, pg8::Dims{1024, 1024, 1024}, S, E);
                {
                    const bool split = F.G == 256;
                    SchedGrid S2{64, 4, split ? 128 : F.G, split ? (cblk >= 128 ? cblk - 128 : 256) : cblk, (const char*)(WSP(bf16, WS_PB) + (size_t)L * M * PLE), wl + WO_WPP, (size_t)256 * 256 * 2, (size_t)256 * 256 * 2};
                    EpiBf16 E2{WSP(bf16, WS_PE), DM};
                    pg8::GEMM_BODY<EpiBf16, SchedGrid, false>(F.lds + RING_OFF, pg8::Dims{256, 256, 256}, S2, E2);
                }
            } else if (sub == 1 && (MK_EN & (4 << 1))) {
#ifdef MK_ATTN_SIMPLE
                attn_simple(F);
#else
                attn_mfma(F); __syncthreads();
#ifdef MK_ATTN_TWICE
                attn_mfma(F); __syncthreads();
#endif
#endif
#ifdef MK_CONV_SIMPLE
                conv_simple(F, args, L);
#else
                conv_v2(F, args, L);
#endif
            } else if (sub == 2 && (MK_EN & (4 << 2))) {
                SchedGrid S{64, 4, F.G, cblk, (const char*)WSP(bf16, WS_OC), wl + WO_WAO, (size_t)256 * 1024 * 2, (size_t)256 * 1024 * 2};
                EpiP3 E{WSP(bf16, WS_SGA), WSP(bf16, WS_SGB), args.in[10] + L * DM, WSP(bf16, WS_MG)};
                pg8::GEMM_BODY<EpiP3, SchedGrid, true>(F.lds + RING_OFF, pg8::Dims{1024, 1024, 1024}, S, E);
            } else if (sub == 3 && (MK_EN & (4 << 3))) {
                SchedGrid S{64, 4, F.G, cblk, (const char*)WSP(bf16, WS_MG), wl + WO_WOUT, (size_t)256 * 1024 * 2, (size_t)256 * 1024 * 2};
                EpiP4 E{XCUR(L), XCUR(L), WSP(float, WS_SSQ + (size_t)(3 * L + 1) * MiB)};
                pg8::GEMM_BODY<EpiP4, SchedGrid, true>(F.lds + RING_OFF, pg8::Dims{1024, 1024, 1024}, S, E);
                {
                    VM_WAIT(); __syncthreads();
                    if (F.tid == 0) { __builtin_amdgcn_fence(__ATOMIC_ACQUIRE, "agent"); VM_WAIT(); }
                    __syncthreads();
                    SchedRouteP S2{F.G, cblk, (const char*)XCUR(L), (const char*)(WSP(bf16, WS_WR) + (size_t)L * 256 * DM)};
                    EpiRouteP E2{WSP(float, WS_LG)};
                    pg8::GEMM_BODY<EpiRouteP, SchedRouteP, false>(F.lds + RING_OFF, pg8::Dims{256, 1024, 1024}, S2, E2);
                }
            } else if (sub == 4 && (MK_EN & (4 << 4))) {
                decide_phase(F, L);
            } else if (sub == 5 && (MK_EN & (4 << 5))) {
                dispatch_phase(F, L);
            } else if (sub == 6 && (MK_EN & (4 << 6))) {
                moe_offsets(F, L);
                SchedMoe S{(const volatile LAS int*)(F.lds + OFFS_OFF), F.G, cblk, 1, (const char*)WSP(bf16, WS_XG), wl + WO_WGU};
                EpiUp E{WSP(float, WS_RSC), WSP(bf16, WS_H)};
                pg8::GEMM_BODY<EpiUp, SchedMoe, true>(F.lds + RING_OFF, pg8::Dims{1024, 1024, 1024}, S, E);
            } else if (sub == 7 && (MK_EN & (4 << 7))) {
                moe_offsets(F, L);
                SchedMoe S{(const volatile LAS int*)(F.lds + OFFS_OFF), F.G, cblk, 0, (const char*)WSP(bf16, WS_H), wl + WO_WD};
                EpiDown E{WSP(float, WS_ROWG), WSP(bf16, WS_Y)};
                pg8::GEMM_BODY<EpiDown, SchedMoe, true>(F.lds + RING_OFF, pg8::Dims{512, 512, 512}, S, E);
            } else if (sub == 8 && (MK_EN & (4 << 8))) {
                combine_phase(F, L);
            } else if (MK_EN & (4 << 9)) {
                SchedGrid S{64, 4, F.G, cblk, (const char*)XCUR(L), wl + WO_WPG, (size_t)256 * 1024 * 2, (size_t)256 * 1024 * 2};
                EpiP8 E{WSP(float, WS_SSQ + (size_t)(3 * L + 2) * MiB), WSP(bf16, WS_PE), XCUR(L), XNXT(L), WSP(float, WS_SSQ + (size_t)(3 * L + 3) * MiB)};
                pg8::GEMM_BODY<EpiP8, SchedGrid, true>(F.lds + RING_OFF, pg8::Dims{1024, 1024, 1024}, S, E);
            }
        }
        if (rep_ > 1) xcd_barrier(bar);
      }
        PHASE_SEAM(ph);
        if (stamper) tsl[ph + 1] = __builtin_amdgcn_s_memrealtime();
    }
    if (stamper) { const unsigned long long d_ = tsl[MK_TIME_PHASE + 1] - tsl[MK_TIME_PHASE], t1_ = __builtin_amdgcn_s_memrealtime(); while (__builtin_amdgcn_s_memrealtime() - t1_ < (unsigned long long)MK_TIME_MUL * d_) __builtin_amdgcn_s_sleep(8); }
}

#ifndef MK_OPT_PHASES
#define MK_OPT_PHASES 22
#endif
#ifndef MK_REPEAT
#define MK_REPEAT 1
#endif
#ifndef MK_SINGLE
#define MK_SINGLE 0
#endif
#if MK_OPT_PHASES < 22
static void naive_tail(hipStream_t stream, void* const* d_in, float* X, float* out, char* ws, int L0, int st0) {
    using namespace naive;
    const float* p = (const float*)d_in[1]; const float* norm_mix = (const float*)d_in[2]; const float* w_in = (const float*)d_in[3];
    const float* w_dw = (const float*)d_in[4]; const float* b_dw = (const float*)d_in[5]; const float* ln_g = (const float*)d_in[6]; const float* ln_b = (const float*)d_in[7];
    const float* w_ao = (const float*)d_in[8]; const float* w_co = (const float*)d_in[9]; const float* b_co = (const float*)d_in[10]; const float* w_out = (const float*)d_in[11];
    const float* norm_ffn = (const float*)d_in[12]; const float* w_rg = (const float*)d_in[13]; const float* b_rg = (const float*)d_in[14]; const float* w_re = (const float*)d_in[15]; const float* b_re = (const float*)d_in[16];
    const float* w_eg = (const float*)d_in[17]; const float* w_eu = (const float*)d_in[18]; const float* w_ed = (const float*)d_in[19];
    const float* norm_ple = (const float*)d_in[20]; const float* w_pp = (const float*)d_in[21]; const float* w_pg = (const float*)d_in[22]; const float* norm_final = (const float*)d_in[23];
    constexpr size_t MiB_ = 1u << 20;
    float* Hn = (float*)(ws + 0 * MiB_); float* QKV = (float*)(ws + 64 * MiB_); float* CUG = (float*)(ws + 160 * MiB_); float* GAB = (float*)(ws + 224 * MiB_);
    float* AO = (float*)(ws + 352 * MiB_); float* CO = (float*)(ws + 384 * MiB_);
    float* YA = Hn; float* YB = QKV;
    float* LG = CUG; float* LE = CUG + (size_t)M_ * 4; int* EID = (int*)(CUG + (size_t)M_ * 40); float* GT = CUG + (size_t)M_ * 48;
    float* GL = GAB; float* PE = QKV;
    for (int L = L0; L < DEPTH_; ++L) {
        const int s0 = (L == L0) ? st0 : 0;
        if (s0 <= 0) {
            hipLaunchKernelGGL(rmsnorm_k, dim3(M_ / 4), dim3(256), 0, stream, X, norm_mix + L * D_, Hn);
            const float* win = w_in + (size_t)L * D_ * WIN_;
            sgemm(stream, Hn, D_, win, WIN_, QKV, 1536, M_, 1536, D_, nullptr, nullptr);
            sgemm(stream, Hn, D_, win + 1536, WIN_, CUG, 1024, M_, 1024, D_, nullptr, nullptr);
            sgemm(stream, Hn, D_, win + 2560, WIN_, GAB, 2048, M_, 2048, D_, nullptr, nullptr);
            hipLaunchKernelGGL(rope_k, dim3(M_ * 2 * H_ * 32 / 256), dim3(256), 0, stream, QKV);
            hipLaunchKernelGGL(attn_naive_k, dim3(M_ * H_ / 4), dim3(256), 0, stream, QKV, AO);
            hipLaunchKernelGGL(conv_naive_k, dim3(M_), dim3(512), 0, stream, CUG, w_dw + (size_t)L * CK_ * CW_, b_dw + L * CW_, ln_g + L * CW_, ln_b + L * CW_, CO);
            sgemm(stream, AO, 512, w_ao + (size_t)L * 512 * D_, D_, YA, D_, M_, D_, 512, nullptr, nullptr);
            sgemm(stream, CO, 512, w_co + (size_t)L * 512 * D_, D_, YB, D_, M_, D_, 512, b_co + L * D_, nullptr);
            hipLaunchKernelGGL(merge_k, dim3(M_ * D_ / 256), dim3(256), 0, stream, GAB, YA, YB);
            sgemm(stream, GAB, 2048, w_out + (size_t)L * D_ * D_, D_, X, D_, M_, D_, D_, nullptr, X);
        }
        if (s0 <= 1) {
            hipLaunchKernelGGL(rmsnorm_k, dim3(M_ / 4), dim3(256), 0, stream, X, norm_ffn + L * D_, Hn);
            sgemm(stream, Hn, D_, w_rg + (size_t)L * D_ * NG_, NG_, LG, 4, M_, 4, D_, b_rg + L * NG_, nullptr);
            sgemm(stream, Hn, D_, w_re + (size_t)L * D_ * NE_, NE_, LE, 32, M_, 32, D_, b_re + L * NE_, nullptr);
            hipLaunchKernelGGL(route_k, dim3(M_ / 256), dim3(256), 0, stream, LG, LE, EID, GT);
            hipLaunchKernelGGL(moe_naive_k, dim3(M_), dim3(256), 0, stream, Hn, EID, GT, w_eg + (size_t)L * NE_ * D_ * FF_, w_eu + (size_t)L * NE_ * D_ * FF_, w_ed + (size_t)L * NE_ * FF_ * D_, X);
        }
        if (s0 <= 2) {
            hipLaunchKernelGGL(rmsnorm_k, dim3(M_ / 4), dim3(256), 0, stream, X, norm_ple + L * D_, Hn);
            sgemm(stream, Hn, D_, w_pg + (size_t)L * D_ * D_, D_, GL, D_, M_, D_, D_, nullptr, nullptr);
            sgemm(stream, p + (size_t)L * M_ * PLE_, PLE_, w_pp + (size_t)L * PLE_ * D_, D_, PE, D_, M_, D_, PLE_, nullptr, nullptr);
            hipLaunchKernelGGL(ple_k, dim3(M_ * D_ / 256), dim3(256), 0, stream, X, GL, PE);
        }
    }
    hipLaunchKernelGGL(rmsnorm_k, dim3(M_ / 4), dim3(256), 0, stream, X, norm_final, out);
}
#endif


#if MK_OPT_PHASES < 22
namespace dbg {
__device__ __forceinline__ float b2f(unsigned short u) { return __uint_as_float((unsigned)u << 16); }
__global__ void __launch_bounds__(256) cvt_qkv_k(const unsigned short* Q, const unsigned short* K, const unsigned short* V, float* qkv) {
    const size_t idx = (size_t)blockIdx.x * 256 + threadIdx.x;
    const int tok = (int)(idx >> 9), col = (int)(idx & 511), h = col >> 6, d = col & 63, b = tok >> 11, t = tok & 2047;
    const size_t src = ((size_t)(b * 8 + h) * 2048 + t) * 64 + d;
    qkv[(size_t)tok * 1536 + col] = b2f(Q[src]) * (1.0f / (0.125f * 1.4426950408889634f));
    qkv[(size_t)tok * 1536 + 512 + col] = b2f(K[src]);
    qkv[(size_t)tok * 1536 + 1024 + col] = b2f(V[src]);
}
__global__ void __launch_bounds__(512) conv_from_u_k(const unsigned short* __restrict__ U, const float* __restrict__ wdw, const float* __restrict__ bdw,
                                                     const float* __restrict__ lg, const float* __restrict__ lb, float* __restrict__ co) {
    __shared__ float red[16];
    const int tok = blockIdx.x, c = threadIdx.x, t = tok % 2048;
    float y = bdw[c];
    for (int j = 0; j < 31; ++j) { const int tt = t - 30 + j; if (tt >= 0) y += wdw[j * 512 + c] * b2f(U[(size_t)(tok - 30 + j) * 512 + c]); }
    float s = naive::wave_sum(y);
    if ((c & 63) == 0) red[c >> 6] = s;
    __syncthreads();
    float mu = 0.f;
    for (int i = 0; i < 8; ++i) mu += red[i];
    mu *= (1.f / 512.f);
    const float dv = y - mu;
    float s2 = naive::wave_sum(dv * dv);
    if ((c & 63) == 0) red[8 + (c >> 6)] = s2;
    __syncthreads();
    float var = 0.f;
    for (int i = 0; i < 8; ++i) var += red[8 + i];
    var *= (1.f / 512.f);
    const float yn = dv * rsqrtf(var + 1e-6f) * lg[c] + lb[c];
    co[(size_t)tok * 512 + c] = yn / (1.f + expf(-yn));
}
__global__ void __launch_bounds__(256) merge_sig_k(const unsigned short* sga, const unsigned short* sgb, const float* ya, const float* yb, float* mg) {
    const size_t idx = (size_t)blockIdx.x * 256 + threadIdx.x;
    mg[idx] = b2f(sga[idx]) * ya[idx] + b2f(sgb[idx]) * yb[idx];
}
__global__ void __launch_bounds__(256) cvt_oc_k(const unsigned short* oc, float* ao, float* co) {
    const size_t idx = (size_t)blockIdx.x * 256 + threadIdx.x;
    const size_t m = idx >> 10; const int n = (int)(idx & 1023);
    const float v = b2f(oc[idx]);
    if (n < 512) ao[m * 512 + n] = v; else co[m * 512 + n - 512] = v;
}
__global__ void __launch_bounds__(256) cvt_bf_k(const unsigned short* src, float* dst) {
    const size_t idx = (size_t)blockIdx.x * 256 + threadIdx.x; dst[idx] = b2f(src[idx]);
}
}
static void dbg_mixer_tail(hipStream_t stream, void* const* d_in, float* X, char* ws, int nopt) {
    using namespace naive;
    constexpr size_t MiB_ = 1u << 20;
    const float* w_dw = (const float*)d_in[4]; const float* b_dw = (const float*)d_in[5]; const float* ln_g = (const float*)d_in[6]; const float* ln_b = (const float*)d_in[7];
    const float* w_ao = (const float*)d_in[8]; const float* w_co = (const float*)d_in[9]; const float* b_co = (const float*)d_in[10]; const float* w_out = (const float*)d_in[11];
    float* Hn = (float*)(ws + 0 * MiB_); float* QKV = (float*)(ws + 64 * MiB_); float* YBb = (float*)(ws + 160 * MiB_); float* MGf = (float*)(ws + 224 * MiB_);
    float* AO = (float*)(ws + 288 * MiB_); float* CO = (float*)(ws + 320 * MiB_);
    const unsigned short* Qb = (const unsigned short*)(ws + WS_Q); const unsigned short* Kb = (const unsigned short*)(ws + WS_K); const unsigned short* Vb = (const unsigned short*)(ws + WS_V);
    const unsigned short* Ub = (const unsigned short*)(ws + WS_U); const unsigned short* SGAb = (const unsigned short*)(ws + WS_SGA); const unsigned short* SGBb = (const unsigned short*)(ws + WS_SGB);
    const unsigned short* OCb = (const unsigned short*)(ws + WS_OC); const unsigned short* MGb = (const unsigned short*)(ws + WS_MG);
    (void)hipMemcpyAsync(X, d_in[0], (size_t)M_ * D_ * 4, hipMemcpyDeviceToDevice, stream);
    if (nopt == 2) {
        hipLaunchKernelGGL(dbg::cvt_qkv_k, dim3(M_ * 512 / 256), dim3(256), 0, stream, Qb, Kb, Vb, QKV);
        hipLaunchKernelGGL(attn_naive_k, dim3(M_ * H_ / 4), dim3(256), 0, stream, QKV, AO);
        hipLaunchKernelGGL(dbg::conv_from_u_k, dim3(M_), dim3(512), 0, stream, Ub, w_dw, b_dw, ln_g, ln_b, CO);
    } else if (nopt == 3) {
        hipLaunchKernelGGL(dbg::cvt_oc_k, dim3(M_ * D_ / 256), dim3(256), 0, stream, OCb, AO, CO);
    }
    if (nopt <= 3) {
        sgemm(stream, AO, 512, w_ao, D_, Hn, D_, M_, D_, 512, nullptr, nullptr);
        sgemm(stream, CO, 512, w_co, D_, YBb, D_, M_, D_, 512, b_co, nullptr);
        hipLaunchKernelGGL(dbg::merge_sig_k, dim3(M_ * D_ / 256), dim3(256), 0, stream, SGAb, SGBb, Hn, YBb, MGf);
    } else {
        hipLaunchKernelGGL(dbg::cvt_bf_k, dim3(M_ * D_ / 256), dim3(256), 0, stream, MGb, MGf);
    }
    sgemm(stream, MGf, D_, w_out, D_, X, D_, M_, D_, D_, nullptr, X);
}
#endif

#if MK_OPT_PHASES < 22
namespace dbg {
__global__ void __launch_bounds__(256) hash_k(const unsigned* buf, size_t nwords, unsigned* out) {
    unsigned acc = 0u;
    for (size_t i = (size_t)blockIdx.x * 256 + threadIdx.x; i < nwords; i += (size_t)gridDim.x * 256) acc += buf[i] * (2654435761u * (unsigned)(2 * i + 1)) + (unsigned)i;
    for (int o = 1; o < 64; o <<= 1) acc += __shfl_xor(acc, o);
    if ((threadIdx.x & 63) == 0) atomicAdd(out, acc);
}
__global__ void __launch_bounds__(256) perturb_k(float* out, size_t first, size_t count, const unsigned* hash) {
    const size_t i = (size_t)blockIdx.x * 256 + threadIdx.x;
    if (i < count) out[first + i] += (float)(hash[0] >> 8) * (1.0f / 16777216.0f);
}
}
static void dbg_hash(hipStream_t st, const void* buf, size_t bytes, unsigned* cell) { hipLaunchKernelGGL(dbg::hash_k, dim3(1024), dim3(256), 0, st, (const unsigned*)buf, bytes / 4, cell); }
#endif

#if MK_OPT_PHASES < 22
#ifndef DBG_USE
#define DBG_USE 7
#endif
static void dbg_p1_tail(hipStream_t stream, void* const* d_in, float* X, char* ws) {
    using namespace naive;
    constexpr size_t MiB_ = 1u << 20;
    const float* norm_mix = (const float*)d_in[2]; const float* w_in = (const float*)d_in[3];
    const float* w_dw = (const float*)d_in[4]; const float* b_dw = (const float*)d_in[5]; const float* ln_g = (const float*)d_in[6]; const float* ln_b = (const float*)d_in[7];
    const float* w_ao = (const float*)d_in[8]; const float* w_co = (const float*)d_in[9]; const float* b_co = (const float*)d_in[10]; const float* w_out = (const float*)d_in[11];
    float* Hn = (float*)(ws + 0 * MiB_); float* QKV = (float*)(ws + 64 * MiB_); float* CUG = (float*)(ws + 160 * MiB_); float* GAB = (float*)(ws + 224 * MiB_);
    float* AO = (float*)(ws + 480 * MiB_); float* CO = (float*)(ws + 64 * MiB_); float* YA = Hn; float* YB = (float*)(ws + 96 * MiB_); float* MGf = (float*)(ws + 160 * MiB_);
    const unsigned short* Qb = (const unsigned short*)(ws + WS_Q); const unsigned short* Kb = (const unsigned short*)(ws + WS_K); const unsigned short* Vb = (const unsigned short*)(ws + WS_V);
    const unsigned short* Ub = (const unsigned short*)(ws + WS_U); const unsigned short* SGAb = (const unsigned short*)(ws + WS_SGA); const unsigned short* SGBb = (const unsigned short*)(ws + WS_SGB);
    (void)hipMemcpyAsync(X, d_in[0], (size_t)M_ * D_ * 4, hipMemcpyDeviceToDevice, stream);
    hipLaunchKernelGGL(rmsnorm_k, dim3(M_ / 4), dim3(256), 0, stream, X, norm_mix, Hn);
    if (DBG_USE & 1) hipLaunchKernelGGL(dbg::cvt_qkv_k, dim3(M_ * 512 / 256), dim3(256), 0, stream, Qb, Kb, Vb, QKV);
    else { sgemm(stream, Hn, D_, w_in, WIN_, QKV, 1536, M_, 1536, D_, nullptr, nullptr); hipLaunchKernelGGL(rope_k, dim3(M_ * 2 * H_ * 32 / 256), dim3(256), 0, stream, QKV); }
    if (!(DBG_USE & 2)) sgemm(stream, Hn, D_, w_in + 1536, WIN_, CUG, 1024, M_, 1024, D_, nullptr, nullptr);
    if (!(DBG_USE & 4)) sgemm(stream, Hn, D_, w_in + 2560, WIN_, GAB, 2048, M_, 2048, D_, nullptr, nullptr);
    hipLaunchKernelGGL(attn_naive_k, dim3(M_ * H_ / 4), dim3(256), 0, stream, QKV, AO);
    if (DBG_USE & 2) hipLaunchKernelGGL(dbg::conv_from_u_k, dim3(M_), dim3(512), 0, stream, Ub, w_dw, b_dw, ln_g, ln_b, CO);
    else hipLaunchKernelGGL(conv_naive_k, dim3(M_), dim3(512), 0, stream, CUG, w_dw, b_dw, ln_g, ln_b, CO);
    sgemm(stream, AO, 512, w_ao, D_, YA, D_, M_, D_, 512, nullptr, nullptr);
    sgemm(stream, CO, 512, w_co, D_, YB, D_, M_, D_, 512, b_co, nullptr);
    if (DBG_USE & 4) { hipLaunchKernelGGL(dbg::merge_sig_k, dim3(M_ * D_ / 256), dim3(256), 0, stream, SGAb, SGBb, YA, YB, MGf); sgemm(stream, MGf, D_, w_out, D_, X, D_, M_, D_, D_, nullptr, X); }
    else { hipLaunchKernelGGL(merge_k, dim3(M_ * D_ / 256), dim3(256), 0, stream, GAB, YA, YB); sgemm(stream, GAB, 2048, w_out, D_, X, D_, M_, D_, D_, nullptr, X); }
}
#endif

extern "C" void kernel_launch(void* const* d_in, const int* in_sizes, int n_in, void* d_out, int out_size, void* d_ws, size_t ws_size, hipStream_t stream) {
    static int grid = 0;
    if (grid == 0) {
        if (n_in != 24 || in_sizes[0] != M * DM || out_size != M * DM || ws_size < WS_END) { fprintf(stderr, "kernel_launch: unexpected shapes (n_in %d, in0 %d, out %d, ws %zu); nothing launched\n", n_in, n_in > 0 ? in_sizes[0] : -1, out_size, ws_size); grid = -1; return; }
        int dev = 0, cus = 0, per_cu = 0;
        if (hipGetDevice(&dev) != hipSuccess || hipDeviceGetAttribute(&cus, hipDeviceAttributeMultiprocessorCount, dev) != hipSuccess) { fprintf(stderr, "kernel_launch: device query failed\n"); grid = -1; return; }
        if (hipFuncSetAttribute((const void*)mk_fwd, hipFuncAttributeMaxDynamicSharedMemorySize, LDS_BYTES) != hipSuccess) { fprintf(stderr, "kernel_launch: hipFuncSetAttribute failed\n"); grid = -1; return; }
        if (hipOccupancyMaxActiveBlocksPerMultiprocessor(&per_cu, (const void*)mk_fwd, NWAVES * 64, LDS_BYTES) != hipSuccess || per_cu < 1) { fprintf(stderr, "kernel_launch: occupancy query reports %d blocks per CU\n", per_cu); }
        (void)hipGetLastError();
        grid = cus;
    }
    if (grid < 0) return;
    (void)hipMemsetAsync((char*)d_ws + WS_CTL, 0, CTL_ZERO_BYTES, stream);
    Args a{};
    for (int i = 0; i < 24; ++i) a.in[i] = (const float*)d_in[i];
    a.out = (float*)d_out; a.ws = (unsigned char*)d_ws;
    constexpr int NOPT = MK_OPT_PHASES;
#if MK_SINGLE
    a.ph_lo = 0; a.ph_hi = NOPT; a.use_bar = 1;
    hipLaunchKernelGGL(mk_fwd, dim3(grid), dim3(NWAVES * 64), LDS_BYTES, stream, a);
#else
    for (int rep = 0; rep < MK_REPEAT; ++rep)
    for (int ph = 0; ph < NOPT; ++ph) { a.ph_lo = ph; a.ph_hi = ph + 1; a.use_bar = 0; hipLaunchKernelGGL(mk_fwd, dim3(grid), dim3(NWAVES * 64), LDS_BYTES, stream, a); }
#endif
#if defined(MK_PROBE)
    {
        constexpr size_t MiB_ = 1u << 20; char* ws = (char*)d_ws; unsigned* cells = (unsigned*)(ws + 520 * MiB_);
        (void)hipMemsetAsync(cells, 0, 256, stream);
        MK_PROBE
        (void)hipMemcpyAsync(d_out, d_in[0], (size_t)M * DM * 4, hipMemcpyDeviceToDevice, stream);
        naive_tail(stream, d_in, (float*)d_out, (float*)d_out, (char*)d_ws, 0, 0);
        hipLaunchKernelGGL(dbg::perturb_k, dim3((1u << 22) / 256), dim3(256), 0, stream, (float*)d_out, (size_t)0, (size_t)1 << 22, cells);
        hipLaunchKernelGGL(dbg::perturb_k, dim3((1u << 16) / 256), dim3(256), 0, stream, (float*)d_out, (size_t)1 << 23, (size_t)1 << 16, cells + 16);
    }
#elif MK_OPT_PHASES < 22
    {
        int L0 = 0, st0 = 0;
        if (NOPT <= 1) { (void)hipMemcpyAsync(d_out, d_in[0], (size_t)M * DM * 4, hipMemcpyDeviceToDevice, stream); }
        else if (NOPT == 2) { dbg_p1_tail(stream, d_in, (float*)d_out, (char*)d_ws); L0 = 0; st0 = 1; }
        else if (NOPT >= 3 && NOPT <= 4) { dbg_mixer_tail(stream, d_in, (float*)d_out, (char*)d_ws, NOPT); L0 = 0; st0 = 1; }
        else if (NOPT == 5) { L0 = 0; st0 = 1; } else if (NOPT == 10) { L0 = 0; st0 = 2; } else if (NOPT == 11) { L0 = 1; st0 = 0; }
        else if (NOPT == 15) { L0 = 1; st0 = 1; } else if (NOPT == 20) { L0 = 1; st0 = 2; } else if (NOPT == 21) { L0 = 2; st0 = 0; }
        naive_tail(stream, d_in, (float*)d_out, (float*)d_out, (char*)d_ws, L0, st0);
    }
#endif
}
```

```cpp
#include <hip/hip_runtime.h>
#include <cstdio>
#include <cstdint>
#include <cmath>
namespace pg8 {
#define PG8_LAS __attribute__((address_space(3)))
typedef unsigned short bf16_t;
typedef short bf16x8 __attribute__((ext_vector_type(8)));
typedef float f32x4 __attribute__((ext_vector_type(4)));
typedef float f32x2 __attribute__((ext_vector_type(2)));
typedef unsigned u32x4 __attribute__((ext_vector_type(4)));
typedef unsigned u32x2 __attribute__((ext_vector_type(2)));
constexpr int BM = 256, BK = 64, HALF = 128, HTB = HALF * BK * 2  , STAGE_BYTES = 8 * HTB, NXCD = 8, WGM = 8;

__host__ __device__ __forceinline__ int lds_byte(int r, int c) { const int st = (r >> 4) * 2 + (c >> 5), rr = r & 15, cc = c & 31, ob = rr * 64 + cc * 2; return st * 1024 + (ob ^ (((ob >> 9) & 1) << 5)); }
__host__ __device__ __forceinline__ void stage_rc(int b, int& R, int& C) { const int st = b / 1024, sb = b % 1024, swz = sb ^ (((sb >> 9) & 1) << 5); R = (st >> 1) * 16 + swz / 64; C = (st & 1) * 32 + (swz % 64) / 2; }
__host__ __device__ __forceinline__ int perm32(int rho) { const int n = rho >> 4, i = rho & 15; return 8 * (i >> 2) + 4 * n + (i & 3); }

struct Unit { int pm, pn, aux, idx0, cnt; const char* A; const char* B; };
struct Dims { int K, lda, ldb; };

__host__ __device__ __forceinline__ void tile_of(int L, int nM, int nN, int& pm, int& pn) {
    const int nwg = nM * nN; int wgid = L; { const int q = nwg / NXCD, r = nwg % NXCD, xcd = wgid % NXCD, off = wgid / NXCD; wgid = (xcd < r ? xcd * (q + 1) : r * (q + 1) + (xcd - r) * q) + off; }
    const int nig = WGM * nN, gid = wgid / nig, fm = gid * WGM, gsz = (nM - fm) < WGM ? (nM - fm) : WGM;
    pm = fm + ((wgid % nig) % gsz); pn = (wgid % nig) / gsz;
}

typedef __bf16 bf16x2v __attribute__((ext_vector_type(2)));
__device__ __forceinline__ unsigned cvt_pk_bf16(float lo, float hi) { const f32x2 v = {lo, hi}; const bf16x2v b = __builtin_convertvector(v, bf16x2v); return __builtin_bit_cast(unsigned, b); }
__device__ __forceinline__ u32x4 pack8(const f32x4 a, const f32x4 b) { u32x4 w; w.x = cvt_pk_bf16(a[0], a[1]); w.y = cvt_pk_bf16(a[2], a[3]); w.z = cvt_pk_bf16(b[0], b[1]); w.w = cvt_pk_bf16(b[2], b[3]); return w; }
__device__ __forceinline__ float bf_lo(unsigned w) { return __uint_as_float(w << 16); }
__device__ __forceinline__ float bf_hi(unsigned w) { return __uint_as_float(w & 0xffff0000u); }
__device__ __forceinline__ void unpack8(const u32x4 w, f32x4& a, f32x4& b) { a[0] = bf_lo(w.x); a[1] = bf_hi(w.x); a[2] = bf_lo(w.y); a[3] = bf_hi(w.y); b[0] = bf_lo(w.z); b[1] = bf_hi(w.z); b[2] = bf_lo(w.w); b[3] = bf_hi(w.w); }
__device__ __forceinline__ float sigm(float x) { return __builtin_amdgcn_rcpf(1.0f + __builtin_amdgcn_exp2f(-1.4426950408889634f * x)); }
__device__ __forceinline__ f32x4 sigm4(const f32x4 x) { f32x4 r; r[0] = sigm(x[0]); r[1] = sigm(x[1]); r[2] = sigm(x[2]); r[3] = sigm(x[3]); return r; }

template <class Epi, class Sched, bool ALIGN_EPI>
__device__ __forceinline__ void gemm_phase(PG8_LAS unsigned char* lds, const Dims g, const Sched& S, const Epi& E) {
    constexpr bool GATHER = Sched::GATHER;
    int tid_ = threadIdx.x; asm volatile("" : "+v"(tid_));
    const int tid = tid_, wid = __builtin_amdgcn_readfirstlane(tid >> 6), lane = tid & 63, wr = wid >> 2, wc = wid & 3, fr = lane & 15, fq = lane >> 4;
    const int K = g.K, nt = K / BK;
    unsigned voffA[2], voffB[2];
#pragma unroll
    for (int i = 0; i < 2; ++i) { int R, C; stage_rc(tid * 16 + i * 8192, R, C); const int Rb = Epi::PERM ? ((R & ~31) + perm32(R & 31)) : R;
        voffA[i] = (unsigned)(R * g.lda + C) * 2u; voffB[i] = (unsigned)(Rb * g.ldb + C) * 2u; }
    const size_t kstep = (size_t)(BK * 2);
    const size_t hA = (size_t)HALF * g.lda * 2, hB = (size_t)HALF * g.ldb * 2;
    const unsigned ldsw = (unsigned)wid * 1024u;
    const int aoff = lds_byte(wr * 64 + fr, fq * 8), boff = lds_byte(wc * 32 + fr, fq * 8);
#define PG8_SA(b, h) (((b) * 2 + (h)) * HTB)
#define PG8_SB(b, h) ((4 + (b) * 2 + (h)) * HTB)
#define PG8_STAGE(bufoff, gbase, voff) do { _Pragma("unroll") for (int _i = 0; _i < 2; ++_i) \
        __builtin_amdgcn_global_load_lds((const unsigned*)((const char*)(gbase) + (voff)[_i]), (PG8_LAS unsigned*)(lds + (bufoff) + ldsw + _i * 8192), 16, 0, 0); } while (0)
#define PG8_LDA(dst, b, h) do { _Pragma("unroll") for (int m = 0; m < 4; ++m) _Pragma("unroll") for (int k = 0; k < 2; ++k) dst[m][k] = *(const PG8_LAS bf16x8*)(lds + PG8_SA(b, h) + aoff + m * 2048 + k * 1024); } while (0)
#define PG8_LDB(dst, b, h) do { _Pragma("unroll") for (int n = 0; n < 2; ++n) _Pragma("unroll") for (int k = 0; k < 2; ++k) dst[n][k] = *(const PG8_LAS bf16x8*)(lds + PG8_SB(b, h) + boff + n * 2048 + k * 1024); } while (0)
#define PG8_MMA(ai, bj, At, Bt) do { __builtin_amdgcn_s_setprio(1); _Pragma("unroll") for (int m = 0; m < 4; ++m) _Pragma("unroll") for (int n = 0; n < 2; ++n) _Pragma("unroll") for (int k = 0; k < 2; ++k) \
        acc[ai][bj][m][n] = __builtin_amdgcn_mfma_f32_16x16x32_bf16(Bt[n][k], At[m][k], acc[ai][bj][m][n], 0, 0, 0); __builtin_amdgcn_s_setprio(0); } while (0)
#define PG8_WAIT_V(n) asm volatile("s_waitcnt vmcnt(" #n ")" ::: "memory")
#define PG8_WAIT_L(n) asm volatile("s_waitcnt lgkmcnt(" #n ")" ::: "memory")
#define PG8_BAR __builtin_amdgcn_s_barrier()
#define PG8_SCHED __builtin_amdgcn_sched_barrier(0)
    Unit cur, nxt; int ui = 0;
    if (!S.next(0, cur)) return;
    unsigned vAc[2] = {0u, 0u}, vAn[2] = {0u, 0u};
#define PG8_GOFFS(d, U) do { _Pragma("unroll") for (int _i = 0; _i < 2; ++_i) { int R_, C_; stage_rc(tid * 16 + _i * 8192, R_, C_); d[_i] = S.row_idx(U, R_) | (S.row_idx(U, R_ + HALF) << 16); } } while (0)
#define PG8_STAGE_A(b, h, kp, nx) do { if constexpr (GATHER) { unsigned v_[2]; _Pragma("unroll") for (int _i = 0; _i < 2; ++_i) { int R_, C_; stage_rc(tid * 16 + _i * 8192, R_, C_); const unsigned p_ = (nx) ? vAn[_i] : vAc[_i]; \
            v_[_i] = ((h) ? (p_ >> 16) : (p_ & 0xffffu)) * (unsigned)(g.lda * 2) + (unsigned)C_ * 2u; } PG8_STAGE(PG8_SA(b, h), kp, v_); } \
        else { PG8_STAGE(PG8_SA(b, h), (kp) + (h) * hA, voffA); } } while (0)
    if constexpr (GATHER) { PG8_GOFFS(vAc, cur); }
    f32x4 acc[2][2][4][2];
#pragma unroll
    for (int a = 0; a < 2; ++a)
#pragma unroll
        for (int b = 0; b < 2; ++b)
#pragma unroll
            for (int m = 0; m < 4; ++m)
#pragma unroll
                for (int n = 0; n < 2; ++n) acc[a][b][m][n] = (f32x4){0.f, 0.f, 0.f, 0.f};
    bf16x8 At[4][2], B0[2][2], B1[2][2];
    const char* cA = cur.A; const char* cB = cur.B;
    PG8_STAGE(PG8_SB(0, 0), cB, voffB); PG8_STAGE(PG8_SB(0, 1), cB + hB, voffB); PG8_STAGE_A(0, 0, cA, false); PG8_STAGE_A(0, 1, cA, false);
    if (wr == 1) PG8_BAR;
    PG8_WAIT_V(2); PG8_BAR;
    PG8_STAGE(PG8_SB(1, 0), cB + kstep, voffB); PG8_STAGE_A(1, 0, cA + kstep, false); PG8_STAGE(PG8_SB(1, 1), cB + hB + kstep, voffB);
    PG8_WAIT_V(6); PG8_BAR;
    for (;;) {
        const bool has_next = S.next(ui + 1, nxt);
        const char* nA = has_next ? nxt.A : cA; const char* nB = has_next ? nxt.B : cB;
        if constexpr (GATHER) { if (has_next) { PG8_GOFFS(vAn, nxt); } else { vAn[0] = vAc[0]; vAn[1] = vAc[1]; } }
        for (int hk = 0; hk < (Epi::MIDK ? 2 : 1); ++hk) {
        if constexpr (Epi::MIDK) { if (hk == 1) E.mid(acc, cur, wr, wc, fr, fq); }
        const int tbeg = Epi::MIDK ? hk * (nt / 2) : 0, tend = Epi::MIDK ? (hk + 1) * (nt / 2) : nt;
        for (int t = tbeg; t < tend; t += 2) {
            const bool last = (t == nt - 2);
            const char* a1 = cA + (size_t)(t + 1) * kstep;
            const char* a2 = last ? nA : cA + (size_t)(t + 2) * kstep; const char* b2 = last ? nB : cB + (size_t)(t + 2) * kstep;
            const char* a3 = a2 + kstep; const char* b3 = b2 + kstep;
            PG8_LDB(B0, 0, 0); PG8_LDB(B1, 0, 1); PG8_SCHED; PG8_LDA(At, 0, 0); PG8_STAGE_A(1, 1, a1, false);
            PG8_WAIT_V(8); PG8_WAIT_L(0); PG8_BAR; PG8_MMA(0, 0, At, B0); PG8_MMA(0, 1, At, B1); PG8_BAR; PG8_SCHED;
            PG8_LDA(At, 0, 1); PG8_STAGE(PG8_SB(0, 0), b2, voffB); PG8_STAGE(PG8_SB(0, 1), b2 + hB, voffB); PG8_STAGE_A(0, 0, a2, last);
            PG8_WAIT_V(8); PG8_WAIT_L(0); PG8_BAR; PG8_MMA(1, 0, At, B0); PG8_MMA(1, 1, At, B1); PG8_BAR; PG8_SCHED;
            PG8_LDB(B0, 1, 0); PG8_LDB(B1, 1, 1); PG8_SCHED; PG8_LDA(At, 1, 0); PG8_STAGE_A(0, 1, a2, last);
            PG8_WAIT_V(8); PG8_WAIT_L(0); PG8_BAR; PG8_MMA(0, 0, At, B0); PG8_MMA(0, 1, At, B1); PG8_BAR; PG8_SCHED;
            PG8_LDA(At, 1, 1); PG8_STAGE(PG8_SB(1, 0), b3, voffB); PG8_STAGE(PG8_SB(1, 1), b3 + hB, voffB); PG8_STAGE_A(1, 0, a3, last);
            PG8_WAIT_V(8); PG8_WAIT_L(0); PG8_BAR; PG8_MMA(1, 0, At, B0); PG8_MMA(1, 1, At, B1); PG8_BAR; PG8_SCHED;
        }
        }
        if constexpr (ALIGN_EPI) { if (wr == 0) PG8_BAR; }
        E(acc, cur, wr, wc, fr, fq);
        if (!has_next) break;
#pragma unroll
        for (int a = 0; a < 2; ++a)
#pragma unroll
            for (int b = 0; b < 2; ++b)
#pragma unroll
                for (int m = 0; m < 4; ++m)
#pragma unroll
                    for (int n = 0; n < 2; ++n) acc[a][b][m][n] = (f32x4){0.f, 0.f, 0.f, 0.f};
        cur = nxt; cA = nA; cB = nB; ++ui;
        if constexpr (GATHER) { vAc[0] = vAn[0]; vAc[1] = vAn[1]; }
        if constexpr (ALIGN_EPI) { if (wr == 1) PG8_BAR; }
    }
    PG8_WAIT_V(0);
    if constexpr (!ALIGN_EPI) { if (wr == 0) PG8_BAR; }
    PG8_BAR;
#undef PG8_GOFFS
#undef PG8_STAGE_A
#undef PG8_SA
#undef PG8_SB
#undef PG8_STAGE
#undef PG8_LDA
#undef PG8_LDB
#undef PG8_MMA
#undef PG8_WAIT_V
#undef PG8_WAIT_L
#undef PG8_BAR
#undef PG8_SCHED
}

template <class Epi, class Sched, bool ALIGN_EPI>
__device__ __forceinline__ void gemm_phase_ref(PG8_LAS unsigned char* lds, const Dims g, const Sched& S, const Epi& E) {
    int tid_ = threadIdx.x; asm volatile("" : "+v"(tid_));
    const int tid = tid_, wid = __builtin_amdgcn_readfirstlane(tid >> 6), lane = tid & 63, wr = wid >> 2, wc = wid & 3, fr = lane & 15, fq = lane >> 4;
    typedef __bf16 bf2 __attribute__((ext_vector_type(2)));
    Unit cur;
    for (int ui = 0; S.next(ui, cur); ++ui) {
        f32x4 acc[2][2][4][2];
#pragma unroll
        for (int a = 0; a < 2; ++a)
#pragma unroll
            for (int b = 0; b < 2; ++b)
#pragma unroll
                for (int m = 0; m < 4; ++m)
#pragma unroll
                    for (int n = 0; n < 2; ++n) acc[a][b][m][n] = (f32x4){0.f, 0.f, 0.f, 0.f};
        for (int k0 = 0; k0 < g.K; k0 += 8) {
            u32x4 av[2][4];
#pragma unroll
            for (int a = 0; a < 2; ++a)
#pragma unroll
                for (int m = 0; m < 4; ++m) av[a][m] = *(const u32x4*)(cur.A + ((size_t)(128 * a + 64 * wr + 16 * m + fr) * g.lda + k0) * 2);
#pragma unroll
            for (int b = 0; b < 2; ++b)
#pragma unroll
                for (int n = 0; n < 2; ++n)
#pragma unroll
                    for (int i = 0; i < 4; ++i) {
                        const int col = Epi::PERM ? (128 * b + 32 * wc + 8 * fq + 4 * n + i) : (128 * b + 32 * wc + 16 * n + 4 * fq + i);
                        const u32x4 bv = *(const u32x4*)(cur.B + ((size_t)col * g.ldb + k0) * 2);
#pragma unroll
                        for (int a = 0; a < 2; ++a)
#pragma unroll
                            for (int m = 0; m < 4; ++m) { float s = acc[a][b][m][n][i];
                                s = __builtin_amdgcn_fdot2_f32_bf16(__builtin_bit_cast(bf2, av[a][m].x), __builtin_bit_cast(bf2, bv.x), s, false);
                                s = __builtin_amdgcn_fdot2_f32_bf16(__builtin_bit_cast(bf2, av[a][m].y), __builtin_bit_cast(bf2, bv.y), s, false);
                                s = __builtin_amdgcn_fdot2_f32_bf16(__builtin_bit_cast(bf2, av[a][m].z), __builtin_bit_cast(bf2, bv.z), s, false);
                                s = __builtin_amdgcn_fdot2_f32_bf16(__builtin_bit_cast(bf2, av[a][m].w), __builtin_bit_cast(bf2, bv.w), s, false);
                                acc[a][b][m][n][i] = s; }
                    }
        }
        E(acc, cur, wr, wc, fr, fq);
    }
}
}
#define GAS __attribute__((address_space(1)))
#define LAS __attribute__((address_space(3)))
typedef unsigned short bf16;
typedef unsigned v4u __attribute__((ext_vector_type(4)));
typedef unsigned v2u __attribute__((ext_vector_type(2)));
typedef float f32x4 __attribute__((ext_vector_type(4)));
typedef float f32x2 __attribute__((ext_vector_type(2)));
typedef short bf16x8 __attribute__((ext_vector_type(8)));
typedef __bf16 bf16x2_t __attribute__((ext_vector_type(2)));
typedef GAS unsigned gu32;
#define RLX_AGENT __ATOMIC_RELAXED, __HIP_MEMORY_SCOPE_AGENT
#define LDS_WAIT() asm volatile("s_waitcnt lgkmcnt(0)" ::: "memory")
#define VM_WAIT() asm volatile("s_waitcnt vmcnt(0)" ::: "memory")
using pg8::cvt_pk_bf16; using pg8::pack8; using pg8::unpack8; using pg8::bf_lo; using pg8::bf_hi; using pg8::sigm; using pg8::sigm4;

__device__ __forceinline__ float wave_sum(float v) {
#pragma unroll
    for (int o = 1; o < 64; o <<= 1) v += __shfl_xor(v, o);
    return v;
}
__device__ __forceinline__ float dot2bf(unsigned a, unsigned b, float acc) { return __builtin_amdgcn_fdot2_f32_bf16(__builtin_bit_cast(bf16x2_t, a), __builtin_bit_cast(bf16x2_t, b), acc, false); }

#define XB_TMO      128
#define XB_XCNT(j)  (256  + 64 * (j))
#define XB_XSUB(j)  (1280 + 64 * (j))
#define XB_XGEN(j)  (2304 + 64 * (j))
#define XB_TOP      3328
#define XB_TOPGEN   3392
#define XCD_BAR_WORDS 3456
#define XB_SPIN_CAP (1u << 18)

__device__ __forceinline__ unsigned xb_ld(unsigned* p)              { return __hip_atomic_load(p, __ATOMIC_RELAXED, __HIP_MEMORY_SCOPE_AGENT); }
__device__ __forceinline__ unsigned xb_add(unsigned* p, unsigned v) { return __hip_atomic_fetch_add(p, v, __ATOMIC_RELAXED, __HIP_MEMORY_SCOPE_AGENT); }
__device__ __forceinline__ unsigned xb_xcc_id() { return (unsigned)__builtin_amdgcn_s_getreg((3 << 11) | 20) & 0xFu; }
#define XB_SPIN(cond, bar) do { unsigned _sp = 0; while (cond) { __builtin_amdgcn_s_sleep(1); \
    if ((++_sp & 255u) == 0u) { if (xb_ld(&(bar)[XB_TMO])) break; if (_sp > XB_SPIN_CAP) { atomicAdd(&(bar)[XB_TMO], 1u); break; } } } } while (0)

struct XcdBarrier {
    unsigned* bar; unsigned x;
    volatile LAS unsigned* st;
};
__device__ __forceinline__ XcdBarrier xcd_barrier_post(unsigned* bar, volatile LAS unsigned* st) {
    XcdBarrier b; b.bar = bar; b.x = xb_xcc_id(); b.st = st;
    if (threadIdx.x == 0) (void)xb_add(&bar[XB_XCNT(b.x)], 1u);
    return b;
}
__device__ __forceinline__ void xcd_barrier_complete(unsigned* bar, unsigned x, unsigned& nloc, unsigned& nx) {
    const unsigned G = gridDim.x * gridDim.y * gridDim.z;
    unsigned sum, cnt, mine, sp = 0u;
    for (;;) {
        sum = 0u; cnt = 0u; mine = 0u;
#pragma unroll
        for (unsigned j = 0; j < 16; ++j) { const unsigned c = xb_ld(&bar[XB_XCNT(j)]); sum += c; cnt += (c > 0u) ? 1u : 0u; mine = (j == x) ? c : mine; }
        if (sum == G) break;
        __builtin_amdgcn_s_sleep(1);
        if ((++sp & 255u) == 0u) { if (xb_ld(&bar[XB_TMO])) break; if (sp > XB_SPIN_CAP) { atomicAdd(&bar[XB_TMO], 1u); break; } }
    }
    nloc = mine > 0u ? mine : 1u; nx = cnt > 0u ? cnt : 1u;
}
__device__ __forceinline__ void xcd_barrier(const XcdBarrier& b) {
    asm volatile("s_waitcnt vmcnt(0)" ::: "memory");
    __syncthreads();
    if (threadIdx.x == 0) {
        unsigned* bar = b.bar;
        __builtin_amdgcn_s_waitcnt(0);
        unsigned nloc = b.st[0], nx = b.st[1];
        if (nloc == 0u) { xcd_barrier_complete(bar, b.x, nloc, nx); b.st[0] = nloc; b.st[1] = nx; }
        const unsigned old = xb_add(&bar[XB_XSUB(b.x)], 1u);
        const unsigned gen = old / nloc;
        if (old + 1u == (gen + 1u) * nloc) {
            __builtin_amdgcn_fence(__ATOMIC_RELEASE, "agent");
            asm volatile("s_waitcnt vmcnt(0)" ::: "memory");
            const unsigned og = xb_add(&bar[XB_TOP], 1u);
            const unsigned tg = og / nx;
            if (og + 1u == (tg + 1u) * nx) xb_add(&bar[XB_TOPGEN], 1u);
            else XB_SPIN(xb_ld(&bar[XB_TOPGEN]) == tg, bar);
            __builtin_amdgcn_fence(__ATOMIC_ACQUIRE, "agent");
            xb_add(&bar[XB_XGEN(b.x)], 1u);
            asm volatile("s_waitcnt vmcnt(0)" ::: "memory");
        } else {
            XB_SPIN(xb_ld(&bar[XB_XGEN(b.x)]) == gen, bar);
            __builtin_amdgcn_fence(__ATOMIC_ACQUIRE, "agent");
            asm volatile("s_waitcnt vmcnt(0)" ::: "memory");
        }
    }
    __syncthreads();
}
constexpr int NWAVES = 8;
constexpr int BATCH = 8, SEQ = 2048, DM = 1024, M = BATCH * SEQ, DEPTH = 2, NH = 8, HD = 64, AW = 512, CW = 512, CK = 31;
constexpr int NGRP = 4, EPG = 8, NEXP = 32, FF = 512, PLE = 256, WIN = 4608;
constexpr float EPS = 1e-6f;
constexpr float QSCALE = 0.125f * 1.4426950408889634f;
constexpr int MAXROWS = 2 * M + NEXP * 256;
constexpr size_t MiB = 1u << 20;
constexpr size_t WS_CTL = 0, CTL_ZERO_BYTES = 2 * MiB;
constexpr size_t WS_COS = 2 * MiB, WS_SIN = 2 * MiB + 256 * 1024;
constexpr size_t WS_SSQ = 3 * MiB;
constexpr size_t WS_ROUTE = 10 * MiB, WS_POS = 10 * MiB + 512 * 1024, WS_RSC = 11 * MiB, WS_ROWG = 11 * MiB + 256 * 1024;
constexpr size_t WS_WR = 12 * MiB;
constexpr size_t WS_LIST = 14 * MiB;
constexpr int LIST_CAP = M;
constexpr size_t WS_RB = 13 * MiB;
constexpr size_t WS_LG = 352 * MiB;
constexpr size_t WS_W = 16 * MiB, W_LAYER = 112 * MiB;
constexpr size_t WO_WIN = 0, WO_WAO = 9 * MiB, WO_WCO = 10 * MiB, WO_WOUT = 11 * MiB, WO_WPG = 13 * MiB, WO_WPP = 15 * MiB, WO_WGU = 16 * MiB, WO_WD = 80 * MiB;
constexpr size_t WS_XB = 240 * MiB, WS_PB = 272 * MiB, WS_PE = 288 * MiB, WS_MG = 320 * MiB;
constexpr size_t WS_Q = 352 * MiB, WS_K = 368 * MiB, WS_V = 384 * MiB, WS_U = 400 * MiB, WS_SGA = 416 * MiB, WS_SGB = 448 * MiB, WS_OC = 480 * MiB;
constexpr size_t WS_XG = 352 * MiB, WS_H = 432 * MiB, WS_Y = 352 * MiB, WS_END = 512 * MiB;
constexpr int CW_TMO = 0, CW_CODE = 1, CW_BAR = 4096, CW_CNT = 16384;
constexpr int RING_OFF = 0, RING_BYTES = 131072;
constexpr int LDSCTL_OFF = RING_BYTES, MISC_OFF = LDSCTL_OFF + 320, OFFS_OFF = LDSCTL_OFF + 1024;
constexpr int LDS_BYTES = 147456;
constexpr int PH_PER_LAYER = 9, PH_FINAL = 1 + DEPTH * PH_PER_LAYER, N_PHASES = PH_FINAL + 1;

struct Frame {
    LAS unsigned char* lds;
    volatile LAS unsigned* MISC;
    gu32* ctl;
    int tid, lane, wave, vcu, G;
    float* out; unsigned char* ws;
};
#define XCUR(L) ((L) == 0 ? WSP(bf16, WS_XB) : (bf16*)F.out)
#define XNXT(L) ((L) == 0 ? (bf16*)F.out : WSP(bf16, WS_XB))
struct Args { const float* in[24]; float* out; unsigned char* ws; int ph_lo, ph_hi, use_bar, pad; };
#define WSP(T, off) ((T*)(F.ws + (off)))

__device__ __forceinline__ void transpose_item(const float* W, int ld, int colA, int colB, const float* gain, int k0, bf16* WT, int K, int row0, LAS float* scr, int lane, int kd = 0) {
    const int kl = lane >> 4, n4 = lane & 15;
    const float* src = W + (size_t)(k0 + kl) * ld + (n4 < 8 ? colA + 4 * n4 : colB + 4 * (n4 - 8));
    f32x4 v[16];
#pragma unroll
    for (int q = 0; q < 16; ++q) v[q] = *(const GAS f32x4*)(src + (size_t)(4 * q) * ld);
#pragma unroll
    for (int q = 0; q < 16; ++q) { const int k = 4 * q + kl; if (gain) v[q] = v[q] * gain[k0 + k]; *(LAS f32x4*)(scr + k * 64 + ((4 * n4) ^ (((k >> 3) & 7) << 3))) = v[q]; }
    LDS_WAIT(); asm volatile("" ::: "memory");
    const int c = lane & 7;
#pragma unroll
    for (int j = 0; j < 8; ++j) { const int n = (lane >> 3) + 8 * j; const LAS float* s = scr + (8 * c) * 64 + (n ^ (c << 3));
        v4u o; o.x = cvt_pk_bf16(s[0 * 64], s[1 * 64]); o.y = cvt_pk_bf16(s[2 * 64], s[3 * 64]); o.z = cvt_pk_bf16(s[4 * 64], s[5 * 64]); o.w = cvt_pk_bf16(s[6 * 64], s[7 * 64]);
        *(GAS v4u*)(WT + (size_t)(row0 + n) * K + kd + k0 + 8 * c) = o; }
    LDS_WAIT(); asm volatile("" ::: "memory");
}
__device__ __forceinline__ int win_src_col(int g) {
    const int pn = g >> 3, sub = g & 7;
    if (pn < 2) return 64 * (4 * pn + (sub & 3)) + 32 * (sub >> 2);
    if (pn < 4) return 512 + 64 * (4 * (pn - 2) + (sub & 3)) + 32 * (sub >> 2);
    if (pn < 6) return 1024 + 256 * (pn - 4) + 32 * sub;
    if (pn < 10) return (sub < 4 ? 1536 : 2048) + 128 * (pn - 6) + 32 * (sub & 3);
    return 2560 + 256 * (pn - 10) + 32 * sub;
}
constexpr int IT_WIN = 72 * 16, IT_WAO = 16 * 8, IT_WCO = 16 * 8, IT_WOUT = 16 * 16, IT_WPG = 16 * 16, IT_WPP = 16 * 4, IT_WGU = 512 * 16, IT_WD = 512 * 8;
constexpr int IT_LAYER = IT_WIN + IT_WAO + IT_WCO + IT_WOUT + IT_WPG + IT_WPP + IT_WGU + IT_WD;
__device__ __forceinline__ void conv_item(Frame& F, const Args& args, int L, int it, LAS float* scr) {
    unsigned char* wl = F.ws + WS_W + (size_t)L * W_LAYER; const int lane = F.lane;
    int r = it;
    if (r < IT_WIN) { const int gp = r >> 4, kb = r & 15; transpose_item(args.in[3] + (size_t)L * DM * WIN, WIN, win_src_col(2 * gp), win_src_col(2 * gp + 1), args.in[2] + L * DM, 64 * kb, (bf16*)(wl + WO_WIN), 1024, 64 * gp, scr, lane); return; } r -= IT_WIN;
    if (r < IT_WAO) { const int gp = r >> 3, kb = r & 7; transpose_item(args.in[8] + (size_t)L * 512 * DM, DM, 64 * gp, 64 * gp + 32, nullptr, 64 * kb, (bf16*)(wl + WO_WAO), 1024, 64 * gp, scr, lane, 0); return; } r -= IT_WAO;
    if (r < IT_WCO) { const int gp = r >> 3, kb = r & 7; transpose_item(args.in[9] + (size_t)L * 512 * DM, DM, 64 * gp, 64 * gp + 32, nullptr, 64 * kb, (bf16*)(wl + WO_WAO), 1024, 64 * gp, scr, lane, 512); return; } r -= IT_WCO;
    if (r < IT_WOUT) { const int gp = r >> 4, kb = r & 15; transpose_item(args.in[11] + (size_t)L * DM * DM, DM, 64 * gp, 64 * gp + 32, nullptr, 64 * kb, (bf16*)(wl + WO_WOUT), 1024, 64 * gp, scr, lane); return; } r -= IT_WOUT;
    if (r < IT_WPG) { const int gp = r >> 4, kb = r & 15; transpose_item(args.in[22] + (size_t)L * DM * DM, DM, 64 * gp, 64 * gp + 32, args.in[20] + L * DM, 64 * kb, (bf16*)(wl + WO_WPG), 1024, 64 * gp, scr, lane); return; } r -= IT_WPG;
    if (r < IT_WPP) { const int gp = r >> 2, kb = r & 3; transpose_item(args.in[21] + (size_t)L * PLE * DM, DM, 64 * gp, 64 * gp + 32, nullptr, 64 * kb, (bf16*)(wl + WO_WPP), 256, 64 * gp, scr, lane); return; } r -= IT_WPP;
    if (r < IT_WGU) { const int gp = r >> 4, kb = r & 15, e = gp >> 4, gl = gp & 15, tile = gl >> 2, sub = gl & 3;
        const float* src = (sub < 2 ? args.in[17] : args.in[18]) + ((size_t)L * NEXP + e) * DM * FF; const int col = 128 * tile + 64 * (sub & 1);
        transpose_item(src, FF, col, col + 32, args.in[12] + L * DM, 64 * kb, (bf16*)(wl + WO_WGU), 1024, 64 * gp, scr, lane); return; } r -= IT_WGU;
    { const int gp = r >> 3, kb = r & 7, e = gp >> 4, gl = gp & 15;
        transpose_item(args.in[19] + ((size_t)L * NEXP + e) * FF * DM, DM, 64 * gl, 64 * gl + 32, nullptr, 64 * kb, (bf16*)(wl + WO_WD), 512, 64 * gp, scr, lane); }
}
__device__ __forceinline__ void p0_prologue(Frame& F, const Args& args) {
    LAS float* scr = (LAS float*)(F.lds + RING_OFF + F.wave * 16384);
    const int gw = F.vcu * NWAVES + F.wave, NGW = F.G * NWAVES, lane = F.lane;
    const int gt = (F.vcu * NWAVES + F.wave) * 64 + lane, NGT = NGW * 64;
    { bf16* XB = WSP(bf16, WS_XB); float* SSQ = WSP(float, WS_SSQ);
      for (int m = gw; m < M; m += NGW) {
          const GAS f32x4* xr = (const GAS f32x4*)(args.in[0] + (size_t)m * DM) + lane; float s = 0.f; GAS v2u* o8 = (GAS v2u*)(XB + (size_t)m * DM) + lane;
#pragma unroll
          for (int j = 0; j < 4; ++j) { const f32x4 v = xr[64 * j]; s += (v[0] * v[0] + v[1] * v[1]) + (v[2] * v[2] + v[3] * v[3]); v2u w; w.x = cvt_pk_bf16(v[0], v[1]); w.y = cvt_pk_bf16(v[2], v[3]); o8[64 * j] = w; }
          const float tot = wave_sum(s);
          if (lane < 16) SSQ[(size_t)m * 16 + lane] = lane == 0 ? tot : 0.f;
      } }
    { const GAS f32x4* ps = (const GAS f32x4*)args.in[1]; GAS v4u* pb = (GAS v4u*)WSP(bf16, WS_PB);
      for (int i = gt; i < DEPTH * M * PLE / 8; i += NGT) { const f32x4 a = ps[2 * i], b = ps[2 * i + 1]; pb[i] = pack8(a, b); } }
    { float* ct = WSP(float, WS_COS); float* st = WSP(float, WS_SIN);
      for (int i = gt; i < SEQ * 32; i += NGT) { const int pos = i >> 5, k = i & 31; const float inv = powf(10000.0f, -(float)(2 * k) / 64.0f); const float ang = (float)pos * inv; ct[i] = cosf(ang); st[i] = sinf(ang); } }
    { bf16* wr = WSP(bf16, WS_WR);
      for (int i = gt; i < DEPTH * 256 * DM; i += NGT) { const int L = i >> 18, j = (i >> 10) & 255, k = i & 1023; float v = 0.f;
          if (j < 4) v = args.in[13][((size_t)L * DM + k) * NGRP + j]; else if (j < 36) v = args.in[15][((size_t)L * DM + k) * NEXP + (j - 4)];
          if (j < 36) v *= args.in[12][L * DM + k];
          wr[i] = (bf16)(cvt_pk_bf16(v, 0.f) & 0xffffu); }
      float* rb = WSP(float, WS_RB);
      for (int i = gt; i < DEPTH * 64; i += NGT) { const int L = i >> 6, j = i & 63; rb[i] = j < 4 ? args.in[14][L * NGRP + j] : (j < 36 ? args.in[16][L * NEXP + j - 4] : 0.f); } }
    for (int it = gw; it < DEPTH * IT_LAYER; it += NGW) { const int L = it >= IT_LAYER ? 1 : 0; conv_item(F, args, L, it - L * IT_LAYER, scr); }
}

struct SchedGrid {
    static constexpr bool GATHER = false;
    int nM, nN, G, c; const char* Ab; const char* Bb; size_t astep, bstep;
    __device__ __forceinline__ bool next(int i, pg8::Unit& u) const {
        const int L = i * G + c; if (L >= nM * nN) return false;
        pg8::tile_of(L, nM, nN, u.pm, u.pn); u.aux = 0; u.A = Ab + (size_t)u.pm * astep; u.B = Bb + (size_t)u.pn * bstep; return true; }
};
struct SchedP3 {     static constexpr bool GATHER = false;
    int G, c; const char* OC; const char* Wa; const char* Wc;
    __device__ __forceinline__ bool next(int i, pg8::Unit& u) const {
        const int T = (i >> 1) * G + c; if (T >= 256) return false;
        pg8::tile_of(T, 64, 4, u.pm, u.pn); u.aux = i & 1;
        u.A = OC + (size_t)u.pm * (256 * 1024 * 2) + (u.aux ? 512 * 2 : 0); u.B = (u.aux ? Wc : Wa) + (size_t)u.pn * (256 * 512 * 2); return true; }
};
struct SchedMoeUp {
    static constexpr bool GATHER = true;
    const volatile LAS int* offs; const int* LIST; int G, c; const char* Xb; const char* Bb;
    __device__ __forceinline__ bool next(int i, pg8::Unit& u) const {
        const int NB = offs[32] >> 8, L = i * G + c; if (L >= NB * 4) return false;
        const int mb = L >> 2, pn = L & 3; int e = 0;
        while (e < 31 && offs[e + 1] <= mb * 256) ++e;
        u.pm = mb; u.pn = pn; u.aux = e; u.idx0 = mb * 256 - offs[e]; u.cnt = offs[33 + e];
        u.A = Xb; u.B = Bb + ((size_t)e * 1024 + pn * 256) * (1024 * 2); return true; }
    __device__ __forceinline__ unsigned row_idx(const pg8::Unit& u, int R) const {
        const int idx = u.idx0 + R; const int lt = idx < u.cnt ? LIST[(size_t)u.aux * LIST_CAP + idx] : 0; return (unsigned)(lt >> 1); }
};
struct SchedMoeDown {
    static constexpr bool GATHER = false;
    const volatile LAS int* offs; int G, c; const char* Ab; const char* Bb;
    __device__ __forceinline__ bool next(int i, pg8::Unit& u) const {
        const int NB = offs[32] >> 8, L = i * G + c; if (L >= NB * 4) return false;
        const int mb = L >> 2, pn = L & 3; int e = 0;
        while (e < 31 && offs[e + 1] <= mb * 256) ++e;
        u.pm = mb; u.pn = pn; u.aux = e; u.idx0 = mb * 256 - offs[e]; u.cnt = offs[33 + e];
        u.A = Ab + (size_t)mb * (256 * 512 * 2); u.B = Bb + ((size_t)e * 1024 + pn * 256) * (512 * 2); return true; }
};

using pg8::f32x4;
#define EPI_FOR_ROWS _Pragma("unroll") for (int ai = 0; ai < 2; ++ai) _Pragma("unroll") for (int m = 0; m < 4; ++m)
#define EPI_ROW (u.pm * 256 + ai * 128 + wr * 64 + m * 16 + fr)
__device__ __forceinline__ float rscale_of(const float* ssq, int row) {
    const f32x4* sp = (const f32x4*)(ssq + (size_t)row * 16); const f32x4 a = sp[0], b = sp[1], c = sp[2], d = sp[3];
    const float s = ((a[0] + a[1]) + (a[2] + a[3])) + ((b[0] + b[1]) + (b[2] + b[3])) + ((c[0] + c[1]) + (c[2] + c[3])) + ((d[0] + d[1]) + (d[2] + d[3]));
    return rsqrtf(s * (1.0f / DM) + EPS);
}
struct EpiP1 {
    static constexpr bool PERM = true, MIDK = false;
    const float* ssq; const float* cosT; const float* sinT; bf16 *Q, *K, *V, *U, *SGA, *SGB;
    __device__ __forceinline__ void operator()(const f32x4 (&acc)[2][2][4][2], const pg8::Unit& u, int wr, int wc, int fr, int fq) const {
        const int pn = u.pn;
        EPI_FOR_ROWS { const int row = EPI_ROW;
            const float r = rscale_of(ssq, row); const int b = row >> 11, t = row & 2047;
            if (pn < 4) {
                const int head = 4 * (pn & 1) + wc; const float qs = pn < 2 ? QSCALE : 1.0f;
                const f32x4* cp = (const f32x4*)(cosT + t * 32 + 8 * fq); const f32x4* sp = (const f32x4*)(sinT + t * 32 + 8 * fq);
                f32x4 o1[2], o2[2];
#pragma unroll
                for (int n = 0; n < 2; ++n) { const f32x4 c = cp[n], s = sp[n], t1 = acc[ai][0][m][n] * (r * qs), t2 = acc[ai][1][m][n] * (r * qs); o1[n] = t1 * c - t2 * s; o2[n] = t1 * s + t2 * c; }
                bf16* dst = (pn < 2 ? Q : K) + ((size_t)(b * NH + head) * SEQ + t) * HD + 8 * fq;
                *(v4u*)dst = pack8(o1[0], o1[1]); *(v4u*)(dst + 32) = pack8(o2[0], o2[1]);
            } else if (pn < 6) {
#pragma unroll
                for (int bj = 0; bj < 2; ++bj) { const int head = 4 * (pn - 4) + 2 * bj + (wc >> 1), dim = 32 * (wc & 1) + 8 * fq;
                    *(v4u*)(V + ((size_t)(b * NH + head) * SEQ + t) * HD + dim) = pack8(acc[ai][bj][m][0] * r, acc[ai][bj][m][1] * r); }
            } else if (pn < 10) {
                f32x4 o[2];
#pragma unroll
                for (int n = 0; n < 2; ++n) o[n] = (acc[ai][0][m][n] * r) * sigm4(acc[ai][1][m][n] * r);
                *(v4u*)(U + (size_t)row * CW + 128 * (pn - 6) + 32 * wc + 8 * fq) = pack8(o[0], o[1]);
            } else {
                bf16* base = (pn < 14 ? SGA + 256 * (pn - 10) : SGB + 256 * (pn - 14)) + (size_t)row * DM + 32 * wc + 8 * fq;
#pragma unroll
                for (int bj = 0; bj < 2; ++bj) *(v4u*)(base + 128 * bj) = pack8(sigm4(acc[ai][bj][m][0] * r), sigm4(acc[ai][bj][m][1] * r));
            }
        }
    }
};
struct EpiP3 {
    static constexpr bool PERM = true, MIDK = true;
    const bf16* SGA; const bf16* SGB; const float* bco; bf16* MG;
    __device__ __forceinline__ void mid(f32x4 (&acc)[2][2][4][2], const pg8::Unit& u, int wr, int wc, int fr, int fq) const {
        int z_ = 0; asm volatile("" : "+v"(z_));
#pragma unroll
        for (int ai = 0; ai < 2; ++ai)
#pragma unroll
            for (int m = 0; m < 4; ++m) { const int row = EPI_ROW + z_;
                v4u a[2], b[2];
#pragma unroll
                for (int bj = 0; bj < 2; ++bj) { const size_t off = (size_t)row * DM + u.pn * 256 + 128 * bj + 32 * wc + 8 * fq; a[bj] = *(const v4u*)(SGA + off); b[bj] = *(const v4u*)(SGB + off); }
#pragma unroll
                for (int bj = 0; bj < 2; ++bj) {
                    acc[ai][bj][m][0][0] *= bf_lo(a[bj].x) * __builtin_amdgcn_rcpf(bf_lo(b[bj].x)); acc[ai][bj][m][0][1] *= bf_hi(a[bj].x) * __builtin_amdgcn_rcpf(bf_hi(b[bj].x));
                    acc[ai][bj][m][0][2] *= bf_lo(a[bj].y) * __builtin_amdgcn_rcpf(bf_lo(b[bj].y)); acc[ai][bj][m][0][3] *= bf_hi(a[bj].y) * __builtin_amdgcn_rcpf(bf_hi(b[bj].y));
                    acc[ai][bj][m][1][0] *= bf_lo(a[bj].z) * __builtin_amdgcn_rcpf(bf_lo(b[bj].z)); acc[ai][bj][m][1][1] *= bf_hi(a[bj].z) * __builtin_amdgcn_rcpf(bf_hi(b[bj].z));
                    acc[ai][bj][m][1][2] *= bf_lo(a[bj].w) * __builtin_amdgcn_rcpf(bf_lo(b[bj].w)); acc[ai][bj][m][1][3] *= bf_hi(a[bj].w) * __builtin_amdgcn_rcpf(bf_hi(b[bj].w)); }
                if (m & 1) asm volatile("" ::: "memory");
            }
    }
    __device__ __forceinline__ void operator()(const f32x4 (&acc)[2][2][4][2], const pg8::Unit& u, int wr, int wc, int fr, int fq) const {
        EPI_FOR_ROWS { const int row = EPI_ROW;
#pragma unroll
            for (int bj = 0; bj < 2; ++bj) { const int col = u.pn * 256 + 128 * bj + 32 * wc + 8 * fq; const size_t off = (size_t)row * DM + col;
                f32x4 g0, g1; unpack8(*(const v4u*)(SGB + off), g0, g1);
                const f32x4 b0 = *(const f32x4*)(bco + col), b1 = *(const f32x4*)(bco + col + 4);
                *(v4u*)(MG + off) = pack8(g0 * (acc[ai][bj][m][0] + b0), g1 * (acc[ai][bj][m][1] + b1)); }
        }
    }
};
#define RESID_STORE(DELTA0, DELTA1) { f32x4 x0, x1; unpack8(*(const v4u*)(XI + off), x0, x1); const f32x4 v0 = x0 + (DELTA0), v1 = x1 + (DELTA1); \
        *(v4u*)(XO + off) = pack8(v0, v1); \
        ss += ((v0[0] * v0[0] + v0[1] * v0[1]) + (v0[2] * v0[2] + v0[3] * v0[3])) + ((v1[0] * v1[0] + v1[1] * v1[1]) + (v1[2] * v1[2] + v1[3] * v1[3])); }
#define SSQ_STORE() { ss += __shfl_xor(ss, 16); ss += __shfl_xor(ss, 32); if (fq == 0) ssq_out[(size_t)row * 16 + u.pn * 4 + wc] = ss; }
struct EpiP4 {
    static constexpr bool PERM = true, MIDK = false;
    const bf16* XI; bf16* XO; float* ssq_out;
    __device__ __forceinline__ void operator()(const f32x4 (&acc)[2][2][4][2], const pg8::Unit& u, int wr, int wc, int fr, int fq) const {
        EPI_FOR_ROWS { const int row = EPI_ROW;
            float ss = 0.f;
#pragma unroll
            for (int bj = 0; bj < 2; ++bj) { const size_t off = (size_t)row * DM + u.pn * 256 + 128 * bj + 32 * wc + 8 * fq; RESID_STORE(acc[ai][bj][m][0], acc[ai][bj][m][1]) }
            SSQ_STORE()
        }
    }
};
struct EpiP8 {
    static constexpr bool PERM = true, MIDK = false;
    const float* ssq_in; const bf16* PE; const bf16* XI; bf16* XO; float* ssq_out;
    __device__ __forceinline__ void operator()(const f32x4 (&acc)[2][2][4][2], const pg8::Unit& u, int wr, int wc, int fr, int fq) const {
        EPI_FOR_ROWS { const int row = EPI_ROW;
            const float r = rscale_of(ssq_in, row); float ss = 0.f;
#pragma unroll
            for (int bj = 0; bj < 2; ++bj) { const size_t off = (size_t)row * DM + u.pn * 256 + 128 * bj + 32 * wc + 8 * fq;
                f32x4 p0, p1; unpack8(*(const v4u*)(PE + off), p0, p1);
                RESID_STORE(sigm4(acc[ai][bj][m][0] * r) * p0, sigm4(acc[ai][bj][m][1] * r) * p1) }
            SSQ_STORE()
        }
    }
};
struct EpiBf16 {
    static constexpr bool PERM = true, MIDK = false;
    bf16* O; int ldc;
    __device__ __forceinline__ void operator()(const f32x4 (&acc)[2][2][4][2], const pg8::Unit& u, int wr, int wc, int fr, int fq) const {
        EPI_FOR_ROWS { const int row = EPI_ROW;
#pragma unroll
            for (int bj = 0; bj < 2; ++bj) *(v4u*)(O + (size_t)row * ldc + u.pn * 256 + 128 * bj + 32 * wc + 8 * fq) = pack8(acc[ai][bj][m][0], acc[ai][bj][m][1]);
        }
    }
};
#define MOE_ROW_ENTRY(rl) ({ const int idx_ = u.idx0 + (rl); idx_ < u.cnt ? LIST[(size_t)u.aux * LIST_CAP + idx_] : 0; })
struct EpiUp {
    static constexpr bool PERM = true, MIDK = false;
    const int* LIST; const float* ROUTEF; bf16* H;
    __device__ __forceinline__ void operator()(const f32x4 (&acc)[2][2][4][2], const pg8::Unit& u, int wr, int wc, int fr, int fq) const {
        EPI_FOR_ROWS { const int row = EPI_ROW; const int lt = MOE_ROW_ENTRY(ai * 128 + wr * 64 + m * 16 + fr);
            const float r = ROUTEF[(size_t)(lt >> 1) * 8 + 6]; f32x4 o[2];
#pragma unroll
            for (int n = 0; n < 2; ++n) { const f32x4 g = acc[ai][0][m][n] * r; o[n] = g * sigm4(g) * (acc[ai][1][m][n] * r); }
            *(v4u*)(H + (size_t)row * FF + 128 * u.pn + 32 * wc + 8 * fq) = pack8(o[0], o[1]);
        }
    }
};
struct EpiDown {
    static constexpr bool PERM = true, MIDK = false;
    const int* LIST; const float* ROUTEF; bf16* Y;
    __device__ __forceinline__ void operator()(const f32x4 (&acc)[2][2][4][2], const pg8::Unit& u, int wr, int wc, int fr, int fq) const {
        EPI_FOR_ROWS { const int row = EPI_ROW; const int lt = MOE_ROW_ENTRY(ai * 128 + wr * 64 + m * 16 + fr);
            const float gt = ROUTEF[(size_t)(lt >> 1) * 8 + 4 + (lt & 1)];
#pragma unroll
            for (int bj = 0; bj < 2; ++bj) *(v4u*)(Y + (size_t)row * DM + u.pn * 256 + 128 * bj + 32 * wc + 8 * fq) = pack8(acc[ai][bj][m][0] * gt, acc[ai][bj][m][1] * gt);
        }
    }
};

struct SchedRouteP {   static constexpr bool GATHER = false;
    int G, c; const char* Xb; const char* Wb;
    __device__ __forceinline__ bool next(int i, pg8::Unit& u) const {
        const int L = i * G + c; if (L >= 256) return false;
        pg8::tile_of(L, 64, 4, u.pm, u.pn); u.aux = 0; u.A = Xb + (size_t)u.pm * (256 * 1024 * 2) + u.pn * 512; u.B = Wb + u.pn * 512; return true; }
};
struct EpiRouteP {
    static constexpr bool PERM = true, MIDK = false;
    float* LGP;
    __device__ __forceinline__ void operator()(const f32x4 (&acc)[2][2][4][2], const pg8::Unit& u, int wr, int wc, int fr, int fq) const {
        if (wc < 2) {
            EPI_FOR_ROWS { const int row = EPI_ROW; float* dst = LGP + ((size_t)u.pn * M + row) * 64 + 32 * wc + 8 * fq;
                *(f32x4*)dst = acc[ai][0][m][0]; *(f32x4*)(dst + 4) = acc[ai][0][m][1]; }
        }
    }
};
__device__ __forceinline__ void decide_phase(Frame& F, int L) {
    volatile LAS unsigned* lcnt = (volatile LAS unsigned*)(F.lds + RING_OFF);
    const float* LGP = WSP(float, WS_LG); const float* SSQ = WSP(float, WS_SSQ + (size_t)(3 * L + 1) * MiB); const float* rb = WSP(float, WS_RB) + L * 64;
    int* ROUTE = WSP(int, WS_ROUTE); unsigned* cnt = (unsigned*)(F.ctl + CW_CNT + 64 * L);
    for (int blk = F.vcu; blk < M / 64; blk += F.G) {
        if (F.tid < 64) lcnt[F.tid] = 0u;
        __syncthreads();
        int ea = 0, eb = 0; unsigned ra = 0, rbk = 0; float g1 = 0.f, g2 = 0.f, rr = 0.f; const int t = blk * 64 + F.tid;
        if (F.tid < 64) {
            rr = rscale_of(SSQ, t);
            float lg[36];
#pragma unroll
            for (int q = 0; q < 9; ++q) { f32x4 a = *(const f32x4*)(LGP + (size_t)t * 64 + 4 * q);
#pragma unroll
                for (int p = 1; p < 4; ++p) a = a + *(const f32x4*)(LGP + ((size_t)p * M + t) * 64 + 4 * q);
                const f32x4 b = *(const f32x4*)(rb + 4 * q); a = a * rr + b; lg[4 * q] = a[0]; lg[4 * q + 1] = a[1]; lg[4 * q + 2] = a[2]; lg[4 * q + 3] = a[3]; }
            float mxv = lg[0]; int gs = 0;
#pragma unroll
            for (int i = 1; i < 4; ++i) if (lg[i] > mxv) { mxv = lg[i]; gs = i; }
            float se = 0.f;
#pragma unroll
            for (int i = 0; i < 4; ++i) se += __expf(lg[i] - mxv);
            const float pg = __builtin_amdgcn_rcpf(se);
            float v1 = -1e30f, v2 = -1e30f; int i1 = 0, i2 = 0;
#pragma unroll
            for (int g = 0; g < 4; ++g) if (g == gs) {
#pragma unroll
                for (int i = 0; i < 8; ++i) { const float v = lg[4 + 8 * g + i]; if (v > v1) { v2 = v1; i2 = i1; v1 = v; i1 = i; } else if (v > v2) { v2 = v; i2 = i; } } }
            const float e2 = __expf(v2 - v1), s1 = __builtin_amdgcn_rcpf(1.0f + e2);
            ea = gs * 8 + i1; eb = gs * 8 + i2; g1 = pg * s1; g2 = pg * e2 * s1;
            ra = __hip_atomic_fetch_add((LAS unsigned*)lcnt + ea, 1u, __ATOMIC_RELAXED, __HIP_MEMORY_SCOPE_WORKGROUP); rbk = __hip_atomic_fetch_add((LAS unsigned*)lcnt + eb, 1u, __ATOMIC_RELAXED, __HIP_MEMORY_SCOPE_WORKGROUP);
        }
        __syncthreads();
        if (F.tid < 32) { const unsigned n = lcnt[F.tid]; lcnt[32 + F.tid] = n ? atomicAdd(cnt + F.tid, n) : 0u; }
        __syncthreads();
        if (F.tid < 64) {
            v4u r0, r1; r0.x = (unsigned)ea; r0.y = (unsigned)eb; r0.z = lcnt[32 + ea] + ra; r0.w = lcnt[32 + eb] + rbk; r1.x = __float_as_uint(g1); r1.y = __float_as_uint(g2); r1.z = __float_as_uint(rr); r1.w = 0u;
            *(GAS v4u*)(ROUTE + (size_t)t * 8) = r0; *(GAS v4u*)(ROUTE + (size_t)t * 8 + 4) = r1;
            int* LIST = WSP(int, WS_LIST); LIST[(size_t)ea * LIST_CAP + r0.z] = 2 * t; LIST[(size_t)eb * LIST_CAP + r0.w] = 2 * t + 1;
        }
        __syncthreads();
    }
}

__device__ __forceinline__ void attn_simple(Frame& F) {
    const bf16* Q = WSP(bf16, WS_Q); const bf16* Kb = WSP(bf16, WS_K); const bf16* Vb = WSP(bf16, WS_V); bf16* OC = WSP(bf16, WS_OC);
    const int lane = F.lane;
    for (int unit = F.vcu * NWAVES + F.wave; unit < BATCH * NH * (SEQ / 64); unit += F.G * NWAVES) {
        const int bh = unit >> 5, t = ((unit & 31) << 6) + lane;
        unsigned qw[32];
        { const GAS v4u* qp = (const GAS v4u*)(Q + ((size_t)bh * SEQ + t) * HD);
#pragma unroll
          for (int i = 0; i < 8; ++i) { const v4u w = qp[i]; qw[4 * i] = w.x; qw[4 * i + 1] = w.y; qw[4 * i + 2] = w.z; qw[4 * i + 3] = w.w; } }
        float o[64];
#pragma unroll
        for (int i = 0; i < 64; ++i) o[i] = 0.f;
        float mx = -1e30f, l = 0.f;
        for (int g = 0; g < 3; ++g) {
            const int d = g == 0 ? 1 : (g == 1 ? 4 : 16);
            for (int j0 = 0; j0 <= 128; j0 += 4) {
                if (!__any(t - j0 * d >= 0)) break;
                float s[4]; int pc[4];
#pragma unroll
                for (int c = 0; c < 4; ++c) { const int j = j0 + c, pos = t - j * d; const bool valid = pos >= 0 && j <= 128; pc[c] = valid ? pos : t;
                    const GAS v4u* kp = (const GAS v4u*)(Kb + ((size_t)bh * SEQ + pc[c]) * HD); float a = 0.f;
#pragma unroll
                    for (int i = 0; i < 8; ++i) { const v4u w = kp[i]; a = dot2bf(qw[4 * i], w.x, a); a = dot2bf(qw[4 * i + 1], w.y, a); a = dot2bf(qw[4 * i + 2], w.z, a); a = dot2bf(qw[4 * i + 3], w.w, a); }
                    s[c] = valid ? a : -1e30f; }
                const float mc = fmaxf(fmaxf(s[0], s[1]), fmaxf(s[2], s[3])), mn = fmaxf(mx, mc), sc = __builtin_amdgcn_exp2f(mx - mn);
                l *= sc;
#pragma unroll
                for (int i = 0; i < 64; ++i) o[i] *= sc;
                mx = mn;
#pragma unroll
                for (int c = 0; c < 4; ++c) { const float p = __builtin_amdgcn_exp2f(s[c] - mn); l += p;
                    const GAS v4u* vp = (const GAS v4u*)(Vb + ((size_t)bh * SEQ + pc[c]) * HD);
#pragma unroll
                    for (int i = 0; i < 8; ++i) { const v4u w = vp[i];
                        o[8 * i + 0] += p * bf_lo(w.x); o[8 * i + 1] += p * bf_hi(w.x); o[8 * i + 2] += p * bf_lo(w.y); o[8 * i + 3] += p * bf_hi(w.y);
                        o[8 * i + 4] += p * bf_lo(w.z); o[8 * i + 5] += p * bf_hi(w.z); o[8 * i + 6] += p * bf_lo(w.w); o[8 * i + 7] += p * bf_hi(w.w); } }
            }
        }
        const float inv = 1.0f / l; const int b = bh >> 3, h = bh & 7;
        GAS v4u* op = (GAS v4u*)(OC + ((size_t)(b * SEQ + t)) * DM + h * HD);
#pragma unroll
        for (int i = 0; i < 8; ++i) { v4u w; w.x = cvt_pk_bf16(o[8 * i] * inv, o[8 * i + 1] * inv); w.y = cvt_pk_bf16(o[8 * i + 2] * inv, o[8 * i + 3] * inv); w.z = cvt_pk_bf16(o[8 * i + 4] * inv, o[8 * i + 5] * inv); w.w = cvt_pk_bf16(o[8 * i + 6] * inv, o[8 * i + 7] * inv); op[i] = w; }
    }
}

typedef float f32x16 __attribute__((ext_vector_type(16)));
typedef short v4i16_t __attribute__((ext_vector_type(4)));
struct AttnStep { int p0, st, mode, T; };
__device__ __forceinline__ void attn_desc(int idx, int qb, int c, int i, int hi, int n1, int n0, int nb2, AttnStep& d) {
    if (idx < n1) { const int kb = qb - idx; d.p0 = 128 * kb + c; d.st = 4; d.mode = (idx == 0) ? 2 : ((idx == 4) ? 1 : 0); d.T = i - 4 * hi; }
    else if (idx < n1 + n0) { const int kb = (qb ? 0 : 4) + (idx - n1); d.st = 1;
        if (kb < 4) { d.p0 = 128 * (qb - 1) + 32 * kb; d.mode = 1; d.T = 4 * i + c - 32 * kb - 4 * hi; }
        else { d.p0 = 128 * qb + 32 * (kb - 4); d.mode = 2; d.T = 4 * i + c - 32 * (kb - 4) - 4 * hi; } }
    else { const int e = idx - n1 - n0, a = e / nb2, kb = e - a * nb2; d.p0 = 512 * kb + 4 * a + c; d.st = 16; d.mode = 2; d.T = ((i & 3) == a) ? (8 * qb + (i >> 2) - 32 * kb - 4 * hi) : -100; }
}
__device__ __forceinline__ void attn_dma(LAS unsigned char* slot, const bf16* Kh, const bf16* Vh, int p0, int st, int lane) {
    const int rl = lane >> 3, pos = lane & 7;
#pragma unroll
    for (int pc = 0; pc < 4; ++pc) {
        const int row = 8 * pc + rl; const size_t rowoff = (size_t)(p0 + st * row) * HD;
        const int chk = pos ^ ((row >> 1) & 7);
        const int chv = (((pos >> 1) ^ (((row >> 1) & 1) << 1)) << 1) | (pos & 1);
        __builtin_amdgcn_global_load_lds((const unsigned*)(Kh + rowoff + chk * 8), (LAS unsigned*)(slot + pc * 1024), 16, 0, 0);
        __builtin_amdgcn_global_load_lds((const unsigned*)(Vh + rowoff + chv * 8), (LAS unsigned*)(slot + 4096 + pc * 1024), 16, 0, 0);
    }
}
__device__ __forceinline__ void attn_mfma(Frame& F) {
    const bf16* Q = WSP(bf16, WS_Q); const bf16* Kb = WSP(bf16, WS_K); const bf16* Vb = WSP(bf16, WS_V); bf16* OC = WSP(bf16, WS_OC);
    const int lane = F.lane, i = lane & 31, hi = lane >> 5;
    LAS unsigned char* ring = F.lds + RING_OFF + F.wave * 16384;
    int koff[4];
#pragma unroll
    for (int s = 0; s < 4; ++s) koff[s] = i * 128 + (((2 * s + hi) ^ ((i >> 1) & 7)) << 4);
    const int g2 = (lane >> 4) & 1, q4 = (lane & 15) >> 2, p4 = lane & 3;
    int voff[2][2];
#pragma unroll
    for (int s = 0; s < 2; ++s)
#pragma unroll
        for (int db = 0; db < 2; ++db) { const int row = 16 * s + 4 * hi + q4; voff[s][db] = 4096 + row * 128 + (((2 * db + g2) ^ (((row >> 1) & 1) << 1)) << 5) + p4 * 8; }
    for (int pass = 0; pass < 2; ++pass) {
        const int gw = F.vcu * NWAVES + F.wave;
        const int T = pass == 0 ? gw : (BATCH * NH * 4 * 16 - 1 - gw);
        if (gw >= BATCH * NH * 4 * 16 / 2) break;
        const int qb = T & 15, c = (T >> 4) & 3, bh = T >> 6;
        const bf16* Kh = Kb + (size_t)bh * SEQ * HD; const bf16* Vh = Vb + (size_t)bh * SEQ * HD;
        const int tq = 128 * qb + 4 * i + c;
        bf16x8 qf[4];
        { const GAS bf16x8* qp = (const GAS bf16x8*)(Q + ((size_t)bh * SEQ + tq) * HD + 8 * hi);
#pragma unroll
          for (int s = 0; s < 4; ++s) qf[s] = qp[2 * s]; }
        const int n1 = (qb < 4 ? qb : 4) + 1, n0 = qb ? 8 : 4, nb2 = (qb >> 2) + 1, nsteps = n1 + n0 + 4 * nb2;
        f32x16 o0, o1;
#pragma unroll
        for (int r = 0; r < 16; ++r) { o0[r] = 0.f; o1[r] = 0.f; }
        float mrun = -1e30f, lrun = 0.f;
        AttnStep cur; attn_desc(0, qb, c, i, hi, n1, n0, nb2, cur);
        attn_dma(ring, Kh, Vh, cur.p0, cur.st, lane);
        for (int idx = 0; idx < nsteps; ++idx) {
            LAS unsigned char* slot = ring + (idx & 1) * 8192;
            AttnStep nxt = cur;
            if (idx + 1 < nsteps) { attn_desc(idx + 1, qb, c, i, hi, n1, n0, nb2, nxt); attn_dma(ring + ((idx + 1) & 1) * 8192, Kh, Vh, nxt.p0, nxt.st, lane); asm volatile("s_waitcnt vmcnt(8)" ::: "memory"); }
            else { asm volatile("s_waitcnt vmcnt(0)" ::: "memory"); }
            f32x16 sacc;
#pragma unroll
            for (int r = 0; r < 16; ++r) sacc[r] = 0.f;
#pragma unroll
            for (int s = 0; s < 4; ++s) { const bf16x8 kf = *(const LAS bf16x8*)(slot + koff[s]); sacc = __builtin_amdgcn_mfma_f32_32x32x16_bf16(kf, qf[s], sacc, 0, 0, 0); }
            if (cur.mode == 1) {
#pragma unroll
                for (int r = 0; r < 16; ++r) sacc[r] = ((r & 3) + 8 * (r >> 2) >= cur.T) ? sacc[r] : -1e30f;
            } else if (cur.mode == 2) {
#pragma unroll
                for (int r = 0; r < 16; ++r) sacc[r] = ((r & 3) + 8 * (r >> 2) <= cur.T) ? sacc[r] : -1e30f;
            }
            float mloc = sacc[0];
#pragma unroll
            for (int r = 1; r < 16; ++r) mloc = fmaxf(mloc, sacc[r]);
            { auto rr = __builtin_amdgcn_permlane32_swap(__float_as_uint(mloc), __float_as_uint(mloc), false, false); mloc = fmaxf(__uint_as_float(rr[0]), __uint_as_float(rr[1])); }
            const float mnew = fmaxf(mrun, mloc), alpha = __builtin_amdgcn_exp2f(mrun - mnew);
            mrun = mnew;
            float psum = 0.f;
#pragma unroll
            for (int r = 0; r < 16; ++r) { sacc[r] = __builtin_amdgcn_exp2f(sacc[r] - mnew); psum += sacc[r]; }
            lrun = lrun * alpha + psum;
#pragma unroll
            for (int r = 0; r < 16; ++r) { o0[r] *= alpha; o1[r] *= alpha; }
            bf16x8 pf[2];
#pragma unroll
            for (int s = 0; s < 2; ++s) { v4u w; w.x = cvt_pk_bf16(sacc[8 * s], sacc[8 * s + 1]); w.y = cvt_pk_bf16(sacc[8 * s + 2], sacc[8 * s + 3]); w.z = cvt_pk_bf16(sacc[8 * s + 4], sacc[8 * s + 5]); w.w = cvt_pk_bf16(sacc[8 * s + 6], sacc[8 * s + 7]); pf[s] = __builtin_bit_cast(bf16x8, w); }
#pragma unroll
            for (int s = 0; s < 2; ++s)
#pragma unroll
                for (int db = 0; db < 2; ++db) {
                    const v4i16_t lo = __builtin_amdgcn_ds_read_tr16_b64_v4i16((LAS v4i16_t*)(slot + voff[s][db]));
                    const v4i16_t hh = __builtin_amdgcn_ds_read_tr16_b64_v4i16((LAS v4i16_t*)(slot + voff[s][db] + 8 * 128));
                    const bf16x8 vf = (bf16x8){lo[0], lo[1], lo[2], lo[3], hh[0], hh[1], hh[2], hh[3]};
                    if (db == 0) o0 = __builtin_amdgcn_mfma_f32_32x32x16_bf16(vf, pf[s], o0, 0, 0, 0); else o1 = __builtin_amdgcn_mfma_f32_32x32x16_bf16(vf, pf[s], o1, 0, 0, 0);
                }
            cur = nxt;
        }
        { auto rr = __builtin_amdgcn_permlane32_swap(__float_as_uint(lrun), __float_as_uint(lrun), false, false); lrun = __uint_as_float(rr[0]) + __uint_as_float(rr[1]); }
        const float inv = 1.0f / lrun; const int b = bh >> 3, h = bh & 7;
        bf16* op = OC + ((size_t)(b * SEQ + tq)) * DM + h * HD + 4 * hi;
#pragma unroll
        for (int g = 0; g < 4; ++g) {
            v2u w0, w1; w0.x = cvt_pk_bf16(o0[4 * g] * inv, o0[4 * g + 1] * inv); w0.y = cvt_pk_bf16(o0[4 * g + 2] * inv, o0[4 * g + 3] * inv);
            w1.x = cvt_pk_bf16(o1[4 * g] * inv, o1[4 * g + 1] * inv); w1.y = cvt_pk_bf16(o1[4 * g + 2] * inv, o1[4 * g + 3] * inv);
            *(GAS v2u*)(op + 8 * g) = w0; *(GAS v2u*)(op + 32 + 8 * g) = w1; }
    }
    asm volatile("s_waitcnt vmcnt(0)" ::: "memory");
}

__device__ __forceinline__ void conv_simple(Frame& F, const Args& args, int L) {
    LAS float* ybuf = (LAS float*)(F.lds + RING_OFF); LAS float* stats = ybuf + 16 * 512;
    const bf16* U = WSP(bf16, WS_U); bf16* OC = WSP(bf16, WS_OC);
    const int c = F.tid, lane = F.lane;
    float w[CK];
#pragma unroll
    for (int j = 0; j < CK; ++j) w[j] = args.in[4][((size_t)L * CK + j) * CW + c];
    const float bias = args.in[5][L * CW + c], lg = args.in[6][L * CW + c], lb = args.in[7][L * CW + c];
    for (int unit = F.vcu; unit < M / 16; unit += F.G) {
        const int row0 = unit * 16, t0 = row0 & (SEQ - 1);
        float uu[46];
#pragma unroll
        for (int i = 0; i < 46; ++i) { const int tt = t0 - 30 + i; uu[i] = tt >= 0 ? __uint_as_float((unsigned)U[(size_t)(row0 - 30 + i) * CW + c] << 16) : 0.f; }
        float y[16];
#pragma unroll
        for (int tt = 0; tt < 16; ++tt) { float a = bias;
#pragma unroll
            for (int j = 0; j < CK; ++j) a += w[j] * uu[tt + j];
            y[tt] = a; ybuf[tt * 512 + c] = a; }
        __syncthreads();
#pragma unroll
        for (int q = 0; q < 2; ++q) { const int tt = 2 * F.wave + q; float v[8]; float s = 0.f;
#pragma unroll
            for (int i = 0; i < 8; ++i) { v[i] = ybuf[tt * 512 + lane + 64 * i]; s += v[i]; }
            const float mu = wave_sum(s) * (1.0f / 512.0f); float s2 = 0.f;
#pragma unroll
            for (int i = 0; i < 8; ++i) { const float dd = v[i] - mu; s2 += dd * dd; }
            const float var = wave_sum(s2) * (1.0f / 512.0f);
            if (lane == 0) { stats[2 * tt] = mu; stats[2 * tt + 1] = rsqrtf(var + EPS); } }
        __syncthreads();
#pragma unroll
        for (int tt = 0; tt < 16; ++tt) { const float yn = (y[tt] - stats[2 * tt]) * stats[2 * tt + 1] * lg + lb; const float ov = yn * sigm(yn);
            OC[(size_t)(row0 + tt) * DM + 512 + c] = (bf16)(cvt_pk_bf16(ov, 0.f) & 0xffffu); }
        __syncthreads();
    }
}

__device__ __forceinline__ void conv_v2(Frame& F, const Args& args, int L) {
    LAS float* ybuf = (LAS float*)(F.lds + RING_OFF);
    LAS float* stats = (LAS float*)(F.lds + OFFS_OFF + 512);
    const bf16* U = WSP(bf16, WS_U); bf16* OC = WSP(bf16, WS_OC);
    const int cp = F.tid & 255, half = F.tid >> 8, lane = F.lane;
    f32x2 w[CK];
#pragma unroll
    for (int j = 0; j < CK; ++j) w[j] = *(const f32x2*)(args.in[4] + ((size_t)L * CK + j) * CW + 2 * cp);
    const f32x2 bias = *(const f32x2*)(args.in[5] + L * CW + 2 * cp), lg = *(const f32x2*)(args.in[6] + L * CW + 2 * cp), lb = *(const f32x2*)(args.in[7] + L * CW + 2 * cp);
    for (int unit = F.vcu; unit < M / 64; unit += F.G) {
        const int row0 = unit * 64 + half * 32, t0 = row0 & (SEQ - 1);
#pragma unroll 1
        for (int sub = 0; sub < 2; ++sub) {
            float wl[46], wh[46];
#pragma unroll
            for (int i = 0; i < 46; ++i) { const int tt = t0 + 16 * sub - 30 + i; const int ri = row0 + 16 * sub - 30 + i; const int rc = tt >= 0 ? ri : row0;
                unsigned u = *(const GAS unsigned*)(U + (size_t)rc * CW + 2 * cp); u = tt >= 0 ? u : 0u; wl[i] = bf_lo(u); wh[i] = bf_hi(u); }
#pragma unroll
            for (int tt = 0; tt < 16; ++tt) { f32x2 a = bias;
#pragma unroll
                for (int j = 0; j < CK; ++j) { a.x += w[j].x * wl[tt + j]; a.y += w[j].y * wh[tt + j]; }
                *(LAS f32x2*)(ybuf + (half * 32 + 16 * sub + tt) * 512 + 2 * cp) = a; }
        }
        __syncthreads();
#pragma unroll
        for (int q = 0; q < 8; ++q) { const int tk = 8 * F.wave + q; float s = 0.f, s2 = 0.f;
#pragma unroll
            for (int i = 0; i < 2; ++i) { const f32x4 v = *(const LAS f32x4*)(ybuf + tk * 512 + 4 * lane + 256 * i); s += (v[0] + v[1]) + (v[2] + v[3]); s2 += (v[0] * v[0] + v[1] * v[1]) + (v[2] * v[2] + v[3] * v[3]); }
            s = wave_sum(s); s2 = wave_sum(s2);
            const float mu = s * (1.0f / 512.0f), var = fmaxf(s2 * (1.0f / 512.0f) - mu * mu, 0.f);
            if (lane == 0) { stats[2 * tk] = mu; stats[2 * tk + 1] = rsqrtf(var + EPS); } }
        __syncthreads();
#pragma unroll
        for (int tt = 0; tt < 32; ++tt) { const f32x2 st = *(const LAS f32x2*)(stats + 2 * (half * 32 + tt));
            const f32x2 yv = *(const LAS f32x2*)(ybuf + (half * 32 + tt) * 512 + 2 * cp);
            const float y0 = (yv.x - st.x) * st.y * lg.x + lb.x, y1 = (yv.y - st.x) * st.y * lg.y + lb.y;
            *(GAS unsigned*)(OC + (size_t)(row0 + tt) * DM + 512 + 2 * cp) = cvt_pk_bf16(y0 * sigm(y0), y1 * sigm(y1)); }
        __syncthreads();
    }
}

__device__ __forceinline__ void route_phase(Frame& F, const Args& args, int L) {
    LAS float* lgs = (LAS float*)(F.lds + RING_OFF) + F.wave * (8 * 40);
    const bf16* XB = WSP(bf16, WS_XB); const float* SSQ = WSP(float, WS_SSQ + (size_t)(3 * L + 1) * MiB); const bf16* WR = WSP(bf16, WS_WR) + (size_t)L * 64 * DM;
    int* ROUTE = WSP(int, WS_ROUTE); unsigned* cnt = (unsigned*)(F.ctl + CW_CNT + 64 * L);
    const int lane = F.lane, gw = F.vcu * NWAVES + F.wave, NGW = F.G * NWAVES;
    int vz = 0; asm volatile("" : "+v"(vz));
    const float bias = lane < 4 ? args.in[14][L * NGRP + lane] : (lane < 36 ? args.in[16][L * NEXP + lane - 4] : 0.f);
    for (int tb = gw; tb < M / 8; tb += NGW) {
        const int t0 = tb * 8;
        const GAS v4u* wp = (const GAS v4u*)(WR + (size_t)lane * DM);
        float a[8];
#pragma unroll
        for (int tt = 0; tt < 8; ++tt) a[tt] = 0.f;
        for (int kc = 0; kc < 128; ++kc) { const v4u w = wp[kc];
#pragma unroll
            for (int tt = 0; tt < 8; ++tt) { const v4u x = *((const GAS v4u*)(XB + (size_t)(t0 + tt) * DM) + kc + vz);
                a[tt] = dot2bf(w.x, x.x, a[tt]); a[tt] = dot2bf(w.y, x.y, a[tt]); a[tt] = dot2bf(w.z, x.z, a[tt]); a[tt] = dot2bf(w.w, x.w, a[tt]); } }
        float rr = 0.f;
#pragma unroll
        for (int tt = 0; tt < 8; ++tt) { const float r = rscale_of(SSQ + vz, t0 + tt); if (lane == tt) rr = r; if (lane < 36) lgs[tt * 40 + lane] = a[tt] * r + bias; }
        LDS_WAIT(); asm volatile("" ::: "memory");
        if (lane < 8) {
            const int t = t0 + lane; const LAS float* lp = lgs + lane * 40;
            float mxv = -1e30f; int gs = 0; float l4[4];
#pragma unroll
            for (int i = 0; i < 4; ++i) { l4[i] = lp[i]; if (l4[i] > mxv) { mxv = l4[i]; gs = i; } }
            float se = 0.f;
#pragma unroll
            for (int i = 0; i < 4; ++i) se += __expf(l4[i] - mxv);
            const float pg = 1.0f / se;
            float v1 = -1e30f, v2 = -1e30f; int i1 = 0, i2 = 0;
#pragma unroll
            for (int i = 0; i < 8; ++i) { const float v = lp[4 + gs * 8 + i]; if (v > v1) { v2 = v1; i2 = i1; v1 = v; i1 = i; } else if (v > v2) { v2 = v; i2 = i; } }
            const float e2 = __expf(v2 - v1), s1 = 1.0f / (1.0f + e2);
            const int ea = gs * 8 + i1, eb = gs * 8 + i2;
            const unsigned ia = atomicAdd(cnt + ea, 1u), ib = atomicAdd(cnt + eb, 1u);
            v4u r0, r1; r0.x = (unsigned)ea; r0.y = (unsigned)eb; r0.z = ia; r0.w = ib; r1.x = __float_as_uint(pg * s1); r1.y = __float_as_uint(pg * e2 * s1); r1.z = __float_as_uint(rr); r1.w = 0u;
            *(GAS v4u*)(ROUTE + (size_t)t * 8) = r0; *(GAS v4u*)(ROUTE + (size_t)t * 8 + 4) = r1;
        }
        LDS_WAIT(); asm volatile("" ::: "memory");
    }
}
__device__ __forceinline__ void moe_offsets(Frame& F, int L) {
    volatile LAS int* offs = (volatile LAS int*)(F.lds + OFFS_OFF);
    __syncthreads();
    if (F.tid == 0) { int acc = 0;
        for (int e = 0; e < NEXP; ++e) { offs[e] = acc; const unsigned c = __hip_atomic_load(F.ctl + CW_CNT + 64 * L + e, RLX_AGENT); offs[33 + e] = (int)c; acc += (int)((c + 255u) & ~255u); }
        offs[NEXP] = acc; }
    __syncthreads();
}
__device__ __forceinline__ void dispatch_phase(Frame& F, int L) {
    moe_offsets(F, L);
    const volatile LAS int* offs = (const volatile LAS int*)(F.lds + OFFS_OFF);
    const bf16* XB = XCUR(L); bf16* XG = WSP(bf16, WS_XG); const int* ROUTE = WSP(int, WS_ROUTE); int* POS = WSP(int, WS_POS); float* RSC = WSP(float, WS_RSC); float* ROWG = WSP(float, WS_ROWG);
    const int lane = F.lane, gw = F.vcu * NWAVES + F.wave, NGW = F.G * NWAVES;
    int vz = 0; asm volatile("" : "+v"(vz));
    for (int t = gw; t < M; t += NGW) {
        const v4u r0 = *(const GAS v4u*)(ROUTE + (size_t)t * 8 + vz), r1 = *(const GAS v4u*)(ROUTE + (size_t)t * 8 + 4 + vz);
        const int s0 = offs[r0.x] + (int)r0.z, s1 = offs[r0.y] + (int)r0.w;
        const GAS v4u* src = (const GAS v4u*)(XB + (size_t)t * DM) + lane; const v4u a = src[0], b = src[64];
        GAS v4u* d0 = (GAS v4u*)(XG + (size_t)s0 * DM) + lane; GAS v4u* d1 = (GAS v4u*)(XG + (size_t)s1 * DM) + lane;
        d0[0] = a; d0[64] = b; d1[0] = a; d1[64] = b;
        if (lane == 0) { POS[2 * t] = s0; POS[2 * t + 1] = s1; RSC[s0] = __uint_as_float(r1.z); RSC[s1] = __uint_as_float(r1.z); ROWG[s0] = __uint_as_float(r1.x); ROWG[s1] = __uint_as_float(r1.y); }
    }
}
__device__ __forceinline__ void combine_phase(Frame& F, int L) {
    moe_offsets(F, L);
    const volatile LAS int* offs = (const volatile LAS int*)(F.lds + OFFS_OFF);
    bf16* XB = XCUR(L); const bf16* Y = WSP(bf16, WS_Y); const int* ROUTE = WSP(int, WS_ROUTE); float* SSQ = WSP(float, WS_SSQ + (size_t)(3 * L + 2) * MiB);
    const int lane = F.lane, gw = F.vcu * NWAVES + F.wave, NGW = F.G * NWAVES;
    int vz = 0; asm volatile("" : "+v"(vz));
    for (int t = gw; t < M; t += NGW) {
        const v4u r0 = *(const GAS v4u*)(ROUTE + (size_t)t * 8 + vz);
        const int s0 = offs[r0.x] + (int)r0.z, s1 = offs[r0.y] + (int)r0.w;
        GAS v4u* xb = (GAS v4u*)(XB + (size_t)t * DM) + lane; const GAS v4u* y0 = (const GAS v4u*)(Y + (size_t)s0 * DM) + lane; const GAS v4u* y1 = (const GAS v4u*)(Y + (size_t)s1 * DM) + lane;
        float s = 0.f;
#pragma unroll
        for (int j = 0; j < 2; ++j) { f32x4 xa, xc, aa, ac, ba, bc; unpack8(xb[64 * j], xa, xc); unpack8(y0[64 * j], aa, ac); unpack8(y1[64 * j], ba, bc);
            const f32x4 v0 = xa + aa + ba, v1 = xc + ac + bc; xb[64 * j] = pack8(v0, v1);
            s += ((v0[0] * v0[0] + v0[1] * v0[1]) + (v0[2] * v0[2] + v0[3] * v0[3])) + ((v1[0] * v1[0] + v1[1] * v1[1]) + (v1[2] * v1[2] + v1[3] * v1[3])); }
        const float tot = wave_sum(s);
        if (lane < 16) SSQ[(size_t)t * 16 + lane] = lane == 0 ? tot : 0.f;
    }
}
__device__ __forceinline__ void final_norm_phase(Frame& F, const Args& args) {
    float* X = F.out; const bf16* XB = WSP(bf16, WS_XB); const float* g = args.in[23];
    const int lane = F.lane, gw = F.vcu * NWAVES + F.wave, NGW = F.G * NWAVES;
    for (int t = gw; t < M; t += NGW) {
        const GAS v4u* xb = (const GAS v4u*)(XB + (size_t)t * DM) + lane; f32x4 v[4]; float s = 0.f;
#pragma unroll
        for (int j = 0; j < 2; ++j) { unpack8(xb[64 * j], v[2 * j], v[2 * j + 1]); }
#pragma unroll
        for (int j = 0; j < 4; ++j) s += (v[j][0] * v[j][0] + v[j][1] * v[j][1]) + (v[j][2] * v[j][2] + v[j][3] * v[j][3]);
        const float r = rsqrtf(wave_sum(s) * (1.0f / DM) + EPS);
        GAS f32x4* xo = (GAS f32x4*)(X + (size_t)t * DM) + 2 * lane;
#pragma unroll
        for (int j = 0; j < 2; ++j) { const f32x4 g0 = *((const f32x4*)g + 2 * lane + 128 * j), g1 = *((const f32x4*)g + 2 * lane + 128 * j + 1);
            xo[128 * j] = v[2 * j] * r * g0; xo[128 * j + 1] = v[2 * j + 1] * r * g1; }
    }
}
#ifndef MK_EXTRA_BAR
#define MK_EXTRA_BAR
#endif
#ifndef MK_TIME_PHASE
#define MK_TIME_PHASE (-1)
#endif
#ifndef MK_TIME_MUL
#define MK_TIME_MUL 4
#endif
#ifndef MK_DUP
#define MK_DUP (-1)
#endif
#ifdef MK_REFGEMM
#define GEMM_BODY gemm_phase_ref
#else
#define GEMM_BODY gemm_phase
#endif
#ifndef MK_EN
#define MK_EN 0xfff
#endif
__global__ void __launch_bounds__(NWAVES * 64, 2) mk_fwd(Args args) {
    extern __shared__ __attribute__((aligned(16))) unsigned char lds[];
    Frame F;
    F.lds = (LAS unsigned char*)lds;
    F.MISC = (volatile LAS unsigned*)(F.lds + MISC_OFF);
    F.tid = threadIdx.x; F.lane = F.tid & 63; F.wave = __builtin_amdgcn_readfirstlane(F.tid >> 6);
    F.G = gridDim.x; { const int bx = blockIdx.x; F.vcu = (F.G % 8 == 0) ? (bx % 8) * (F.G / 8) + bx / 8 : bx; }
    F.ws = args.ws; F.out = args.out; F.ctl = (gu32*)(args.ws + WS_CTL);
    for (int u = F.tid; u < (LDS_BYTES - LDSCTL_OFF) / 4; u += NWAVES * 64) ((LAS unsigned*)(F.lds + LDSCTL_OFF))[u] = 0u;
    __syncthreads();
    XcdBarrier bar; bar.bar = (unsigned*)(F.ctl + CW_BAR); bar.x = 0; bar.st = nullptr;
    if (args.use_bar) bar = xcd_barrier_post((unsigned*)(F.ctl + CW_BAR), F.MISC + 8);
    const int cblk = (int)blockIdx.x;
#define PHASE_SEAM(ph_) do { if ((ph_) + 1 < args.ph_hi) { if (args.use_bar) { xcd_barrier(bar); MK_EXTRA_BAR } else { VM_WAIT(); __syncthreads(); } } } while (0)
    volatile LAS unsigned long long* tsl = (volatile LAS unsigned long long*)(F.lds + LDSCTL_OFF + 2048);
    const bool stamper = MK_TIME_PHASE >= 0 && blockIdx.x == 0 && threadIdx.x == 0;
    if (stamper) tsl[0] = __builtin_amdgcn_s_memrealtime();
    int ph0 = args.ph_lo;
    if (ph0 == 0 && (MK_EN & 1)) { p0_prologue(F, args); if (MK_DUP == 0) { xcd_barrier(bar); p0_prologue(F, args); } PHASE_SEAM(0); ph0 = 1; if (stamper) tsl[1] = __builtin_amdgcn_s_memrealtime(); }
    for (int ph = ph0; ph < args.ph_hi; ++ph) {
      for (int rep_ = (ph == MK_DUP ? 2 : 1); rep_ > 0; --rep_) {
        { int t_ = threadIdx.x; asm volatile("" : "+v"(t_)); F.tid = t_; F.lane = t_ & 63; F.wave = __builtin_amdgcn_readfirstlane(t_ >> 6); }
        if (ph == PH_FINAL && (MK_EN & 2)) {
            final_norm_phase(F, args);
        } else {
            const int L = (ph - 1) / PH_PER_LAYER, sub = (ph - 1) % PH_PER_LAYER;
            const char* wl = (const char*)(F.ws + WS_W + (size_t)L * W_LAYER);
            float* SSQ0 = WSP(float, WS_SSQ + (size_t)(3 * L) * MiB);
            if (sub == 0 && (MK_EN & (4 << 0))) {
                SchedGrid S{64, 18, F.G, cblk, (const char*)XCUR(L), wl + WO_WIN, (size_t)256 * 1024 * 2, (size_t)256 * 1024 * 2};
                EpiP1 E{SSQ0, WSP(float, WS_COS), WSP(float, WS_SIN), WSP(bf16, WS_Q), WSP(bf16, WS_K), WSP(bf16, WS_V), WSP(bf16, WS_U), WSP(bf16, WS_SGA), WSP(bf16, WS_SGB)};
                pg8::GEMM_BODY<EpiP1, SchedGrid, true>(F.lds + RING_OFF, pg8::Dims{1024, 1024, 1024}, S, E);
                {
                    const bool split = F.G == 256;
                    SchedGrid S2{64, 4, split ? 128 : F.G, split ? (cblk >= 128 ? cblk - 128 : 256) : cblk, (const char*)(WSP(bf16, WS_PB) + (size_t)L * M * PLE), wl + WO_WPP, (size_t)256 * 256 * 2, (size_t)256 * 256 * 2};
                    EpiBf16 E2{WSP(bf16, WS_PE), DM};
                    pg8::GEMM_BODY<EpiBf16, SchedGrid, false>(F.lds + RING_OFF, pg8::Dims{256, 256, 256}, S2, E2);
                }
            } else if (sub == 1 && (MK_EN & (4 << 1))) {
#ifdef MK_ATTN_SIMPLE
                attn_simple(F);
#else
                attn_mfma(F); __syncthreads();
#ifdef MK_ATTN_TWICE
                attn_mfma(F); __syncthreads();
#endif
#endif
#ifdef MK_CONV_SIMPLE
                conv_simple(F, args, L);
#else
                conv_v2(F, args, L);
#endif
            } else if (sub == 2 && (MK_EN & (4 << 2))) {
                SchedGrid S{64, 4, F.G, cblk, (const char*)WSP(bf16, WS_OC), wl + WO_WAO, (size_t)256 * 1024 * 2, (size_t)256 * 1024 * 2};
                EpiP3 E{WSP(bf16, WS_SGA), WSP(bf16, WS_SGB), args.in[10] + L * DM, WSP(bf16, WS_MG)};
                pg8::GEMM_BODY<EpiP3, SchedGrid, true>(F.lds + RING_OFF, pg8::Dims{1024, 1024, 1024}, S, E);
            } else if (sub == 3 && (MK_EN & (4 << 3))) {
                SchedGrid S{64, 4, F.G, cblk, (const char*)WSP(bf16, WS_MG), wl + WO_WOUT, (size_t)256 * 1024 * 2, (size_t)256 * 1024 * 2};
                EpiP4 E{XCUR(L), XCUR(L), WSP(float, WS_SSQ + (size_t)(3 * L + 1) * MiB)};
                pg8::GEMM_BODY<EpiP4, SchedGrid, true>(F.lds + RING_OFF, pg8::Dims{1024, 1024, 1024}, S, E);
                {
                    VM_WAIT(); __syncthreads();
                    if (F.tid == 0) { __builtin_amdgcn_fence(__ATOMIC_ACQUIRE, "agent"); VM_WAIT(); }
                    __syncthreads();
                    SchedRouteP S2{F.G, cblk, (const char*)XCUR(L), (const char*)(WSP(bf16, WS_WR) + (size_t)L * 256 * DM)};
                    EpiRouteP E2{WSP(float, WS_LG)};
                    pg8::GEMM_BODY<EpiRouteP, SchedRouteP, false>(F.lds + RING_OFF, pg8::Dims{256, 1024, 1024}, S2, E2);
                }
            } else if (sub == 4 && (MK_EN & (4 << 4))) {
                decide_phase(F, L);
            } else if (sub == 5 && (MK_EN & (4 << 5))) {
                moe_offsets(F, L);
                SchedMoeUp S{(const volatile LAS int*)(F.lds + OFFS_OFF), WSP(int, WS_LIST), F.G, cblk, (const char*)XCUR(L), wl + WO_WGU};
                EpiUp E{WSP(int, WS_LIST), WSP(float, WS_ROUTE), WSP(bf16, WS_H)};
                pg8::GEMM_BODY<EpiUp, SchedMoeUp, true>(F.lds + RING_OFF, pg8::Dims{1024, 1024, 1024}, S, E);
            } else if (sub == 6 && (MK_EN & (4 << 6))) {
                moe_offsets(F, L);
                SchedMoeDown S{(const volatile LAS int*)(F.lds + OFFS_OFF), F.G, cblk, (const char*)WSP(bf16, WS_H), wl + WO_WD};
                EpiDown E{WSP(int, WS_LIST), WSP(float, WS_ROUTE), WSP(bf16, WS_Y)};
                pg8::GEMM_BODY<EpiDown, SchedMoeDown, true>(F.lds + RING_OFF, pg8::Dims{512, 512, 512}, S, E);
            } else if (sub == 7 && (MK_EN & (4 << 7))) {
                combine_phase(F, L);
            } else if (MK_EN & (4 << 8)) {
                SchedGrid S{64, 4, F.G, cblk, (const char*)XCUR(L), wl + WO_WPG, (size_t)256 * 1024 * 2, (size_t)256 * 1024 * 2};
                EpiP8 E{WSP(float, WS_SSQ + (size_t)(3 * L + 2) * MiB), WSP(bf16, WS_PE), XCUR(L), XNXT(L), WSP(float, WS_SSQ + (size_t)(3 * L + 3) * MiB)};
                pg8::GEMM_BODY<EpiP8, SchedGrid, true>(F.lds + RING_OFF, pg8::Dims{1024, 1024, 1024}, S, E);
            }
        }
        if (rep_ > 1) xcd_barrier(bar);
      }
        PHASE_SEAM(ph);
        if (stamper) tsl[ph + 1] = __builtin_amdgcn_s_memrealtime();
    }
    if (stamper) { const unsigned long long d_ = tsl[MK_TIME_PHASE + 1] - tsl[MK_TIME_PHASE], t1_ = __builtin_amdgcn_s_memrealtime(); while (__builtin_amdgcn_s_memrealtime() - t1_ < (unsigned long long)MK_TIME_MUL * d_) __builtin_amdgcn_s_sleep(8); }
}

extern "C" void kernel_launch(void* const* d_in, const int* in_sizes, int n_in, void* d_out, int out_size, void* d_ws, size_t ws_size, hipStream_t stream) {
    static int grid = 0;
    if (grid == 0) {
        if (n_in != 24 || in_sizes[0] != M * DM || out_size != M * DM || ws_size < WS_END) { fprintf(stderr, "kernel_launch: unexpected shapes (n_in %d, in0 %d, out %d, ws %zu); nothing launched\n", n_in, n_in > 0 ? in_sizes[0] : -1, out_size, ws_size); grid = -1; return; }
        int dev = 0, cus = 0, per_cu = 0;
        if (hipGetDevice(&dev) != hipSuccess || hipDeviceGetAttribute(&cus, hipDeviceAttributeMultiprocessorCount, dev) != hipSuccess) { fprintf(stderr, "kernel_launch: device query failed\n"); grid = -1; return; }
        if (hipFuncSetAttribute((const void*)mk_fwd, hipFuncAttributeMaxDynamicSharedMemorySize, LDS_BYTES) != hipSuccess) { fprintf(stderr, "kernel_launch: hipFuncSetAttribute failed\n"); grid = -1; return; }
        if (hipOccupancyMaxActiveBlocksPerMultiprocessor(&per_cu, (const void*)mk_fwd, NWAVES * 64, LDS_BYTES) != hipSuccess || per_cu < 1) { fprintf(stderr, "kernel_launch: occupancy query reports %d blocks per CU\n", per_cu); }
        (void)hipGetLastError();
        grid = cus;
    }
    if (grid < 0) return;
    (void)hipMemsetAsync((char*)d_ws + WS_CTL, 0, CTL_ZERO_BYTES, stream);
    Args a{};
    for (int i = 0; i < 24; ++i) a.in[i] = (const float*)d_in[i];
    a.out = (float*)d_out; a.ws = (unsigned char*)d_ws;
    a.ph_lo = 0; a.ph_hi = N_PHASES; a.use_bar = 1;
    hipLaunchKernelGGL(mk_fwd, dim3(grid), dim3(NWAVES * 64), LDS_BYTES, stream, a);
}
```
